# Optimizing an MI355X kernel written in HIP

```python
import math
import jax, jax.numpy as jnp
from jax import lax
import numpy as np

D_MODEL = 1024
BATCH = 4
SEQ = 4096
DEPTH = 2
DEC_BATCH = 8
DEC_SEQ = 16
PAST_LEN = 2048

CHUNK = 64
N_META = 16
N_A = DEPTH // 2
N_B = DEPTH - N_A
RW_HEAD = 64
RW_HEADS = D_MODEL // RW_HEAD
LORA_W = 64
LORA_A = 64
LORA_G = 160
GN_EPS = 64e-5
HEAD_DIM = 64
N_HEADS = D_MODEL // (2 * HEAD_DIM)
V_DIM = 2 * HEAD_DIM
ROPE_DIM = HEAD_DIM // 4
ROPE_THETA = 500000.0
SUBLN_EPS = 1e-5
Q_BLOCK = 128
NEG_INF = -1e30
D_FF = 2816
NORM_EPS = 1e-6

kernel_name = 'yoco_rwkv7_diffattn_streaming_step'


def rmsnorm(x, g, eps=NORM_EPS):
    xf = x.astype(jnp.float32)
    y = xf * lax.rsqrt(jnp.mean(xf * xf, axis=-1, keepdims=True) + eps)
    return (y * g.astype(jnp.float32)).astype(x.dtype)


def swiglu(x, w_gate, w_up, w_down):
    return (jax.nn.silu(x @ w_gate) * (x @ w_up)) @ w_down


def rope(x, pos):
    half = ROPE_DIM // 2
    inv = jnp.power(jnp.float32(ROPE_THETA), -jnp.arange(0, ROPE_DIM, 2, dtype=jnp.float32) / ROPE_DIM)
    ang = pos.astype(jnp.float32)[:, None] * inv[None, :]
    cos = jnp.cos(ang)[None, :, None, None, :]
    sin = jnp.sin(ang)[None, :, None, None, :]
    x1 = x[..., :half].astype(jnp.float32)
    x2 = x[..., half:ROPE_DIM].astype(jnp.float32)
    rot = jnp.concatenate([x1 * cos - x2 * sin, x2 * cos + x1 * sin], axis=-1)
    return jnp.concatenate([rot.astype(x.dtype), x[..., ROPE_DIM:]], axis=-1)


def _wkv7_step(S, inp):
    r_t, w_t, k_t, v_t, a_t, b_t = inp
    sa = jnp.einsum('bhvk,bhk->bhv', S, a_t)
    S = S * w_t[:, :, None, :] + sa[..., None] * b_t[:, :, None, :] + v_t[..., None] * k_t[:, :, None, :]
    y = jnp.einsum('bhvk,bhk->bhv', S, r_t)
    return S, y


def rwkv7_time_mix(x, shift_prev, S0, P, i):
    B, T, C = x.shape
    H, N = RW_HEADS, RW_HEAD
    f32 = jnp.float32
    dt = x.dtype
    x_prev = jnp.concatenate([shift_prev[:, None, :].astype(dt), x[:, :-1]], axis=1)
    xx = x_prev - x
    mu = P['rw_mu'][i]
    xr, xw, xk, xv, xa, xg = (x + xx * mu[m] for m in range(6))
    r = xr @ P['rw_w_r'][i]
    k = xk @ P['rw_w_k'][i]
    v = xv @ P['rw_w_v'][i]
    w_log = -jax.nn.softplus(-(P['rw_w0'][i] + jnp.tanh(xw @ P['rw_w1'][i]) @ P['rw_w2'][i])) - 0.5
    decay = jnp.exp(-jnp.exp(w_log.astype(f32)))
    a = jax.nn.sigmoid(P['rw_a0'][i] + (xa @ P['rw_a1'][i]) @ P['rw_a2'][i])
    g = jax.nn.sigmoid(xg @ P['rw_g1'][i]) @ P['rw_g2'][i]
    kk = (k * P['rw_k_k'][i]).reshape(B, T, H, N).astype(f32)
    kk = kk / jnp.maximum(jnp.linalg.norm(kk, axis=-1, keepdims=True), 1e-12)
    k = k * (1 + (a - 1) * P['rw_k_a'][i])
    heads = lambda z: z.reshape(B, T, H, N).astype(f32)
    r_h, k_h, v_h, a_h = heads(r), heads(k), heads(v), heads(a)
    w_h = decay.reshape(B, T, H, N)
    seq = tuple(jnp.moveaxis(z, 1, 0) for z in (r_h, w_h, k_h, v_h, -kk, kk * a_h))
    S_T, ys = lax.scan(_wkv7_step, S0.astype(f32), seq)
    y = jnp.moveaxis(ys, 0, 1)
    mean = jnp.mean(y, axis=-1, keepdims=True)
    var = jnp.mean(jnp.square(y - mean), axis=-1, keepdims=True)
    y = ((y - mean) * lax.rsqrt(var + GN_EPS)).reshape(B, T, C)
    y = y * P['rw_gn_g'][i].astype(f32) + P['rw_gn_b'][i].astype(f32)
    bonus = jnp.sum(r_h * k_h * P['rw_r_k'][i].astype(f32), axis=-1, keepdims=True) * v_h
    y = (y + bonus.reshape(B, T, C)).astype(dt)
    out = (y * g) @ P['rw_w_o'][i]
    return out, x[:, -1], S_T.astype(S0.dtype)


def diff_softmax_attn(q, k, v, lam, mask):
    s = jnp.einsum('bqhcd,bkhcd->bhcqk', q, k).astype(jnp.float32) * (HEAD_DIM ** -0.5)
    if mask is not None:
        s = jnp.where(mask, s, NEG_INF)
    p = jax.nn.softmax(s, axis=-1)
    pd = p[:, :, 0] - lam * p[:, :, 1]
    return jnp.einsum('bhqk,bkhe->bqhe', pd.astype(v.dtype), v)


def attend_prompt(q, k, v, lam):
    B = q.shape[0]
    n_frames = q.shape[1] - N_META
    o_meta = diff_softmax_attn(q[:, :N_META], k[:, :N_META], v[:, :N_META], lam, None)
    key_idx = jnp.arange(k.shape[1])
    key_cid = jnp.where(key_idx < N_META, -1, (key_idx - N_META) // CHUNK)
    n_blk = n_frames // Q_BLOCK
    qb = jnp.swapaxes(q[:, N_META:].reshape(B, n_blk, Q_BLOCK, N_HEADS, 2, HEAD_DIM), 0, 1)

    def blk(args):
        q_blk, b = args
        q_cid = (b * Q_BLOCK + jnp.arange(Q_BLOCK)) // CHUNK
        mask = key_cid[None, :] <= q_cid[:, None]
        return diff_softmax_attn(q_blk, k, v, lam, mask)

    o_frames = lax.map(blk, (qb, jnp.arange(n_blk)))
    o_frames = jnp.swapaxes(o_frames, 0, 1).reshape(B, n_frames, N_HEADS, V_DIM)
    return jnp.concatenate([o_meta, o_frames], axis=1)


def attend_sample(q, k, v, lam):
    return diff_softmax_attn(q, k, v, lam, None)


def shared_kv(h, pos, P):
    B, T, _ = h.shape
    hn = rmsnorm(h, P['kv_norm'])
    k = rope((hn @ P['w_k']).reshape(B, T, N_HEADS, 2, HEAD_DIM), pos)
    v = (hn @ P['w_v']).reshape(B, T, N_HEADS, V_DIM)
    return k, v


def diff_attn_layer(h, pos, k_all, v_all, attend, P, li):
    j = li - N_A
    B, T, _ = h.shape
    q = rope((h @ P['b_w_q'][j]).reshape(B, T, N_HEADS, 2, HEAD_DIM), pos)
    lam_init = 0.8 - 0.6 * math.exp(-0.3 * li)
    lp = P['b_lambda'][j].astype(jnp.float32)
    lam = jnp.exp(jnp.sum(lp[0] * lp[1])) - jnp.exp(jnp.sum(lp[2] * lp[3])) + lam_init
    o = attend(q, k_all, v_all, lam)
    o = rmsnorm(o, P['b_subln'][j], SUBLN_EPS) * (1.0 - lam_init)
    return o.reshape(B, T, N_HEADS * V_DIM) @ P['b_w_o'][j]


def trunk(x, pos, shift0, wkv0, extend_kv, attend, P):
    shifts, wkvs = [], []
    k_new = v_new = k_all = v_all = None
    for li in range(DEPTH):
        if li == N_A:
            k_new, v_new = shared_kv(x, pos, P)
            k_all, v_all = extend_kv(k_new, v_new)
        x = x + 0.5 * swiglu(rmsnorm(x, P['norm_ffn'][li, 0]), P['ffn_w_gate'][li, 0], P['ffn_w_up'][li, 0], P['ffn_w_down'][li, 0])
        h = rmsnorm(x, P['norm_mix'][li])
        if li < N_A:
            y, s_last, S = rwkv7_time_mix(h, shift0[:, li], wkv0[:, li], P, li)
            shifts.append(s_last)
            wkvs.append(S)
        else:
            y = diff_attn_layer(h, pos, k_all, v_all, attend, P, li)
        x = x + y
        x = x + 0.5 * swiglu(rmsnorm(x, P['norm_ffn'][li, 1]), P['ffn_w_gate'][li, 1], P['ffn_w_up'][li, 1], P['ffn_w_down'][li, 1])
    return x, jnp.stack(shifts, axis=1), jnp.stack(wkvs, axis=1), k_new, v_new


def setup_inputs(seed: int = 0) -> dict:
    key = jax.random.key(seed)
    ks = iter(jax.random.split(key, 64))
    f32 = jnp.float32
    nrm = lambda shape, scale: jax.random.normal(next(ks), shape, f32) * scale
    D = D_MODEL
    HK = N_HEADS * 2 * HEAD_DIM
    HV = N_HEADS * V_DIM
    T_c = N_META + PAST_LEN
    return {
        'x_prompt': nrm((BATCH, SEQ, D), 1.0),
        'x_sample': nrm((DEC_BATCH, DEC_SEQ, D), 1.0),
        'cache_k': nrm((DEC_BATCH, T_c, N_HEADS, 2 * HEAD_DIM), 1.0),
        'cache_v': nrm((DEC_BATCH, T_c, N_HEADS, V_DIM), 1.0),
        'state_wkv': nrm((DEC_BATCH, N_A, RW_HEADS, RW_HEAD, RW_HEAD), 0.1),
        'state_shift': nrm((DEC_BATCH, N_A, D), 1.0),
        'meta_tokens': nrm((N_META, D), 1.0),
        'norm_ffn': 1.0 + nrm((DEPTH, 2, D), 0.02),
        'norm_mix': 1.0 + nrm((DEPTH, D), 0.02),
        'ffn_w_gate': nrm((DEPTH, 2, D, D_FF), D ** -0.5),
        'ffn_w_up': nrm((DEPTH, 2, D, D_FF), D ** -0.5),
        'ffn_w_down': nrm((DEPTH, 2, D_FF, D), D_FF ** -0.5),
        'rw_mu': jax.random.uniform(next(ks), (N_A, 6, D), f32, 0.0, 1.0),
        'rw_w_r': nrm((N_A, D, D), D ** -0.5),
        'rw_w_k': nrm((N_A, D, D), D ** -0.5),
        'rw_w_v': nrm((N_A, D, D), D ** -0.5),
        'rw_w_o': nrm((N_A, D, D), D ** -0.5),
        'rw_w0': -0.5 + nrm((N_A, D), 1.0),
        'rw_w1': nrm((N_A, D, LORA_W), D ** -0.5),
        'rw_w2': nrm((N_A, LORA_W, D), LORA_W ** -0.5),
        'rw_a0': nrm((N_A, D), 0.1),
        'rw_a1': nrm((N_A, D, LORA_A), D ** -0.5),
        'rw_a2': nrm((N_A, LORA_A, D), LORA_A ** -0.5),
        'rw_g1': nrm((N_A, D, LORA_G), D ** -0.5),
        'rw_g2': nrm((N_A, LORA_G, D), LORA_G ** -0.5),
        'rw_k_k': 0.85 + nrm((N_A, D), 0.02),
        'rw_k_a': 1.0 + nrm((N_A, D), 0.02),
        'rw_r_k': nrm((N_A, RW_HEADS, RW_HEAD), 0.1),
        'rw_gn_g': 1.0 + nrm((N_A, D), 0.02),
        'rw_gn_b': nrm((N_A, D), 0.02),
        'kv_norm': 1.0 + nrm((D,), 0.02),
        'w_k': nrm((D, HK), D ** -0.5),
        'w_v': nrm((D, HV), D ** -0.5),
        'b_w_q': nrm((N_B, D, HK), D ** -0.5),
        'b_w_o': nrm((N_B, HV, D), HV ** -0.5),
        'b_lambda': nrm((N_B, 4, HEAD_DIM), 0.1),
        'b_subln': 1.0 + nrm((N_B, V_DIM), 0.02),
        'final_norm': 1.0 + nrm((D,), 0.02),
    }


def reference(x_prompt, x_sample, cache_k, cache_v, state_wkv, state_shift, meta_tokens,
              norm_ffn, norm_mix, ffn_w_gate, ffn_w_up, ffn_w_down,
              rw_mu, rw_w_r, rw_w_k, rw_w_v, rw_w_o, rw_w0, rw_w1, rw_w2,
              rw_a0, rw_a1, rw_a2, rw_g1, rw_g2, rw_k_k, rw_k_a, rw_r_k, rw_gn_g, rw_gn_b,
              kv_norm, w_k, w_v, b_w_q, b_w_o, b_lambda, b_subln, final_norm):
    P = dict(norm_ffn=norm_ffn, norm_mix=norm_mix, ffn_w_gate=ffn_w_gate, ffn_w_up=ffn_w_up,
             ffn_w_down=ffn_w_down, rw_mu=rw_mu, rw_w_r=rw_w_r, rw_w_k=rw_w_k, rw_w_v=rw_w_v,
             rw_w_o=rw_w_o, rw_w0=rw_w0, rw_w1=rw_w1, rw_w2=rw_w2, rw_a0=rw_a0, rw_a1=rw_a1,
             rw_a2=rw_a2, rw_g1=rw_g1, rw_g2=rw_g2, rw_k_k=rw_k_k, rw_k_a=rw_k_a, rw_r_k=rw_r_k,
             rw_gn_g=rw_gn_g, rw_gn_b=rw_gn_b, kv_norm=kv_norm, w_k=w_k, w_v=w_v, b_w_q=b_w_q,
             b_w_o=b_w_o, b_lambda=b_lambda, b_subln=b_subln)

    Bp, Tp = x_prompt.shape[0], x_prompt.shape[1]
    meta = jnp.broadcast_to(meta_tokens[None].astype(x_prompt.dtype), (Bp, N_META, D_MODEL))
    xp = jnp.concatenate([meta, x_prompt], axis=1)
    pos_p = jnp.arange(N_META + Tp)
    shift0_p = jnp.zeros((Bp, N_A, D_MODEL), x_prompt.dtype)
    wkv0_p = jnp.zeros((Bp, N_A, RW_HEADS, RW_HEAD, RW_HEAD), state_wkv.dtype)
    hp, shift_p, wkv_p, k_p, v_p = trunk(xp, pos_p, shift0_p, wkv0_p, lambda kn, vn: (kn, vn), attend_prompt, P)
    y_prompt = rmsnorm(hp[:, N_META:], final_norm)

    Bd, Ts = x_sample.shape[0], x_sample.shape[1]
    past = cache_k.shape[1] - N_META
    pos_s = N_META + past + jnp.arange(Ts)

    def extend_sample(kn, vn):
        k_all = jnp.concatenate([cache_k.reshape(Bd, -1, N_HEADS, 2, HEAD_DIM).astype(kn.dtype), kn], axis=1)
        v_all = jnp.concatenate([cache_v.astype(vn.dtype), vn], axis=1)
        return k_all, v_all

    hs, shift_s, wkv_s, k_s, v_s = trunk(x_sample, pos_s, state_shift, state_wkv, extend_sample, attend_sample, P)
    y_sample = rmsnorm(hs, final_norm)

    new_cache_k_p = k_p.reshape(Bp, N_META + Tp, N_HEADS, 2 * HEAD_DIM)
    new_cache_v_p = v_p
    new_cache_k_s = k_s.reshape(Bd, Ts, N_HEADS, 2 * HEAD_DIM)
    new_cache_v_s = v_s
    return (y_prompt, y_sample, wkv_p, shift_p, new_cache_k_p, new_cache_v_p, wkv_s, shift_s, new_cache_k_s, new_cache_v_s)
```

```cpp
#define MK_PER_PHASE 1

#include <hip/hip_runtime.h>
#include <hip/hip_bf16.h>
#include <cstdio>
#include <cstdint>
#include <cmath>

constexpr int D = 1024, FF = 2816, NGU = 2 * FF;
constexpr int NTM = 65, MP = NTM * 256;
constexpr int ROW_S = 16384, ROW_M = 16512, ROW_END = 16576;
constexpr size_t O_YP = 0, O_YS = 16777216, O_WKVP = 16908288, O_SHP = 17170432, O_CKP = 17174528, O_CVP = 34017280, O_WKVS = 50860032, O_SHS = 51384320, O_CKS = 51392512, O_CVS = 51523584, O_END = 51654656;
constexpr size_t MiB = 1u << 20;
constexpr size_t WS_CTL = 0, CTL_ZERO_BYTES = 1 * MiB;
constexpr size_t WS_XEXTRA = 1 * MiB;
constexpr size_t WS_ROPE = 1 * MiB + 512 * 1024;
constexpr size_t WS_MISC = 2 * MiB;
constexpr size_t WS_KMETA = 3 * MiB, WS_VMETA = 4 * MiB;
constexpr size_t WS_W = 8 * MiB;
constexpr size_t W_GU = WS_W, W_D = W_GU + 44 * MiB, W_RKVL = W_D + 22 * MiB, W_ORW = W_RKVL + 7 * MiB + 512 * 1024, W_LU = W_ORW + 2 * MiB, W_KV = W_LU + 1 * MiB + 512 * 1024, W_Q = W_KV + 4 * MiB, W_OAT = W_Q + 2 * MiB, W_END = W_OAT + 2 * MiB;
static_assert(W_END == 93 * MiB, "weight map");
constexpr size_t WS_U = 96 * MiB;
constexpr size_t S1 = (size_t)MP * 1024 * 2;
constexpr size_t U_XN = WS_U, U_H = WS_U + S1;
constexpr size_t U_A6 = WS_U, U_LOR = WS_U + 6 * S1;
constexpr size_t U_LOGW = WS_U, U_ASIG = WS_U + 2 * S1, U_G = WS_U + 3 * S1, U_YG = WS_U + 4 * S1;
constexpr size_t U_HNKV = WS_U + 4 * S1, U_KB = WS_U + 5 * S1, U_VB = WS_U + 6 * S1;
constexpr size_t U_HN1 = WS_U + 4 * S1, U_QB = WS_U, U_O1 = WS_U + S1, U_O2 = WS_U + 2 * S1, U_OA = WS_U + 3 * S1;
constexpr size_t WS_END = WS_U + 7 * S1;
static_assert(U_H + (size_t)MP * FF * 2 <= U_HNKV, "H overlay");
static_assert(U_LOR + 3 * (size_t)MP * 256 * 2 <= WS_END, "lora overlay");

__device__ __forceinline__ float* xrow_ptr(float* dout, float* xextra, int r) { return r < ROW_M ? dout + (size_t)r * D : xextra + (size_t)(r - ROW_M) * D; }


__device__ __forceinline__ const float* in_ptr(int i) {
    auto kp = (const float* const __attribute__((address_space(4)))*)__builtin_amdgcn_kernarg_segment_ptr();
    asm volatile("" : "+s"(kp));
    return kp[i];
}

namespace pg8 {
#define PG8_LAS __attribute__((address_space(3)))
typedef unsigned short bf16_t;
typedef short bf16x8 __attribute__((ext_vector_type(8)));
typedef float f32x4 __attribute__((ext_vector_type(4)));
typedef unsigned u32x4 __attribute__((ext_vector_type(4)));
constexpr int BM = 256, BK = 64, HALF = 128, HTB = HALF * BK * 2  , STAGE_BYTES = 8 * HTB, NXCD = 8, WGM = 8;

__host__ __device__ __forceinline__ int lds_byte(int r, int c) { const int st = (r >> 4) * 2 + (c >> 5), rr = r & 15, cc = c & 31, ob = rr * 64 + cc * 2; return st * 1024 + (ob ^ (((ob >> 9) & 1) << 5)); }
__host__ __device__ __forceinline__ void stage_rc(int b, int& R, int& C) { const int st = b / 1024, sb = b % 1024, swz = sb ^ (((sb >> 9) & 1) << 5); R = (st >> 1) * 16 + swz / 64; C = (st & 1) * 32 + (swz % 64) / 2; }
__host__ __device__ __forceinline__ int perm32(int rho) { const int n = rho >> 4, i = rho & 15; return 8 * (i >> 2) + 4 * n + (i & 3); }

struct Unit { int pm, pn; };
struct Gemm { const bf16_t* A; const bf16_t* Bt; int M, N, K; };

struct StaticOrder {
    int nM, nN, nwg, G, c;
    __host__ __device__ void init(int M, int N, int G_, int c_) { nM = M / BM; nN = N / BM; nwg = nM * nN; G = G_; c = c_; }
    __host__ __device__ bool next(int i, Unit& u) const {
        const long L = (long)i * G + c; if (L >= nwg) return false;
        int wgid = (int)L; { const int q = nwg / NXCD, r = nwg % NXCD, xcd = wgid % NXCD, off = wgid / NXCD; wgid = (xcd < r ? xcd * (q + 1) : r * (q + 1) + (xcd - r) * q) + off; }
        const int nig = WGM * nN, gid = wgid / nig, fm = gid * WGM, gsz = (nM - fm) < WGM ? (nM - fm) : WGM;
        u.pm = fm + ((wgid % nig) % gsz); u.pn = (wgid % nig) / gsz; return true;
    }
    __device__ __forceinline__ void a_ready(const Unit&) const {}
    __device__ __forceinline__ void done(const Unit&) const {}
};

typedef float f32x2 __attribute__((ext_vector_type(2)));
typedef __bf16 bf16x2_cv __attribute__((ext_vector_type(2)));
__device__ __forceinline__ unsigned cvt_pk_bf16(float lo, float hi) { const f32x2 v = {lo, hi}; const bf16x2_cv b = __builtin_convertvector(v, bf16x2_cv); return __builtin_bit_cast(unsigned, b); }

template <int nN, int mode> struct GSched {
    int G, c;
    __device__ __forceinline__ void init(int G_, int c_) { G = G_; c = c_; }
    __device__ __forceinline__ bool next(int i, Unit& u) const {
        const int nM = NTM, nwg = nM * nN;
        const long L = (long)i * G + c; if (L >= nwg) return false;
        int wgid = (int)L; { const int q = nwg / NXCD, r = nwg % NXCD, xcd = wgid % NXCD, off = wgid / NXCD; wgid = (xcd < r ? xcd * (q + 1) : r * (q + 1) + (xcd - r) * q) + off; }
        const int nig = WGM * nN, gid = wgid / nig, fm = gid * WGM, gsz = (nM - fm) < WGM ? (nM - fm) : WGM;
        const int pm = fm + ((wgid % nig) % gsz), ct = (wgid % nig) / gsz;
        int g = 0;
        if (mode == 1) g = (ct < 12) ? (ct >> 2) : (ct - 9); else if (mode == 2) g = ct >> 2;
        u.pm = pm + g * nM; u.pn = ct; return true;
    }
    __device__ __forceinline__ void a_ready(const Unit&) const {}
    __device__ __forceinline__ void done(const Unit&) const {}
};

__device__ __forceinline__ float fast_sigmoid(float x) { return __builtin_amdgcn_rcpf(1.0f + __expf(-x)); }
__device__ __forceinline__ float fast_tanh(float x) { return 1.0f - 2.0f * __builtin_amdgcn_rcpf(__expf(2.0f * x) + 1.0f); }
typedef unsigned u32x2 __attribute__((ext_vector_type(2)));


enum { ET_SWIGLU = 0, ET_P4 = 1 };
template <int kind> struct EpiT {
    static constexpr bool PERM = true, AFTER_DRAIN = false;
    float scale; float* dout; unsigned char* ws; const float* pa; const float* pb;
    __device__ __forceinline__ void operator()(const f32x4 (&acc)[2][2][4][2], const Unit& u, int wr, int wc, int fr, int fq) const {
        if constexpr (kind == ET_SWIGLU) {
            bf16_t* O0 = (bf16_t*)(ws + U_H);
            const int row0 = u.pm * BM + wr * 64 + fr, hcol0 = (u.pn * BM + wc * 32 + 8 * fq) >> 1;
#pragma unroll
            for (int ai = 0; ai < 2; ++ai)
#pragma unroll
                for (int m = 0; m < 4; ++m) { bf16_t* rowp = O0 + (size_t)(row0 + ai * HALF + m * 16) * FF + hcol0;
#pragma unroll
                    for (int bj = 0; bj < 2; ++bj) { const f32x4 gt = acc[ai][bj][m][0], up = acc[ai][bj][m][1]; f32x4 h;
#pragma unroll
                        for (int e = 0; e < 4; ++e) h[e] = gt[e] * fast_sigmoid(gt[e]) * up[e];
                        u32x2 w; w.x = cvt_pk_bf16(h[0], h[1]); w.y = cvt_pk_bf16(h[2], h[3]);
                        *(u32x2*)(rowp + bj * (HALF / 2)) = w; } }
        } else {
            bf16_t* O0 = (bf16_t*)(dout + O_CKP); bf16_t* O1 = (bf16_t*)(ws + U_LOR);
            const int pn = u.pn; int g, pnl; if (pn < 12) { g = pn >> 2; pnl = pn & 3; } else { g = pn - 9; pnl = 0; }
            const int pml = u.pm - NTM * g, row0 = pml * BM + wr * 64 + fr, col0 = pnl * BM + wc * 32 + 8 * fq;
            bf16_t* base; int ldc, act;
            if (g < 3) { base = O0 + (size_t)g * MP * 1024; ldc = 1024; act = 0; } else { base = O1 + (size_t)(g - 3) * MP * 256; ldc = 256; act = (g == 3) ? 1 : ((g == 5) ? 2 : 0); }
#pragma unroll
            for (int ai = 0; ai < 2; ++ai)
#pragma unroll
                for (int m = 0; m < 4; ++m) { bf16_t* rowp = base + (size_t)(row0 + ai * HALF + m * 16) * ldc + col0;
#pragma unroll
                    for (int bj = 0; bj < 2; ++bj) { f32x4 v0 = acc[ai][bj][m][0], v1 = acc[ai][bj][m][1];
                        if (act == 1) {
#pragma unroll
                            for (int e = 0; e < 4; ++e) { v0[e] = fast_tanh(v0[e]); v1[e] = fast_tanh(v1[e]); } }
                        else if (act == 2) {
#pragma unroll
                            for (int e = 0; e < 4; ++e) { v0[e] = fast_sigmoid(v0[e]); v1[e] = fast_sigmoid(v1[e]); } }
                        u32x4 w; w.x = cvt_pk_bf16(v0[0], v0[1]); w.y = cvt_pk_bf16(v0[2], v0[3]); w.z = cvt_pk_bf16(v1[0], v1[1]); w.w = cvt_pk_bf16(v1[2], v1[3]);
                        *(u32x4*)(rowp + bj * HALF) = w; } }
        }
    }
};

enum { EF_RESID = 0, EF_P5 = 1, EF_KV = 2, EF_Q = 3 };
template <int kind> struct EpiF {
    static constexpr bool PERM = false, AFTER_DRAIN = false;
    float scale;
    float* dout; unsigned char* ws; const float* pa; const float* pb;
    __device__ __forceinline__ void operator()(const f32x4 (&acc)[2][2][4][2], const Unit& u, int wr, int wc, int fr, int fq) const {
        float* xextra = (float*)(ws + WS_XEXTRA);
        if constexpr (kind == EF_RESID) {
            const int row0 = u.pm * BM + wr * 64 + fr, col0 = u.pn * BM + wc * 32 + 4 * fq;
#pragma unroll
            for (int ai = 0; ai < 2; ++ai)
#pragma unroll
                for (int m = 0; m < 4; ++m) { float* rowp = xrow_ptr(dout, xextra, row0 + ai * HALF + m * 16) + col0;
#pragma unroll
                    for (int bj = 0; bj < 2; ++bj)
#pragma unroll
                        for (int n = 0; n < 2; ++n) { f32x4* p = (f32x4*)(rowp + bj * HALF + n * 16); const f32x4 x = *p; *p = x + acc[ai][bj][m][n] * scale; } }
        } else if constexpr (kind == EF_P5) {
            const float* p0 = pa; const float* p1 = pb; float* f0 = (float*)(ws + U_LOGW); bf16_t* h0 = (bf16_t*)(ws + U_ASIG); bf16_t* h1 = (bf16_t*)(ws + U_G);
            const int g = u.pn >> 2, pnl = u.pn & 3, pml = u.pm - NTM * g, row0 = pml * BM + wr * 64 + fr, col0 = pnl * BM + wc * 32 + 4 * fq;
#pragma unroll
            for (int bj = 0; bj < 2; ++bj)
#pragma unroll
                for (int n = 0; n < 2; ++n) { const int c = col0 + bj * HALF + n * 16;
                    f32x4 bias = (f32x4){0.f, 0.f, 0.f, 0.f};
#ifndef PROBE_NO_BIAS
                    if (g == 0) bias = *(const f32x4*)(p0 + c); else if (g == 1) bias = *(const f32x4*)(p1 + c);
#endif
#pragma unroll
                    for (int ai = 0; ai < 2; ++ai)
#pragma unroll
                        for (int m = 0; m < 4; ++m) { const size_t off = (size_t)(row0 + ai * HALF + m * 16) * 1024 + c; const f32x4 v = acc[ai][bj][m][n] + bias;
                            if (g == 0) { f32x4 o;
#pragma unroll
                                for (int e = 0; e < 4; ++e) o[e] = -0.6065306597126334f * fast_sigmoid(v[e]);
                                *(f32x4*)(f0 + off) = o; }
                            else if (g == 1) { u32x2 w; w.x = cvt_pk_bf16(fast_sigmoid(v[0]), fast_sigmoid(v[1])); w.y = cvt_pk_bf16(fast_sigmoid(v[2]), fast_sigmoid(v[3])); *(u32x2*)(h0 + off) = w; }
                            else { u32x2 w; w.x = cvt_pk_bf16(v[0], v[1]); w.y = cvt_pk_bf16(v[2], v[3]); *(u32x2*)(h1 + off) = w; } } }
        } else {
            const bool isQ = (kind == EF_Q), isK = isQ || (u.pn < 4);
            const float* p0 = (const float*)(ws + WS_ROPE);
            bf16_t* h0 = (bf16_t*)(ws + (isQ ? U_QB : U_KB)); bf16_t* h1 = (bf16_t*)(ws + U_VB); bf16_t* h2 = (bf16_t*)(ws + WS_KMETA); bf16_t* h3 = (bf16_t*)(ws + WS_VMETA);
            const int colbase = (u.pn & 3) * BM + wc * 32 + 4 * fq;
            const bool ropew = isK && ((wc & 1) == 0);
#pragma unroll
            for (int ai = 0; ai < 2; ++ai)
#pragma unroll
                for (int m = 0; m < 4; ++m) {
                    const int row = u.pm * BM + ai * HALF + wr * 64 + m * 16 + fr;
                    int pos; float* fdst = nullptr; bf16_t* bdst = nullptr; bool valid = true;
                    if (row < ROW_S) { const int b = row >> 12, t = row & 4095; pos = 16 + t;
                        if (isQ) bdst = h0 + (size_t)row * 1024; else { fdst = dout + (isK ? O_CKP : O_CVP) + ((size_t)b * 4112 + 16 + t) * 1024; bdst = (isK ? h0 : h1) + (size_t)row * 1024; } }
                    else if (row < ROW_M) { const int i = row - ROW_S; pos = 2064 + (i & 15);
                        if (isQ) bdst = h0 + (size_t)row * 1024; else fdst = dout + (isK ? O_CKS : O_CVS) + (size_t)i * 1024; }
                    else if (row < ROW_END) { const int i = row - ROW_M, b = i >> 4, j = i & 15; pos = j;
                        if (isQ) bdst = h0 + (size_t)row * 1024; else { fdst = dout + (isK ? O_CKP : O_CVP) + ((size_t)b * 4112 + j) * 1024; bdst = (isK ? h2 : h3) + ((size_t)b * 128 + j) * 1024; } }
                    else { pos = 0; valid = false; }
                    f32x4 cs = (f32x4){1.f, 1.f, 1.f, 1.f}, sn = (f32x4){0.f, 0.f, 0.f, 0.f};
                    if (ropew) { cs = *(const f32x4*)(p0 + (size_t)pos * 16 + 4 * (fq & 1)); sn = *(const f32x4*)(p0 + (size_t)pos * 16 + 8 + 4 * (fq & 1)); }
#pragma unroll
                    for (int bj = 0; bj < 2; ++bj)
#pragma unroll
                        for (int n = 0; n < 2; ++n) { f32x4 v = acc[ai][bj][m][n];
                            if (n == 0 && ropew) { f32x4 pr;
#pragma unroll
                                for (int e = 0; e < 4; ++e) pr[e] = __shfl_xor(v[e], 32);
                                const float sg = (fq < 2) ? -1.f : 1.f;
#pragma unroll
                                for (int e = 0; e < 4; ++e) v[e] = v[e] * cs[e] + sg * pr[e] * sn[e]; }
                            if (isQ) v = v * scale;
                            const int c = colbase + bj * HALF + n * 16;
                            if (valid) { if (fdst) *(f32x4*)(fdst + c) = v;
                                if (bdst) { u32x2 w; w.x = cvt_pk_bf16(v[0], v[1]); w.y = cvt_pk_bf16(v[2], v[3]); *(u32x2*)(bdst + c) = w; } } }
                }
        }
    }
};
template <class Epi, class Sched, bool ALIGN_EPI = false, bool SP2 = false>
__device__ __forceinline__ void gemm_phase(PG8_LAS unsigned char* lds, const Gemm g, const Sched& S, const Epi& E) {
    const int tid = threadIdx.x, wid = __builtin_amdgcn_readfirstlane(tid >> 6), lane = tid & 63, wr = wid >> 2, wc = wid & 3, fr = lane & 15, fq = lane >> 4;
    const int K = g.K, nt = K / BK;
    unsigned voffA[2], voffB[2];
#pragma unroll
    for (int i = 0; i < 2; ++i) { int R, C; stage_rc(tid * 16 + i * 8192, R, C); const int Rb = Epi::PERM ? ((R & ~31) + perm32(R & 31)) : R;
        voffA[i] = (unsigned)(R * K + C) * 2u; voffB[i] = (unsigned)(Rb * K + C) * 2u; }
    const size_t kstep = (size_t)(BK * 2);
    const size_t hstep = (size_t)HALF * K * 2;
    const size_t tstep = 2 * hstep;
    const unsigned ldsw = (unsigned)wid * 1024u;
    const int aoff = lds_byte(wr * 64 + fr, fq * 8), boff = lds_byte(wc * 32 + fr, fq * 8);
#define PG8_SA(b, h) (((b) * 2 + (h)) * HTB)
#define PG8_SB(b, h) ((4 + (b) * 2 + (h)) * HTB)
#define PG8_STAGE(bufoff, gbase, voff) do { _Pragma("unroll") for (int _i = 0; _i < 2; ++_i) \
        __builtin_amdgcn_global_load_lds((const unsigned*)((const char*)(gbase) + (voff)[_i]), (PG8_LAS unsigned*)(lds + (bufoff) + ldsw + _i * 8192), 16, 0, 0); } while (0)
#define PG8_LDA(dst, b, h) do { _Pragma("unroll") for (int m = 0; m < 4; ++m) _Pragma("unroll") for (int k = 0; k < 2; ++k) dst[m][k] = *(const PG8_LAS bf16x8*)(lds + PG8_SA(b, h) + aoff + m * 2048 + k * 1024); } while (0)
#define PG8_LDB(dst, b, h) do { _Pragma("unroll") for (int n = 0; n < 2; ++n) _Pragma("unroll") for (int k = 0; k < 2; ++k) dst[n][k] = *(const PG8_LAS bf16x8*)(lds + PG8_SB(b, h) + boff + n * 2048 + k * 1024); } while (0)
#define PG8_MMA(ai, bj, At, Bt) do { __builtin_amdgcn_s_setprio(1); _Pragma("unroll") for (int m = 0; m < 4; ++m) _Pragma("unroll") for (int n = 0; n < 2; ++n) _Pragma("unroll") for (int k = 0; k < 2; ++k) \
        acc[ai][bj][m][n] = __builtin_amdgcn_mfma_f32_16x16x32_bf16(Bt[n][k], At[m][k], acc[ai][bj][m][n], 0, 0, 0); __builtin_amdgcn_s_setprio(0); } while (0)
#define PG8_WAIT_V(n) asm volatile("s_waitcnt vmcnt(" #n ")" ::: "memory")
#define PG8_WAIT_L(n) asm volatile("s_waitcnt lgkmcnt(" #n ")" ::: "memory")
#define PG8_BAR __builtin_amdgcn_s_barrier()
#define PG8_SCHED __builtin_amdgcn_sched_barrier(0)
    Unit cur, nxt; int ui = 0;
    if (!S.next(0, cur)) return;
    f32x4 acc[2][2][4][2];
#pragma unroll
    for (int a = 0; a < 2; ++a)
#pragma unroll
        for (int b = 0; b < 2; ++b)
#pragma unroll
            for (int m = 0; m < 4; ++m)
#pragma unroll
                for (int n = 0; n < 2; ++n) acc[a][b][m][n] = (f32x4){0.f, 0.f, 0.f, 0.f};
    bf16x8 At[4][2], B0[2][2], B1[2][2];
    const char* cA = (const char*)g.A + (size_t)cur.pm * tstep; const char* cB = (const char*)g.Bt + (size_t)cur.pn * tstep;
    S.a_ready(cur);
    if constexpr (SP2) {
        PG8_STAGE(PG8_SB(0, 0), cB, voffB); PG8_STAGE(PG8_SB(0, 1), cB + hstep, voffB); PG8_STAGE(PG8_SA(0, 0), cA, voffA); PG8_STAGE(PG8_SA(0, 1), cA + hstep, voffA);
        if (wr == 1) PG8_BAR;
        PG8_WAIT_V(2); PG8_BAR;
        PG8_STAGE(PG8_SB(1, 0), cB + kstep, voffB); PG8_STAGE(PG8_SA(1, 0), cA + kstep, voffA); PG8_STAGE(PG8_SB(1, 1), cB + hstep + kstep, voffB);
        PG8_WAIT_V(6); PG8_BAR;
    } else {
        PG8_STAGE(PG8_SB(0, 0), cB, voffB); PG8_STAGE(PG8_SA(0, 0), cA, voffA); PG8_STAGE(PG8_SB(0, 1), cB + hstep, voffB); PG8_STAGE(PG8_SA(0, 1), cA + hstep, voffA);
        if (wr == 1) PG8_BAR;
        PG8_WAIT_V(4); PG8_BAR;
        PG8_STAGE(PG8_SB(1, 0), cB + kstep, voffB); PG8_STAGE(PG8_SA(1, 0), cA + kstep, voffA); PG8_STAGE(PG8_SB(1, 1), cB + hstep + kstep, voffB);
        PG8_WAIT_V(6); PG8_BAR;
    }
    for (;;) {
        const bool has_next = S.next(ui + 1, nxt);
        const char* nA = has_next ? (const char*)g.A + (size_t)nxt.pm * tstep : cA; const char* nB = has_next ? (const char*)g.Bt + (size_t)nxt.pn * tstep : cB;
        for (int t = 0; t < nt; t += 2) {
            const bool last = (t == nt - 2);
            const char* a1 = cA + (size_t)(t + 1) * kstep;
            const char* a2 = last ? nA : cA + (size_t)(t + 2) * kstep; const char* b2 = last ? nB : cB + (size_t)(t + 2) * kstep;
            const char* a3 = a2 + kstep; const char* b3 = b2 + kstep;
            if (last && has_next) S.a_ready(nxt);
            if constexpr (SP2) {
            PG8_LDB(B0, 0, 0); PG8_LDB(B1, 0, 1); PG8_SCHED; PG8_LDA(At, 0, 0); PG8_STAGE(PG8_SA(1, 1), a1 + hstep, voffA);
            PG8_WAIT_V(8); PG8_WAIT_L(0); PG8_BAR; PG8_MMA(0, 0, At, B0); PG8_MMA(0, 1, At, B1); PG8_BAR; PG8_SCHED;
            PG8_LDA(At, 0, 1); PG8_STAGE(PG8_SB(0, 0), b2, voffB); PG8_STAGE(PG8_SB(0, 1), b2 + hstep, voffB); PG8_STAGE(PG8_SA(0, 0), a2, voffA);
            PG8_WAIT_V(8); PG8_WAIT_L(0); PG8_BAR; PG8_MMA(1, 0, At, B0); PG8_MMA(1, 1, At, B1); PG8_BAR; PG8_SCHED;
            PG8_LDB(B0, 1, 0); PG8_LDB(B1, 1, 1); PG8_SCHED; PG8_LDA(At, 1, 0); PG8_STAGE(PG8_SA(0, 1), a2 + hstep, voffA);
            PG8_WAIT_V(8); PG8_WAIT_L(0); PG8_BAR; PG8_MMA(0, 0, At, B0); PG8_MMA(0, 1, At, B1); PG8_BAR; PG8_SCHED;
            PG8_LDA(At, 1, 1); PG8_STAGE(PG8_SB(1, 0), b3, voffB); PG8_STAGE(PG8_SB(1, 1), b3 + hstep, voffB); PG8_STAGE(PG8_SA(1, 0), a3, voffA);
            PG8_WAIT_V(8); PG8_WAIT_L(0); PG8_BAR; PG8_MMA(1, 0, At, B0); PG8_MMA(1, 1, At, B1); PG8_BAR; PG8_SCHED;
            } else {
            PG8_LDB(B0, 0, 0); PG8_SCHED; PG8_LDA(At, 0, 0); PG8_STAGE(PG8_SA(1, 1), a1 + hstep, voffA);
            PG8_WAIT_L(8); PG8_BAR; PG8_WAIT_L(0); PG8_MMA(0, 0, At, B0); PG8_BAR; PG8_SCHED;
            PG8_LDB(B1, 0, 1); PG8_STAGE(PG8_SB(0, 0), b2, voffB);
            PG8_BAR; PG8_WAIT_L(0); PG8_MMA(0, 1, At, B1); PG8_BAR;
            PG8_LDA(At, 0, 1); PG8_STAGE(PG8_SA(0, 0), a2, voffA);
            PG8_BAR; PG8_WAIT_L(0); PG8_MMA(1, 0, At, B0); PG8_BAR; PG8_SCHED;
            PG8_STAGE(PG8_SB(0, 1), b2 + hstep, voffB);
            PG8_WAIT_V(6); PG8_BAR; PG8_MMA(1, 1, At, B1); PG8_BAR;
            PG8_LDB(B0, 1, 0); PG8_SCHED; PG8_LDA(At, 1, 0); PG8_STAGE(PG8_SA(0, 1), a2 + hstep, voffA);
            PG8_WAIT_L(8); PG8_BAR; PG8_WAIT_L(0); PG8_MMA(0, 0, At, B0); PG8_BAR; PG8_SCHED;
            PG8_LDB(B1, 1, 1); PG8_STAGE(PG8_SB(1, 0), b3, voffB);
            PG8_BAR; PG8_WAIT_L(0); PG8_MMA(0, 1, At, B1); PG8_BAR;
            PG8_LDA(At, 1, 1); PG8_STAGE(PG8_SA(1, 0), a3, voffA);
            PG8_BAR; PG8_WAIT_L(0); PG8_MMA(1, 0, At, B0); PG8_BAR; PG8_SCHED;
            PG8_STAGE(PG8_SB(1, 1), b3 + hstep, voffB);
            PG8_WAIT_V(6); PG8_BAR; PG8_MMA(1, 1, At, B1); PG8_BAR;
            }
        }
        if constexpr (ALIGN_EPI) { if (wr == 0) PG8_BAR; }
        if constexpr (!Epi::AFTER_DRAIN) { E(acc, cur, wr, wc, fr, fq); S.done(cur); }
        if (!has_next) break;
#pragma unroll
        for (int a = 0; a < 2; ++a)
#pragma unroll
            for (int b = 0; b < 2; ++b)
#pragma unroll
                for (int m = 0; m < 4; ++m)
#pragma unroll
                    for (int n = 0; n < 2; ++n) acc[a][b][m][n] = (f32x4){0.f, 0.f, 0.f, 0.f};
        cur = nxt; cA = nA; cB = nB; ++ui;
        if constexpr (ALIGN_EPI) { if (wr == 1) PG8_BAR; }
    }
    PG8_WAIT_V(0);
    if constexpr (!ALIGN_EPI) { if (wr == 0) PG8_BAR; }
    PG8_BAR;
    if constexpr (Epi::AFTER_DRAIN) { E.fused(acc, cur, wr, wc, fr, fq, lds, wid, lane); S.done(cur); }
#undef PG8_SA
#undef PG8_SB
#undef PG8_STAGE
#undef PG8_LDA
#undef PG8_LDB
#undef PG8_MMA
#undef PG8_WAIT_V
#undef PG8_WAIT_L
#undef PG8_BAR
#undef PG8_SCHED
}
}
#include <hip/hip_bf16.h>
#include <cmath>
namespace attn_body {
using bf16=__hip_bfloat16;
using bf16x8=__attribute__((ext_vector_type(8)))short;
using s16x4=__attribute__((ext_vector_type(4)))short;
using f32x16=__attribute__((ext_vector_type(16)))float;
using u32x4=__attribute__((ext_vector_type(4)))unsigned;
constexpr int BATCH=4,NHEAD=16,SEQ=4096,D=64,DM=NHEAD*D;
constexpr int NW=8,QBLK=32,QB=QBLK*NW,KVBLK=64,NQB=SEQ/QB;
constexpr int ATTN_PITCH=DM, ATTN_UNIT_ROWS=QB;
__device__ __forceinline__ int crow(int r,int hi){return (r&3)+8*(r>>2)+4*hi;}
#define SBAR() __builtin_amdgcn_sched_barrier(0)
__device__ __forceinline__ void bmask(f32x16&p0,f32x16&p1,int jb,int wid,int hi){
  const float NEG=-INFINITY;
  const bool all=(jb<4)?(jb>(wid>>1)):(jb==5); const bool meta=(jb==4);
  const bool m0lo=all, m0hi=all||meta, m1=all||meta;
  #pragma unroll
  for(int r=0;r<8;++r)p0[r]=m0lo?NEG:p0[r];
  #pragma unroll
  for(int r=8;r<16;++r)p0[r]=m0hi?NEG:p0[r];
  #pragma unroll
  for(int r=0;r<16;++r)p1[r]=m1?NEG:p1[r];
}

constexpr int NSLOT=3, SLOTB=8192;
constexpr int LDS_K=0, LDS_V=NSLOT*SLOTB, LDS_WS=2*NSLOT*SLOTB, LDS_OST=LDS_WS+NW*64*4, LDS_BYTES=LDS_OST+NW*4096;
constexpr float C2=0.125f*1.4426950408889634f;
__device__ __forceinline__ void glds16(const void*gsrc,unsigned lds_dst){unsigned keep;
  asm volatile("s_mov_b32 %0, m0\n\ts_mov_b32 m0, %2\n\ts_nop 0\n\tglobal_load_lds_dwordx4 %1, off\n\ts_mov_b32 m0, %0":"=&s"(keep):"v"(gsrc),"s"(lds_dst):"memory");}
__device__ __forceinline__ float max3f(float a,float b,float c){float r;asm("v_max3_f32 %0, %1, %2, %3":"=v"(r):"v"(a),"v"(b),"v"(c));return r;}
__device__ __forceinline__ float max2f(float a,float b){float r;asm("v_max_f32_e32 %0, %1, %2":"=v"(r):"v"(a),"v"(b));return r;}
__device__ __forceinline__ float fadd_s(float a,float b){float r;asm("v_add_f32_e32 %0, %1, %2":"=v"(r):"v"(a),"v"(b));return r;}
__device__ __forceinline__ float fsub_s(float a,float b){float r;asm("v_sub_f32_e32 %0, %1, %2":"=v"(r):"v"(a),"v"(b));return r;}
typedef float f32x2_t __attribute__((ext_vector_type(2))); typedef __bf16 bf16x2_t __attribute__((ext_vector_type(2)));
__device__ __forceinline__ unsigned cvtpk_s(float lo,float hi){f32x2_t v={lo,hi};bf16x2_t b=__builtin_convertvector(v,bf16x2_t);return __builtin_bit_cast(unsigned,b);}
#define WAIT_BAR(N) asm volatile("s_waitcnt vmcnt(" #N ") lgkmcnt(0)\n\ts_barrier":::"memory")

__device__ __forceinline__ void qkt(f32x16&p0,f32x16&p1,const char*Kslot,const bf16x8*qr,const f32x16&negm,int r32,int hi){
  const char*kb=Kslot+hi*1024+r32*16;
  #pragma unroll
  for(int d0=0;d0<4;++d0){
    const bf16x8 b0=*reinterpret_cast<const bf16x8*>(kb+d0*2048);
    const bf16x8 b1=*reinterpret_cast<const bf16x8*>(kb+d0*2048+512);
    if(d0==0){p0=__builtin_amdgcn_mfma_f32_32x32x16_bf16(b0,qr[0],negm,0,0,0);p1=__builtin_amdgcn_mfma_f32_32x32x16_bf16(b1,qr[0],negm,0,0,0);}
    else{p0=__builtin_amdgcn_mfma_f32_32x32x16_bf16(b0,qr[d0],p0,0,0,0);p1=__builtin_amdgcn_mfma_f32_32x32x16_bf16(b1,qr[d0],p1,0,0,0);}}
}
typedef __attribute__((address_space(3))) const char* lds_cptr;
typedef short v4i16_t __attribute__((ext_vector_type(4)));
__device__ __forceinline__ void kload8(bf16x8*kf,lds_cptr kp){
  kf[0]=*(const __attribute__((address_space(3))) bf16x8*)(kp);      kf[1]=*(const __attribute__((address_space(3))) bf16x8*)(kp+512);
  kf[2]=*(const __attribute__((address_space(3))) bf16x8*)(kp+2048); kf[3]=*(const __attribute__((address_space(3))) bf16x8*)(kp+2560);
  kf[4]=*(const __attribute__((address_space(3))) bf16x8*)(kp+4096); kf[5]=*(const __attribute__((address_space(3))) bf16x8*)(kp+4608);
  kf[6]=*(const __attribute__((address_space(3))) bf16x8*)(kp+6144); kf[7]=*(const __attribute__((address_space(3))) bf16x8*)(kp+6656);
}
__device__ __forceinline__ void kload2(bf16x8*kf,lds_cptr kp,int j){ kf[2*j]=*(const __attribute__((address_space(3))) bf16x8*)(kp+j*2048); kf[2*j+1]=*(const __attribute__((address_space(3))) bf16x8*)(kp+j*2048+512); }
__device__ __forceinline__ s16x4 vtr(lds_cptr p){ return __builtin_bit_cast(s16x4,__builtin_amdgcn_ds_read_tr16_b64_v4i16((__attribute__((address_space(3))) v4i16_t*)p)); }
__device__ __forceinline__ float rowmax(const f32x16&p0,const f32x16&p1){
  float a=max3f(p0[0],p0[1],p1[0]),b=max3f(p0[2],p0[3],p1[1]);a=max3f(a,p1[2],p1[3]);
  #pragma unroll
  for(int r=4;r<16;r+=4){a=max3f(a,p0[r],p0[r+1]);b=max3f(b,p0[r+2],p0[r+3]);a=max3f(a,p1[r],p1[r+1]);b=max3f(b,p1[r+2],p1[r+3]);}
  const float m=max2f(a,b);
  auto rr=__builtin_amdgcn_permlane32_swap(__float_as_uint(m),__float_as_uint(m),false,false);
  return max2f(__uint_as_float(rr[0]),__uint_as_float(rr[1]));
}
__device__ __forceinline__ void pv(f32x16*o,int vb,bf16x8 pa0,bf16x8 pa1,bf16x8 pa2,bf16x8 pa3){
  #pragma unroll
  for(int d0=0;d0<2;++d0){s16x4 lo[4],hi[4];
    #pragma unroll
    for(int ks=0;ks<4;++ks){
      asm volatile("ds_read_b64_tr_b16 %0,%1 offset:%c2":"=&v"(lo[ks]):"v"(vb),"i"(d0*4096+ks*1024):"memory");
      asm volatile("ds_read_b64_tr_b16 %0,%1 offset:%c2":"=&v"(hi[ks]):"v"(vb),"i"(d0*4096+ks*1024+512):"memory");}
    asm volatile("s_waitcnt lgkmcnt(0)":::"memory");SBAR();
    #define PK(k) (bf16x8){lo[k][0],lo[k][1],lo[k][2],lo[k][3],hi[k][0],hi[k][1],hi[k][2],hi[k][3]}
    o[d0]=__builtin_amdgcn_mfma_f32_32x32x16_bf16(pa0,PK(0),o[d0],0,0,0);
    o[d0]=__builtin_amdgcn_mfma_f32_32x32x16_bf16(pa1,PK(1),o[d0],0,0,0);
    o[d0]=__builtin_amdgcn_mfma_f32_32x32x16_bf16(pa2,PK(2),o[d0],0,0,0);
    o[d0]=__builtin_amdgcn_mfma_f32_32x32x16_bf16(pa3,PK(3),o[d0],0,0,0);
    #undef PK
  }
}

#ifndef ATTN_STORE16
#define ATTN_STORE16(p,v) (*(u32x4*)(p)=(v))
#endif
template<int THRL> __device__ __forceinline__ void attn_unit(int b,int h,int hv,int qb,const bf16*Q,const bf16*__restrict__ K,const bf16*__restrict__ V,const bf16*__restrict__ KM,const bf16*__restrict__ VM,bf16*O,char*shm){
  const int tid=threadIdx.x,lane=tid&63,r32=lane&31,hi=lane>>5; const int wid=__builtin_amdgcn_readfirstlane(tid>>6);
  const long rowbase=(long)b*SEQ; const int q0=qb*QB;
  const bf16*Qw=Q+(rowbase+q0+wid*QBLK)*DM+h*D;
  const bf16*Kh=K+rowbase*DM+h*D,*Vh=V+rowbase*DM+hv*D;
  const unsigned lds0=(unsigned)(uintptr_t)shm;
  float*wsf=(float*)(shm+LDS_WS)+wid*64;
  const bf16*ksrc=Kh+(long)lane*DM+wid*8;
  const bf16*vsrc=Vh+(long)(16*(wid&3)+(lane>>2))*DM+(wid>>2)*32+(lane&3)*8;
  const long dKm=(long)(KM-K)+((long)b*128-rowbase)*DM, dVm=(long)(VM-V)+((long)b*128-rowbase)*DM;
  const int NTF=(q0+QB)/KVBLK, NT=NTF+2;
  const unsigned kdst=lds0+LDS_K+wid*1024, vdst=lds0+LDS_V+wid*1024;
  #define DMA_K(t,slot) glds16(ksrc+(((t)<NTF)?(long)(t)*KVBLK*DM:dKm+(long)((t)-NTF)*KVBLK*DM),(unsigned)__builtin_amdgcn_readfirstlane(kdst+(slot)))
  #define DMA_V(t,slot) glds16(vsrc+(((t)<NTF)?(long)(t)*KVBLK*DM:dVm+(long)((t)-NTF)*KVBLK*DM),(unsigned)__builtin_amdgcn_readfirstlane(vdst+(slot)))
  const int vb0=(int)(lds0+LDS_V)+((lane>>4)&1)*32+(lane&3)*8+(4*hi+((lane&15)>>2))*64;
  const char*Kbase=shm+LDS_K; bf16x8 kf[8];
  const lds_cptr shm3=(lds_cptr)shm; const lds_cptr kp0=shm3+LDS_K+hi*1024+r32*16; const lds_cptr vp0=shm3+LDS_V+((lane>>4)&1)*32+(lane&3)*8+(4*hi+((lane&15)>>2))*64;
  DMA_K(0,0);DMA_V(0,0);DMA_K(1,SLOTB);
  bf16x8 qr[4];
  #pragma unroll
  for(int d0=0;d0<4;++d0)qr[d0]=*reinterpret_cast<const bf16x8*>(&Qw[(long)r32*DM+d0*16+hi*8]);
  float mhat=0.f,l_reg=0.f;f32x16 o[2];o[0]=f32x16{};o[1]=f32x16{};f32x16 negm=f32x16{};asm volatile("":"+v"(negm));
  #define CMASK(P0,P1,t) do{int jb_=(t)-(NT-6); if(jb_>=0)bmask(P0,P1,jb_,wid,hi);}while(0)
  bool resc=false;
  #define START(P0,P1) do{ const float rm=rowmax(P0,P1); resc=false; \
    { const float dl=rm; mhat=fadd_s(mhat,dl); \
      _Pragma("unroll") for(int r=0;r<16;++r){P0[r]=fsub_s(P0[r],dl);P1[r]=fsub_s(P1[r],dl);} \
      _Pragma("unroll") for(int r=0;r<16;++r)negm[r]=-mhat; asm volatile("":"+v"(negm)); } \
    _Pragma("unroll") for(int r=0;r<16;++r)P0[r]=__builtin_amdgcn_exp2f(P0[r]); }while(0)
  #define RESC() do{ if(resc){ asm volatile("s_waitcnt lgkmcnt(0)":::"memory"); \
      _Pragma("unroll") for(int d_=0;d_<2;++d_) _Pragma("unroll") for(int r=0;r<16;++r)o[d_][r]*=wsf[crow(r,hi)]; } }while(0)
  f32x16 pA0,pA1,pB0,pB1;
  int sl_prev=0,sl_cur=0,sl_next=SLOTB;
  #define ROT() do{sl_prev=sl_cur;sl_cur=sl_next;sl_next=(sl_next==(NSLOT-1)*SLOTB)?0:sl_next+SLOTB;}while(0)
  DMA_K(2,2*SLOTB);
  WAIT_BAR(3);
  qkt(pA0,pA1,Kbase,qr,negm,r32,hi);asm volatile("s_nop 15\n\ts_nop 7":"+v"(pA0),"+v"(pA1));CMASK(pA0,pA1,0);
  START(pA0,pA1);
  _Pragma("unroll") for(int r=0;r<16;++r)pA1[r]=__builtin_amdgcn_exp2f(pA1[r]);
  WAIT_BAR(0);
  DMA_K(3,0);DMA_V(1,SLOTB);
  ROT();
  kload8(kf,kp0+sl_cur);
  WAIT_BAR(2);
  s16x4 vlo[8],vhi[8]; u32x4 pw0,pw1,pw2,pw3;
  #define PKW(P,B) cvtpk_s(P[B],P[B+1])
  #define PAF(k) __builtin_bit_cast(bf16x8,pw##k)
  #define VFR(i) (bf16x8){vlo[i][0],vlo[i][1],vlo[i][2],vlo[i][3],vhi[i][0],vhi[i][1],vhi[i][2],vhi[i][3]}
  #define PIN(x) asm volatile("":"+v"(x))
  #define MX3(a,b,c) __builtin_fmaxf(__builtin_fmaxf((a),(b)),(c))
  #define GAPA(MF,A0,A1,A2,A3,W0,W1,PW) do{ MF; sacc+=A0; sacc+=A1; sacc+=A2; sacc+=A3; PIN(sacc); W0; W1; PIN(PW); SBAR(); }while(0)
  #define EX(v) __builtin_amdgcn_exp2f(v)
  #define GAPB(MF,X,B) do{ MF; X[B]=EX(X[B]); X[B+1]=EX(X[B+1]); X[B+2]=EX(X[B+2]); X[B+3]=EX(X[B+3]); PIN(X); SBAR(); }while(0)
  #define VRD(i) do{ vlo[i]=vtr(vp_+(((i)>>2)*4096+((i)&3)*1024)); vhi[i]=vtr(vp_+(((i)>>2)*4096+((i)&3)*1024+512)); }while(0)
  #define KRD(G,j) do{ if(G){ kload2(kf,kp0+sl_next,j); SBAR(); } }while(0)
  #define STEP(C0,C1,P0,P1,t,GK,GV,GL) do{ SBAR(); \
    const lds_cptr vp_=vp0+sl_prev; \
    VRD(0); SBAR(); float sacc=(P0[0]+P0[1]); \
    GAPA(C0=__builtin_amdgcn_mfma_f32_32x32x16_bf16(kf[0],qr[0],negm,0,0,0), P0[2],P0[3],P0[4],P0[5],     pw0[0]=PKW(P0,0), pw0[1]=PKW(P0,2), pw0); \
    VRD(4); SBAR(); GAPA(C1=__builtin_amdgcn_mfma_f32_32x32x16_bf16(kf[1],qr[0],negm,0,0,0), P0[6],P0[7],P0[8],P0[9],     pw0[2]=PKW(P0,4), pw0[3]=PKW(P0,6), pw0); \
    VRD(1); SBAR(); GAPA(C0=__builtin_amdgcn_mfma_f32_32x32x16_bf16(kf[2],qr[1],C0,0,0,0),   P0[10],P0[11],P0[12],P0[13], pw1[0]=PKW(P0,8), pw1[1]=PKW(P0,10), pw1); \
    VRD(5); SBAR(); GAPA(C1=__builtin_amdgcn_mfma_f32_32x32x16_bf16(kf[3],qr[1],C1,0,0,0),   P0[14],P0[15],P1[0],P1[1],   pw1[2]=PKW(P0,12),pw1[3]=PKW(P0,14), pw1); \
    VRD(2); SBAR(); GAPA(C0=__builtin_amdgcn_mfma_f32_32x32x16_bf16(kf[4],qr[2],C0,0,0,0),   P1[2],P1[3],P1[4],P1[5],     pw2[0]=PKW(P1,0), pw2[1]=PKW(P1,2), pw2); \
    VRD(6); SBAR(); GAPA(C1=__builtin_amdgcn_mfma_f32_32x32x16_bf16(kf[5],qr[2],C1,0,0,0),   P1[6],P1[7],P1[8],P1[9],     pw2[2]=PKW(P1,4), pw2[3]=PKW(P1,6), pw2); \
    VRD(3); SBAR(); GAPA(C0=__builtin_amdgcn_mfma_f32_32x32x16_bf16(kf[6],qr[3],C0,0,0,0),   P1[10],P1[11],P1[12],P1[13], pw3[0]=PKW(P1,8), pw3[1]=PKW(P1,10), pw3); \
    VRD(7); SBAR(); GAPA(C1=__builtin_amdgcn_mfma_f32_32x32x16_bf16(kf[7],qr[3],C1,0,0,0),   P1[14],P1[15],0.f,0.f,       pw3[2]=PKW(P1,12),pw3[3]=PKW(P1,14), pw3); \
    l_reg+=sacc; \
    if(GK){DMA_K((t)+3,sl_cur);} if(GV){DMA_V((t)+1,sl_next);} \
    CMASK(C0,C1,t); \
    { float a=MX3(C0[0],C0[1],C1[0]),b=MX3(C0[2],C0[3],C1[1]); a=MX3(a,C1[2],C1[3]); \
      _Pragma("unroll") for(int r=4;r<16;r+=4){a=MX3(a,C0[r],C0[r+1]);b=MX3(b,C0[r+2],C0[r+3]);a=MX3(a,C1[r],C1[r+1]);b=MX3(b,C1[r+2],C1[r+3]);} \
      float rm=__builtin_fmaxf(a,b); { auto rr=__builtin_amdgcn_permlane32_swap(__float_as_uint(rm),__float_as_uint(rm),false,false); rm=__builtin_fmaxf(__uint_as_float(rr[0]),__uint_as_float(rr[1])); } \
      resc=false; \
      if(__builtin_expect(__any(rm>(float)THRL),0)){ const float dl=__builtin_fmaxf(rm,0.f); mhat+=dl; \
        _Pragma("unroll") for(int r=0;r<16;++r){C0[r]-=dl;C1[r]-=dl;} \
        _Pragma("unroll") for(int r=0;r<16;++r)negm[r]=-mhat; asm volatile("":"+v"(negm)); \
        const float f=__builtin_amdgcn_exp2f(-dl); l_reg*=f; if(hi==0)wsf[r32]=f; resc=true; } } \
    SBAR(); \
    GAPB(o[0]=__builtin_amdgcn_mfma_f32_32x32x16_bf16(PAF(0),VFR(0),o[0],0,0,0), C0,0); \
    GAPB(o[1]=__builtin_amdgcn_mfma_f32_32x32x16_bf16(PAF(0),VFR(4),o[1],0,0,0), C0,4); \
    KRD(GL,0); GAPB(o[0]=__builtin_amdgcn_mfma_f32_32x32x16_bf16(PAF(1),VFR(1),o[0],0,0,0), C0,8); \
    KRD(GL,1); GAPB(o[1]=__builtin_amdgcn_mfma_f32_32x32x16_bf16(PAF(1),VFR(5),o[1],0,0,0), C0,12); \
    KRD(GL,2); GAPB(o[0]=__builtin_amdgcn_mfma_f32_32x32x16_bf16(PAF(2),VFR(2),o[0],0,0,0), C1,0); \
    KRD(GL,3); GAPB(o[1]=__builtin_amdgcn_mfma_f32_32x32x16_bf16(PAF(2),VFR(6),o[1],0,0,0), C1,4); \
    GAPB(o[0]=__builtin_amdgcn_mfma_f32_32x32x16_bf16(PAF(3),VFR(3),o[0],0,0,0), C1,8); \
    GAPB(o[1]=__builtin_amdgcn_mfma_f32_32x32x16_bf16(PAF(3),VFR(7),o[1],0,0,0), C1,12); \
    }while(0)
  int t=1;
  #undef CMASK
  #define CMASK(P0,P1,t) do{}while(0)
  for(;t+7<NT;t+=2){
    STEP(pB0,pB1,pA0,pA1,t,true,true,true);     WAIT_BAR(2); RESC(); ROT();
    STEP(pA0,pA1,pB0,pB1,t+1,true,true,true);   WAIT_BAR(2); RESC(); ROT();
  }
  #undef CMASK
  #define CMASK(P0,P1,t) do{int jb_=(t)-(NT-6); if(jb_>=0)bmask(P0,P1,jb_,wid,hi);}while(0)
  #define ENDW(tt) do{ if((tt)+3<NT){WAIT_BAR(2);} else if((tt)+2<NT){WAIT_BAR(1);} else {WAIT_BAR(0);} }while(0)
  for(;t+1<NT;t+=2){
    STEP(pB0,pB1,pA0,pA1,t,(t+3<NT),(t+1<NT),(t+1<NT));       ENDW(t);   RESC(); ROT();
    STEP(pA0,pA1,pB0,pB1,t+1,(t+4<NT),(t+2<NT),(t+2<NT));     ENDW(t+1); RESC(); ROT();
  }
  STEP(pB0,pB1,pA0,pA1,NT-1,false,false,false); RESC();
  { float sacc=pB0[0]+pB0[1]; _Pragma("unroll") for(int r=2;r<16;++r)sacc+=pB0[r]; _Pragma("unroll") for(int r=0;r<16;++r)sacc+=pB1[r]; l_reg+=sacc;
    pw0=(u32x4){PKW(pB0,0),PKW(pB0,2),PKW(pB0,4),PKW(pB0,6)};pw1=(u32x4){PKW(pB0,8),PKW(pB0,10),PKW(pB0,12),PKW(pB0,14)};pw2=(u32x4){PKW(pB1,0),PKW(pB1,2),PKW(pB1,4),PKW(pB1,6)};pw3=(u32x4){PKW(pB1,8),PKW(pB1,10),PKW(pB1,12),PKW(pB1,14)};
    SBAR(); pv(o,vb0+sl_cur,PAF(0),PAF(1),PAF(2),PAF(3)); }
  #undef PKW
  #undef PAF
  #undef VFR
  #undef PIN
  #undef MX3
  #undef GAPA
  #undef GAPB
  #undef EX
  #undef VRD
  #undef KRD
  #undef STEP
  #undef ENDW
  {auto rr=__builtin_amdgcn_permlane32_swap(__float_as_uint(l_reg),__float_as_uint(l_reg),false,false);l_reg=__uint_as_float(rr[0])+__uint_as_float(rr[1]);}
  if(hi==0)wsf[32+r32]=l_reg;asm volatile("s_waitcnt lgkmcnt(0)":::"memory");
  float rli[16];
  #pragma unroll
  for(int r=0;r<16;++r)rli[r]=__builtin_amdgcn_rcpf(wsf[32+crow(r,hi)]);
  bf16*Ow=O+(rowbase+q0+wid*QBLK)*DM+hv*D;
  { bf16*stg=(bf16*)(shm+LDS_OST)+wid*2048;
    #pragma unroll
    for(int r=0;r<16;++r){const int orow=crow(r,hi);
      #pragma unroll
      for(int d0=0;d0<2;++d0)stg[orow*64+d0*32+r32]=__float2bfloat16(o[d0][r]*rli[r]);}
    asm volatile("s_waitcnt lgkmcnt(0)":::"memory");
    #pragma unroll
    for(int i=0;i<4;++i){const int row=i*8+(lane>>3),ch=lane&7; const u32x4 v=*(const u32x4*)(stg+row*64+ch*8); ATTN_STORE16(Ow+(long)row*DM+ch*8,v);} }
  asm volatile("s_waitcnt lgkmcnt(0)\n\ts_barrier":::"memory");
  #undef DMA_K
  #undef DMA_V
  #undef CMASK
  #undef START
  #undef RESC
  #undef ROT
}
constexpr int ATTN_LDS_BYTES=LDS_BYTES;
#undef SBAR
#undef WAIT_BAR
}
#define GAS __attribute__((address_space(1)))
#define LAS __attribute__((address_space(3)))
typedef unsigned short bf16;
typedef unsigned v4u __attribute__((ext_vector_type(4)));
typedef float f32x4 __attribute__((ext_vector_type(4)));
typedef short bf16x8 __attribute__((ext_vector_type(8)));
typedef GAS unsigned gu32;
typedef GAS unsigned long long gu64;
#define RLX_AGENT __ATOMIC_RELAXED, __HIP_MEMORY_SCOPE_AGENT
#define LDS_WAIT() asm volatile("s_waitcnt lgkmcnt(0)" ::: "memory")
#define VM_WAIT() asm volatile("s_waitcnt vmcnt(0)" ::: "memory")
__device__ __forceinline__ unsigned long long rt() { return __builtin_amdgcn_s_memrealtime(); }
__device__ __forceinline__ unsigned f2bf(float f) { unsigned u = __builtin_bit_cast(unsigned, f); return (u + 0x7fffu + ((u >> 16) & 1u)) >> 16; }
__device__ __forceinline__ unsigned pk2(float lo, float hi) { return f2bf(lo) | (f2bf(hi) << 16); }

#define XB_TMO      128
#define XB_XCNT(j)  (256  + 64 * (j))
#define XB_XSUB(j)  (1280 + 64 * (j))
#define XB_XGEN(j)  (2304 + 64 * (j))
#define XB_TOP      3328
#define XB_TOPGEN   3392
#define XCD_BAR_WORDS 3456
#define XB_SPIN_CAP (1u << 18)

__device__ __forceinline__ unsigned xb_ld(unsigned* p)              { return __hip_atomic_load(p, __ATOMIC_RELAXED, __HIP_MEMORY_SCOPE_AGENT); }
__device__ __forceinline__ unsigned xb_add(unsigned* p, unsigned v) { return __hip_atomic_fetch_add(p, v, __ATOMIC_RELAXED, __HIP_MEMORY_SCOPE_AGENT); }
__device__ __forceinline__ unsigned xb_xcc_id() { return (unsigned)__builtin_amdgcn_s_getreg((3 << 11) | 20) & 0xFu; }
#define XB_SPIN(cond, bar) do { unsigned _sp = 0; while (cond) { __builtin_amdgcn_s_sleep(1); \
    if ((++_sp & 255u) == 0u) { if (xb_ld(&(bar)[XB_TMO])) break; if (_sp > XB_SPIN_CAP) { atomicAdd(&(bar)[XB_TMO], 1u); break; } } } } while (0)

struct XcdBarrier {
    unsigned* bar; unsigned x;
    volatile LAS unsigned* st;
};

__device__ __forceinline__ XcdBarrier xcd_barrier_post(unsigned* bar, volatile LAS unsigned* st) {
    XcdBarrier b; b.bar = bar; b.x = xb_xcc_id(); b.st = st;
    if (threadIdx.x == 0) (void)xb_add(&bar[XB_XCNT(b.x)], 1u);
    return b;
}
__device__ __forceinline__ void xcd_barrier_complete(unsigned* bar, unsigned x, unsigned& nloc, unsigned& nx) {
    const unsigned G = gridDim.x * gridDim.y * gridDim.z;
    unsigned sum, cnt, mine, sp = 0u;
    for (;;) {
        sum = 0u; cnt = 0u; mine = 0u;
#pragma unroll
        for (unsigned j = 0; j < 16; ++j) { const unsigned c = xb_ld(&bar[XB_XCNT(j)]); sum += c; cnt += (c > 0u) ? 1u : 0u; mine = (j == x) ? c : mine; }
        if (sum == G) break;
        __builtin_amdgcn_s_sleep(1);
        if ((++sp & 255u) == 0u) { if (xb_ld(&bar[XB_TMO])) break; if (sp > XB_SPIN_CAP) { atomicAdd(&bar[XB_TMO], 1u); break; } }
    }
    nloc = mine > 0u ? mine : 1u; nx = cnt > 0u ? cnt : 1u;
}

__device__ __forceinline__ void xcd_barrier(const XcdBarrier& b) {
    asm volatile("s_waitcnt vmcnt(0)" ::: "memory");
    __syncthreads();
    if (threadIdx.x == 0) {
        unsigned* bar = b.bar;
        __builtin_amdgcn_s_waitcnt(0);
        unsigned nloc = b.st[0], nx = b.st[1];
        if (nloc == 0u) { xcd_barrier_complete(bar, b.x, nloc, nx); b.st[0] = nloc; b.st[1] = nx; }
        const unsigned old = xb_add(&bar[XB_XSUB(b.x)], 1u);
        const unsigned gen = old / nloc;
        if (old + 1u == (gen + 1u) * nloc) {
            __builtin_amdgcn_fence(__ATOMIC_RELEASE, "agent");
            asm volatile("s_waitcnt vmcnt(0)" ::: "memory");
            const unsigned og = xb_add(&bar[XB_TOP], 1u);
            const unsigned tg = og / nx;
            if (og + 1u == (tg + 1u) * nx) xb_add(&bar[XB_TOPGEN], 1u);
            else XB_SPIN(xb_ld(&bar[XB_TOPGEN]) == tg, bar);
            __builtin_amdgcn_fence(__ATOMIC_ACQUIRE, "agent");
            xb_add(&bar[XB_XGEN(b.x)], 1u);
            asm volatile("s_waitcnt vmcnt(0)" ::: "memory");
        } else {
            XB_SPIN(xb_ld(&bar[XB_XGEN(b.x)]) == gen, bar);
            __builtin_amdgcn_fence(__ATOMIC_ACQUIRE, "agent");
            asm volatile("s_waitcnt vmcnt(0)" ::: "memory");
        }
    }
    __syncthreads();
}

constexpr int NWAVES = 8;
constexpr int RING_OFF = 0, RING_BYTES = 131072;
constexpr int LDSCTL_OFF = RING_BYTES, MISC_OFF = LDSCTL_OFF + 320;
constexpr int LDS_BYTES = 147456;
constexpr int CW_BAR = 4096;
typedef float f32x4 __attribute__((ext_vector_type(4)));
typedef unsigned u32x2v __attribute__((ext_vector_type(2)));
using pg8::bf16_t;

struct Args { const float* in[38]; float* out; unsigned char* ws; int ph_lo, ph_hi; };

struct Ctx {
    float* out; unsigned char* ws; float* xextra;
    LAS unsigned char* lds; int tid, lane, wave, vcu, G;
};


__device__ __forceinline__ float wave_sum(float v) {
#pragma unroll
    for (int o = 1; o < 64; o <<= 1) v += __shfl_xor(v, o);
    return v;
}
__device__ __forceinline__ float wave_max(float v) {
#pragma unroll
    for (int o = 1; o < 64; o <<= 1) v = fmaxf(v, __shfl_xor(v, o));
    return v;
}
__device__ __forceinline__ float bf2f(bf16_t h) { return __uint_as_float(((unsigned)h) << 16); }
__device__ __forceinline__ void load_row(const float* p, int lane, f32x4 (&v)[4]) {
    const f32x4* q = (const f32x4*)p + lane;
#pragma unroll
    for (int j = 0; j < 4; ++j) v[j] = q[64 * j];
}
__device__ __forceinline__ float row_rstd(const f32x4 (&v)[4], float eps) {
    float s = 0.f;
#pragma unroll
    for (int j = 0; j < 4; ++j) s += (v[j].x * v[j].x + v[j].y * v[j].y) + (v[j].z * v[j].z + v[j].w * v[j].w);
    return 1.0f / sqrtf(wave_sum(s) * (1.0f / D) + eps);
}
__device__ __forceinline__ void store_row_bf16(bf16_t* p, int lane, const f32x4 (&v)[4]) {
    unsigned long long* o = (unsigned long long*)p + lane;
#pragma unroll
    for (int j = 0; j < 4; ++j) o[64 * j] = (unsigned long long)pk2(v[j].x, v[j].y) | ((unsigned long long)pk2(v[j].z, v[j].w) << 32);
}

__device__ __forceinline__ void p0_transpose_item(const float* W, int K, int N, bf16_t* WT, int ldk, int row_off, int mode, LAS float* scr, int kb, int nb, int lane) {
    const int k0 = 64 * kb, n0 = 32 * nb;
#pragma unroll 8
    for (int i = 0; i < 32; ++i) { const int kk = 2 * i + (lane >> 5), k = k0 + kk, n = n0 + (lane & 31);
        scr[kk * 33 + (lane & 31)] = (k < K && n < N) ? W[(size_t)k * N + n] : 0.f; }
    LDS_WAIT(); asm volatile("" ::: "memory");
    const int c = lane & 7;
#pragma unroll
    for (int j = 0; j < 4; ++j) { const int n = (lane >> 3) + 8 * j; const LAS float* s = scr + (8 * c) * 33 + n;
        v4u o; o.x = pk2(s[0 * 33], s[1 * 33]); o.y = pk2(s[2 * 33], s[3 * 33]); o.z = pk2(s[4 * 33], s[5 * 33]); o.w = pk2(s[6 * 33], s[7 * 33]);
        const int nn = n0 + n, drow = (mode == 0) ? nn : ((nn >> 2) * 8 + (nn & 3) + (mode == 2 ? 4 : 0));
        *(GAS v4u*)(WT + (size_t)(row_off + drow) * ldk + k0 + 8 * c) = o; }
    LDS_WAIT(); asm volatile("" ::: "memory");
}
__device__ __forceinline__ void p0_transpose(const Ctx& C, const float* W, int K, int N, int Kd, int Nd, bf16_t* WT, int ldk, int row_off, int mode) {
    LAS float* scr = (LAS float*)(C.lds + RING_OFF + C.wave * 16384);
    const int gw = C.vcu * NWAVES + C.wave, NGW = C.G * NWAVES, nkb = Kd / 64, nnb = Nd / 32, nit = nkb * nnb;
    for (int it = gw; it < nit; it += NGW) p0_transpose_item(W, K, N, WT, ldk, row_off, mode, scr, it / nnb, it % nnb, C.lane);
}
__device__ __forceinline__ void p0_prologue(const Ctx& C) {
    unsigned char* ws = C.ws;
    for (int f = 0; f < 4; ++f) {
        p0_transpose(C, in_ptr(9) + (size_t)f * D * FF, D, FF, D, FF, (bf16_t*)(ws + W_GU) + (size_t)f * NGU * D, D, 0, 1);
        p0_transpose(C, in_ptr(10) + (size_t)f * D * FF, D, FF, D, FF, (bf16_t*)(ws + W_GU) + (size_t)f * NGU * D, D, 0, 2);
        p0_transpose(C, in_ptr(11) + (size_t)f * FF * D, FF, D, FF, D, (bf16_t*)(ws + W_D) + (size_t)f * D * FF, FF, 0, 0);
    }
    bf16_t* wrkvl = (bf16_t*)(ws + W_RKVL);
    p0_transpose(C, in_ptr(13), D, D, D, D, wrkvl, D, 0, 0);
    p0_transpose(C, in_ptr(14), D, D, D, D, wrkvl, D, 1024, 0);
    p0_transpose(C, in_ptr(15), D, D, D, D, wrkvl, D, 2048, 0);
    p0_transpose(C, in_ptr(18), D, 64, D, 256, wrkvl, D, 3072, 0);
    p0_transpose(C, in_ptr(21), D, 64, D, 256, wrkvl, D, 3328, 0);
    p0_transpose(C, in_ptr(23), D, 160, D, 256, wrkvl, D, 3584, 0);
    p0_transpose(C, in_ptr(16), D, D, D, D, (bf16_t*)(ws + W_ORW), D, 0, 0);
    bf16_t* wlu = (bf16_t*)(ws + W_LU);
    p0_transpose(C, in_ptr(19), 64, D, 256, D, wlu, 256, 0, 0);
    p0_transpose(C, in_ptr(22), 64, D, 256, D, wlu, 256, 1024, 0);
    p0_transpose(C, in_ptr(24), 160, D, 256, D, wlu, 256, 2048, 0);
    p0_transpose(C, in_ptr(31), D, D, D, D, (bf16_t*)(ws + W_KV), D, 0, 0);
    p0_transpose(C, in_ptr(32), D, D, D, D, (bf16_t*)(ws + W_KV), D, 1024, 0);
    p0_transpose(C, in_ptr(33), D, D, D, D, (bf16_t*)(ws + W_Q), D, 0, 0);
    p0_transpose(C, in_ptr(34), D, D, D, D, (bf16_t*)(ws + W_OAT), D, 0, 0);
    const int gw = C.vcu * NWAVES + C.wave, NGW = C.G * NWAVES;
    {
        f32x4 gn[4]; load_row(in_ptr(7), C.lane, gn);
        bf16_t* XN = (bf16_t*)(ws + U_XN);
        for (int r = gw; r < MP; r += NGW) {
            f32x4 v[4];
            if (r < ROW_S) load_row(in_ptr(0) + (size_t)r * D, C.lane, v);
            else if (r < ROW_M) load_row(in_ptr(1) + (size_t)(r - ROW_S) * D, C.lane, v);
            else if (r < ROW_END) load_row(in_ptr(6) + (size_t)((r - ROW_M) & 15) * D, C.lane, v);
            else {
#pragma unroll
                for (int j = 0; j < 4; ++j) v[j] = (f32x4){0.f, 0.f, 0.f, 0.f}; }
            float* xr = xrow_ptr(C.out, C.xextra, r);
            f32x4* xo = (f32x4*)xr + C.lane;
#pragma unroll
            for (int j = 0; j < 4; ++j) xo[64 * j] = v[j];
            const float rs = row_rstd(v, 1e-6f);
#pragma unroll
            for (int j = 0; j < 4; ++j) v[j] = v[j] * rs * gn[j];
            store_row_bf16(XN + (size_t)r * D, C.lane, v);
        }
    }
    {
        float* rope = (float*)(ws + WS_ROPE);
        const int gt = (C.vcu * NWAVES + C.wave) * 64 + C.lane, NGT = C.G * NWAVES * 64;
        for (int e = gt; e < 4112 * 8; e += NGT) {
            const int pos = e >> 3, i = e & 7;
            const float inv = exp2f(-(float)i * (18.931568569324174f / 8.0f));
            const float x = (float)pos * inv;
            const float n = rintf(x * 0.15915494309189535f);
            float r = fmaf(-n, 6.28125f, x); r = fmaf(-n, 1.9353071795864769e-3f, r);
            rope[(size_t)pos * 16 + i] = cosf(r); rope[(size_t)pos * 16 + 8 + i] = sinf(r);
        }
    }
    {
        v4u* z = (v4u*)(ws + WS_KMETA); const int gt = (C.vcu * NWAVES + C.wave) * 64 + C.lane, NGT = C.G * NWAVES * 64;
        for (int e = gt; e < (int)(2 * MiB / 16); e += NGT) z[e] = (v4u){0u, 0u, 0u, 0u};
    }
    if (blockIdx.x == 0 && C.wave == 0) {
        const float* lp = in_ptr(35);
        const float a = wave_sum(lp[C.lane] * lp[64 + C.lane]), b = wave_sum(lp[128 + C.lane] * lp[192 + C.lane]);
        if (C.lane == 0) ((float*)(ws + WS_MISC))[0] = expf(a) - expf(b) + 0.35550906759096924f;
    }
}

__device__ __forceinline__ void p_norm(const Ctx& C, const float* g0, bf16_t* o0, const float* g1, bf16_t* o1) {
    const int gw = C.vcu * NWAVES + C.wave, NGW = C.G * NWAVES;
    f32x4 ga[4], gb[4]; load_row(g0, C.lane, ga); if (g1) load_row(g1, C.lane, gb);
    for (int r = ROW_END + gw; r < MP; r += NGW) {
        f32x4 z[4];
#pragma unroll
        for (int j = 0; j < 4; ++j) z[j] = (f32x4){0.f, 0.f, 0.f, 0.f};
        store_row_bf16(o0 + (size_t)r * D, C.lane, z); if (g1) store_row_bf16(o1 + (size_t)r * D, C.lane, z); }
    for (int r = gw; r < ROW_END; r += NGW) {
        f32x4 v[4]; load_row(xrow_ptr(C.out, C.xextra, r), C.lane, v);
        const float rs = row_rstd(v, 1e-6f);
        f32x4 o[4];
#pragma unroll
        for (int j = 0; j < 4; ++j) o[j] = v[j] * rs * ga[j];
        store_row_bf16(o0 + (size_t)r * D, C.lane, o);
        if (g1) {
#pragma unroll
            for (int j = 0; j < 4; ++j) o[j] = v[j] * rs * gb[j];
            store_row_bf16(o1 + (size_t)r * D, C.lane, o);
        }
    }
}
__device__ __forceinline__ void p_final(const Ctx& C) {
    const int gw = C.vcu * NWAVES + C.wave, NGW = C.G * NWAVES;
    f32x4 ga[4]; load_row(in_ptr(37), C.lane, ga);
    for (int r = gw; r < ROW_M; r += NGW) {
        float* xr = C.out + (size_t)r * D;
        f32x4 v[4]; load_row(xr, C.lane, v);
        const float rs = row_rstd(v, 1e-6f);
        f32x4* xo = (f32x4*)xr + C.lane;
#pragma unroll
        for (int j = 0; j < 4; ++j) xo[64 * j] = v[j] * rs * ga[j];
    }
}

__device__ __forceinline__ void p_rwmix(const Ctx& C) {
    const int gw = C.vcu * NWAVES + C.wave, NGW = C.G * NWAVES;
    f32x4 gn[4]; load_row(in_ptr(8), C.lane, gn);
    bf16_t* A6 = (bf16_t*)(C.ws + U_A6);
    for (int r = ROW_END + gw; r < MP; r += NGW) {
        f32x4 z[4];
#pragma unroll
        for (int j = 0; j < 4; ++j) z[j] = (f32x4){0.f, 0.f, 0.f, 0.f};
#pragma unroll
        for (int g = 0; g < 6; ++g) store_row_bf16(A6 + ((size_t)g * MP + r) * D, C.lane, z); }
    for (int r = gw; r < ROW_END; r += NGW) {
        f32x4 h[4], hp[4];
        load_row(xrow_ptr(C.out, C.xextra, r), C.lane, h);
        { const float rs = row_rstd(h, 1e-6f);
#pragma unroll
          for (int j = 0; j < 4; ++j) h[j] = h[j] * rs * gn[j]; }
        int prev = -1; const float* raw = nullptr; int last = 0; size_t shoff = 0;
        if (r < ROW_S) { const int b = r >> 12, t = r & 4095; prev = t > 0 ? r - 1 : ROW_M + b * 16 + 15; if (t == 4095) { last = 1; shoff = O_SHP + (size_t)b * D; } }
        else if (r < ROW_M) { const int i = r - ROW_S, b = i >> 4, t = i & 15; if (t > 0) prev = r - 1; else raw = in_ptr(5) + (size_t)b * D; if (t == 15) { last = 1; shoff = O_SHS + (size_t)b * D; } }
        else { const int j = (r - ROW_M) & 15; if (j > 0) prev = r - 1; }
        if (prev >= 0) { load_row(xrow_ptr(C.out, C.xextra, prev), C.lane, hp); const float rs = row_rstd(hp, 1e-6f);
#pragma unroll
            for (int j = 0; j < 4; ++j) hp[j] = hp[j] * rs * gn[j]; }
        else if (raw) load_row(raw, C.lane, hp);
        else {
#pragma unroll
            for (int j = 0; j < 4; ++j) hp[j] = (f32x4){0.f, 0.f, 0.f, 0.f}; }
        if (last) { f32x4* so = (f32x4*)(C.out + shoff) + C.lane;
#pragma unroll
            for (int j = 0; j < 4; ++j) so[64 * j] = h[j]; }
#pragma unroll
        for (int g = 0; g < 6; ++g) {
            const int mi = (g == 0) ? 0 : (g == 1) ? 2 : (g == 2) ? 3 : (g == 3) ? 1 : g;
            f32x4 mu[4]; load_row(in_ptr(12) + (size_t)mi * D, C.lane, mu);
            f32x4 o[4];
#pragma unroll
            for (int j = 0; j < 4; ++j) o[j] = h[j] + (hp[j] - h[j]) * mu[j];
            store_row_bf16(A6 + ((size_t)g * MP + r) * D, C.lane, o);
        }
    }
}

__device__ __forceinline__ void p_scan(const Ctx& C) {
    const int g = (int)blockIdx.x;
    if (C.wave == 2 && g < 64) {
        f32x4 z[4];
#pragma unroll
        for (int j = 0; j < 4; ++j) z[j] = (f32x4){0.f, 0.f, 0.f, 0.f};
        store_row_bf16((bf16_t*)(C.ws + U_YG) + (size_t)(ROW_END + g) * D, C.lane, z); return; }
    int prompt, b, h;
    if (C.wave == 0 && g < 64) { prompt = 1; b = g >> 4; h = g & 15; }
    else if (C.wave == 0 && g >= 64 && g < 192) { prompt = 0; b = (g - 64) >> 4; h = g & 15; }
    else return;
    const int lane = C.lane, col = h * 64 + lane;
#ifdef PROBE_DELAY
    { const unsigned long long t0 = __builtin_amdgcn_s_memrealtime(); while (__builtin_amdgcn_s_memrealtime() - t0 < 20000ull) __builtin_amdgcn_s_sleep(16); }
#endif
    LAS float* sc = (LAS float*)(C.lds + RING_OFF + C.wave * 2048);
    const bf16_t* Rb = (const bf16_t*)(C.out + O_CKP); const bf16_t* Kb = Rb + (size_t)MP * D; const bf16_t* Vb = Kb + (size_t)MP * D;
    const float* LW = (const float*)(C.ws + U_LOGW); const bf16_t* AS = (const bf16_t*)(C.ws + U_ASIG); const bf16_t* GG = (const bf16_t*)(C.ws + U_G);
    bf16_t* YG = (bf16_t*)(C.ws + U_YG);
    const float kk_c = in_ptr(25)[col], ka_c = in_ptr(26)[col], rk_c = in_ptr(27)[col], gng = in_ptr(28)[col], gnb = in_ptr(29)[col];
    float S[64];
#ifdef PROBE_ZERO_STATE
    if (true) {
#else
    if (prompt) {
#endif
#pragma unroll
        for (int k = 0; k < 64; ++k) S[k] = 0.f;
    } else { const f32x4* s0 = (const f32x4*)(in_ptr(4) + ((size_t)(b * 16 + h) * 64 + lane) * 64);
#pragma unroll
        for (int k4 = 0; k4 < 16; ++k4) { const f32x4 q = s0[k4]; S[4 * k4] = q.x; S[4 * k4 + 1] = q.y; S[4 * k4 + 2] = q.z; S[4 * k4 + 3] = q.w; } }
    const int nsteps = prompt ? 4112 : 16;
#define SCAN_ROWOF(t) (prompt ? ((t) < 16 ? (size_t)(ROW_M + b * 16 + (t)) : (size_t)(b * 4096 + ((t) - 16))) : (size_t)(ROW_S + b * 16 + (t)))
    size_t off = SCAN_ROWOF(0) * D + col;
    float rk = bf2f(Rb[off]), kr = bf2f(Kb[off]), vv = bf2f(Vb[off]), lw = LW[off], aa = bf2f(AS[off]), gg = bf2f(GG[off]);
    for (int t = 0; t < nsteps; ++t) {
        const size_t offc = off;
        const float rk_ = rk, kr_ = kr, vv_ = vv, lw_ = lw, aa_ = aa, gg_ = gg;
        if (t + 1 < nsteps) { off = SCAN_ROWOF(t + 1) * D + col; rk = bf2f(Rb[off]); kr = bf2f(Kb[off]); vv = bf2f(Vb[off]); lw = LW[off]; aa = bf2f(AS[off]); gg = bf2f(GG[off]); }
        const float kkv = kr_ * kk_c, n2 = wave_sum(kkv * kkv), kkn = kkv / fmaxf(sqrtf(n2), 1e-12f);
        const float kp = kr_ * (1.0f + (aa_ - 1.0f) * ka_c), dec = __expf(lw_), an = -kkn, bn = kkn * aa_;
        const float bonus = wave_sum(rk_ * kp * rk_c);
        sc[lane] = an; sc[64 + lane] = dec; sc[128 + lane] = bn; sc[192 + lane] = kp; sc[256 + lane] = rk_;
        LDS_WAIT(); asm volatile("" ::: "memory");
        float sa0 = 0.f, sa1 = 0.f, sa2 = 0.f, sa3 = 0.f;
#pragma unroll
        for (int k4 = 0; k4 < 16; ++k4) { const f32x4 q = *(const LAS f32x4*)(sc + 4 * k4); sa0 += S[4 * k4] * q.x; sa1 += S[4 * k4 + 1] * q.y; sa2 += S[4 * k4 + 2] * q.z; sa3 += S[4 * k4 + 3] * q.w; if (k4 & 1) __builtin_amdgcn_sched_barrier(0); }
        const float sa = (sa0 + sa1) + (sa2 + sa3);
        float y0 = 0.f, y1 = 0.f, y2 = 0.f, y3 = 0.f;
#pragma unroll
        for (int k4 = 0; k4 < 16; ++k4) {
            const f32x4 qd = *(const LAS f32x4*)(sc + 64 + 4 * k4), qb = *(const LAS f32x4*)(sc + 128 + 4 * k4), qk = *(const LAS f32x4*)(sc + 192 + 4 * k4), qr = *(const LAS f32x4*)(sc + 256 + 4 * k4);
            S[4 * k4]     = S[4 * k4] * qd.x     + sa * qb.x + vv_ * qk.x; y0 += S[4 * k4] * qr.x;
            S[4 * k4 + 1] = S[4 * k4 + 1] * qd.y + sa * qb.y + vv_ * qk.y; y1 += S[4 * k4 + 1] * qr.y;
            S[4 * k4 + 2] = S[4 * k4 + 2] * qd.z + sa * qb.z + vv_ * qk.z; y2 += S[4 * k4 + 2] * qr.z;
            S[4 * k4 + 3] = S[4 * k4 + 3] * qd.w + sa * qb.w + vv_ * qk.w; y3 += S[4 * k4 + 3] * qr.w; __builtin_amdgcn_sched_barrier(0); }
        const float y = (y0 + y1) + (y2 + y3);
        LDS_WAIT(); asm volatile("" ::: "memory");
        const float mean = wave_sum(y) * (1.0f / 64.0f), dlt = y - mean, var = wave_sum(dlt * dlt) * (1.0f / 64.0f);
        const float yn = dlt * (1.0f / sqrtf(var + 64e-5f)) * gng + gnb;
        const float o = (yn + bonus * vv_) * gg_;
        YG[offc] = (bf16_t)f2bf(o);
    }
    float* so = C.out + (prompt ? O_WKVP : O_WKVS) + ((size_t)(b * 16 + h) * 64 + lane) * 64;
#pragma unroll
    for (int k4 = 0; k4 < 16; ++k4) ((f32x4*)so)[k4] = (f32x4){S[4 * k4], S[4 * k4 + 1], S[4 * k4 + 2], S[4 * k4 + 3]};
}

constexpr float ATT_C2 = 0.125f * 1.4426950408889634f;
constexpr float LAM_INIT = 0.35550906759096924f;
__device__ __forceinline__ void sample_attn_unit(const Ctx& C, int b, int hh) {
    const int tid = C.tid, lane = C.lane, wave = C.wave;
    LAS float* QS = (LAS float*)(C.lds + RING_OFF);
    LAS float* KT = (LAS float*)(C.lds + RING_OFF + 8192);
    LAS float* VT = (LAS float*)(C.lds + RING_OFF + 8192 + 33792);
    LAS float* PS = (LAS float*)(C.lds + RING_OFF + 8192 + 2 * 33792);
    LAS float* ML = (LAS float*)(C.lds + RING_OFF + 8192 + 2 * 33792 + 8192);
    LAS float* OS = (LAS float*)(C.lds + RING_OFF + 8192 + 2 * 33792 + 8192 + 512);
    const bf16_t* QB = (const bf16_t*)(C.ws + U_QB);
    const float lam = ((const float*)(C.ws + WS_MISC))[0];
    __syncthreads();
    { const int q = tid >> 5, e0 = (tid & 31) * 4; const bf16_t* qp = QB + (size_t)(ROW_S + b * 16 + q) * D + hh * 128 + e0;
      const int c = e0 >> 6, d = e0 & 63;
#pragma unroll
      for (int e = 0; e < 4; ++e) QS[(c * 16 + q) * 64 + d + e] = bf2f(qp[e]); }
    float m_[4], l_[4];
#pragma unroll
    for (int i = 0; i < 4; ++i) { m_[i] = -INFINITY; l_[i] = 0.f; }
    float acc[2][4];
#pragma unroll
    for (int c = 0; c < 2; ++c)
#pragma unroll
        for (int i = 0; i < 4; ++i) acc[c][i] = 0.f;
    const int dim = tid & 127, qg = tid >> 7;
    const float* ck = in_ptr(2); const float* cv = in_ptr(3);
    for (int tile = 0; tile < 33; ++tile) {
        const int key0 = tile * 64;
        { const int key = tid >> 3, seg = tid & 7, kidx = key0 + key;
          f32x4 kq[4], vq[4];
          if (kidx < 2064) { const size_t o = (((size_t)b * 2064 + kidx) * 8 + hh) * 128 + seg * 16;
#pragma unroll
              for (int i = 0; i < 4; ++i) { kq[i] = *(const f32x4*)(ck + o + 4 * i); vq[i] = *(const f32x4*)(cv + o + 4 * i); } }
          else if (kidx < 2080) { const size_t o = (((size_t)b * 16 + (kidx - 2064)) * 8 + hh) * 128 + seg * 16;
#pragma unroll
              for (int i = 0; i < 4; ++i) { kq[i] = *(const f32x4*)(C.out + O_CKS + o + 4 * i); vq[i] = *(const f32x4*)(C.out + O_CVS + o + 4 * i); } }
          else {
#pragma unroll
              for (int i = 0; i < 4; ++i) { kq[i] = (f32x4){0.f, 0.f, 0.f, 0.f}; vq[i] = (f32x4){0.f, 0.f, 0.f, 0.f}; } }
#pragma unroll
          for (int i = 0; i < 4; ++i) { *(LAS f32x4*)(KT + key * 132 + seg * 16 + 4 * i) = kq[i]; *(LAS f32x4*)(VT + key * 132 + seg * 16 + 4 * i) = vq[i]; } }
        __syncthreads();
        float s[4] = {0.f, 0.f, 0.f, 0.f};
#pragma unroll 2
        for (int i = 0; i < 16; ++i) {
#pragma unroll
            for (int c = 0; c < 2; ++c) { const f32x4 kv = *(const LAS f32x4*)(KT + lane * 132 + c * 64 + 4 * i);
#pragma unroll
                for (int qi = 0; qi < 2; ++qi) { const f32x4 qv = *(const LAS f32x4*)(QS + (c * 16 + 2 * wave + qi) * 64 + 4 * i);
                    s[2 * c + qi] += (kv.x * qv.x + kv.y * qv.y) + (kv.z * qv.z + kv.w * qv.w); } } }
        const bool kvalid = (key0 + lane) < 2080;
#pragma unroll
        for (int ri = 0; ri < 4; ++ri) { const int c = ri >> 1, q = 2 * wave + (ri & 1);
            const float sv = kvalid ? s[ri] : -INFINITY;
            const float tmax = wave_max(sv), mnew = fmaxf(m_[ri], tmax), alpha = exp2f(m_[ri] - mnew), p = exp2f(sv - mnew);
            l_[ri] = l_[ri] * alpha + wave_sum(p); m_[ri] = mnew;
            PS[(c * 16 + q) * 64 + lane] = p;
            if (lane == 0) ML[c * 16 + q] = alpha; }
        __syncthreads();
#pragma unroll
        for (int c = 0; c < 2; ++c)
#pragma unroll
            for (int qi = 0; qi < 4; ++qi) acc[c][qi] *= ML[c * 16 + 4 * qg + qi];
#pragma unroll 2
        for (int k4 = 0; k4 < 16; ++k4) {
            float vv[4];
#pragma unroll
            for (int e = 0; e < 4; ++e) vv[e] = VT[(4 * k4 + e) * 132 + dim];
#pragma unroll
            for (int c = 0; c < 2; ++c)
#pragma unroll
                for (int qi = 0; qi < 4; ++qi) { const f32x4 pv = *(const LAS f32x4*)(PS + (c * 16 + 4 * qg + qi) * 64 + 4 * k4);
                    acc[c][qi] += (pv.x * vv[0] + pv.y * vv[1]) + (pv.z * vv[2] + pv.w * vv[3]); } }
        __syncthreads();
    }
    if (lane == 0) {
#pragma unroll
        for (int ri = 0; ri < 4; ++ri) ML[32 + (ri >> 1) * 16 + 2 * wave + (ri & 1)] = l_[ri]; }
    __syncthreads();
#pragma unroll
    for (int qi = 0; qi < 4; ++qi) { const int q = 4 * qg + qi; OS[q * 128 + dim] = acc[0][qi] / ML[32 + q] - lam * (acc[1][qi] / ML[32 + 16 + q]); }
    __syncthreads();
    bf16_t* OA = (bf16_t*)(C.ws + U_OA);
    const float* sub = in_ptr(36);
#pragma unroll
    for (int qi = 0; qi < 2; ++qi) { const int q = 2 * wave + qi; const float o0 = OS[q * 128 + lane], o1 = OS[q * 128 + 64 + lane];
        const float rs = 1.0f / sqrtf(wave_sum(o0 * o0 + o1 * o1) * (1.0f / 128.0f) + 1e-5f) * (1.0f - LAM_INIT);
        bf16_t* op = OA + (size_t)(ROW_S + b * 16 + q) * D + hh * 128;
        op[lane] = (bf16_t)f2bf(o0 * rs * sub[lane]); op[64 + lane] = (bf16_t)f2bf(o1 * rs * sub[64 + lane]); }
    __syncthreads();
}

__device__ __forceinline__ void p_attn(const Ctx& C) {
    const attn_body::bf16* QB = (const attn_body::bf16*)(C.ws + U_QB); const attn_body::bf16* KB = (const attn_body::bf16*)(C.ws + U_KB); const attn_body::bf16* VB = (const attn_body::bf16*)(C.ws + U_VB);
    const attn_body::bf16* KM = (const attn_body::bf16*)(C.ws + WS_KMETA); const attn_body::bf16* VM = (const attn_body::bf16*)(C.ws + WS_VMETA);
    {
        const int v = C.vcu, par = v & 1;
        for (int i = (C.G == 256 ? 0 : C.vcu); i < (C.G == 256 ? 8 : 2048); i += (C.G == 256 ? 1 : C.G)) {
            int combo, qb;
            if (C.G == 256) { const int s = 4 * par + (i >> 1); combo = v >> 1; qb = (i & 1) ? 15 - s : s; } else { combo = i >> 4; qb = i & 15; }
            const int vh = combo & 1, c = (combo >> 1) & 1, hh = (combo >> 2) & 7, b = combo >> 5;
            attn_body::bf16* O = (attn_body::bf16*)(C.ws + (c ? U_O2 : U_O1));
            attn_body::attn_unit<8>(b, 2 * hh + c, 2 * hh + vh, qb, QB, KB, VB, KM, VM, O, (char*)C.lds + RING_OFF); }
    }
#ifndef NO_SAMPLE
    for (int u = C.vcu; u < 64; u += C.G) sample_attn_unit(C, u >> 3, u & 7);
#endif
}

__device__ __forceinline__ void p_combine(const Ctx& C) {
    const int gw = C.vcu * NWAVES + C.wave, NGW = C.G * NWAVES, lane = C.lane;
    const bf16_t* O1 = (const bf16_t*)(C.ws + U_O1); const bf16_t* O2 = (const bf16_t*)(C.ws + U_O2); bf16_t* OA = (bf16_t*)(C.ws + U_OA);
    const float lam = ((const float*)(C.ws + WS_MISC))[0];
    const f32x4 sub = *(const f32x4*)(in_ptr(36) + 4 * (lane & 31));
    for (int r = ROW_M + gw; r < MP; r += NGW) {
        f32x4 z[4];
#pragma unroll
        for (int j = 0; j < 4; ++j) z[j] = (f32x4){0.f, 0.f, 0.f, 0.f};
        store_row_bf16(OA + (size_t)r * D, lane, z); }
    for (int r = gw; r < ROW_S; r += NGW) {
        f32x4 o[4];
#pragma unroll
        for (int j = 0; j < 4; ++j) { const size_t off = (size_t)r * D + 4 * lane + 256 * j;
            const unsigned long long a = *(const unsigned long long*)(O1 + off), bb = *(const unsigned long long*)(O2 + off);
            o[j].x = __uint_as_float((unsigned)(a & 0xffffull) << 16) - lam * __uint_as_float((unsigned)(bb & 0xffffull) << 16);
            o[j].y = __uint_as_float((unsigned)((a >> 16) & 0xffffull) << 16) - lam * __uint_as_float((unsigned)((bb >> 16) & 0xffffull) << 16);
            o[j].z = __uint_as_float((unsigned)((a >> 32) & 0xffffull) << 16) - lam * __uint_as_float((unsigned)((bb >> 32) & 0xffffull) << 16);
            o[j].w = __uint_as_float((unsigned)((a >> 48) & 0xffffull) << 16) - lam * __uint_as_float((unsigned)((bb >> 48) & 0xffffull) << 16); }
#pragma unroll
        for (int j = 0; j < 4; ++j) { float ss = (o[j].x * o[j].x + o[j].y * o[j].y) + (o[j].z * o[j].z + o[j].w * o[j].w);
            ss += __shfl_xor(ss, 1); ss += __shfl_xor(ss, 2); ss += __shfl_xor(ss, 4); ss += __shfl_xor(ss, 8); ss += __shfl_xor(ss, 16);
            const float rs = 1.0f / sqrtf(ss * (1.0f / 128.0f) + 1e-5f) * (1.0f - LAM_INIT);
            o[j] = o[j] * rs * sub; }
        store_row_bf16(OA + (size_t)r * D, lane, o);
    }
}

constexpr int N_PHASES = 24;
__global__ void __launch_bounds__(NWAVES * 64, 2) mk_fwd(Args args) {
    extern __shared__ __attribute__((aligned(16))) unsigned char lds[];
    Ctx C;
    C.out = args.out; C.ws = args.ws; C.xextra = (float*)(args.ws + WS_XEXTRA);
    C.lds = (LAS unsigned char*)lds; C.tid = threadIdx.x; C.lane = C.tid & 63; C.wave = __builtin_amdgcn_readfirstlane(C.tid >> 6);
    C.G = gridDim.x; { const int bx = blockIdx.x; C.vcu = (C.G % 8 == 0) ? (bx % 8) * (C.G / 8) + bx / 8 : bx; }
    volatile LAS unsigned* MISC = (volatile LAS unsigned*)(C.lds + MISC_OFF);
    for (int u = C.tid; u < (LDS_BYTES - LDSCTL_OFF) / 4; u += NWAVES * 64) ((LAS unsigned*)(C.lds + LDSCTL_OFF))[u] = 0u;
    __syncthreads();
    const int lo = args.ph_lo, hi = args.ph_hi;
    const bool use_bar = (hi - lo) > 1;
    XcdBarrier bar; bar.bar = (unsigned*)(args.ws + WS_CTL) + CW_BAR; bar.x = 0; bar.st = nullptr;
    if (use_bar) bar = xcd_barrier_post((unsigned*)(args.ws + WS_CTL) + CW_BAR, MISC + 8);
    unsigned char* ws = args.ws;
#ifdef PROBE_HASH
    if (lo == 100) {
        const unsigned* a = (const unsigned*)C.out; const size_t na = (size_t)42733568;
        const unsigned* b = (const unsigned*)(args.ws + PROBE_HASH_WS_LO); const size_t nb = (size_t)(PROBE_HASH_WS_HI - PROBE_HASH_WS_LO) / 4;
        const size_t gt = (size_t)blockIdx.x * 512 + C.tid, NT_ = (size_t)C.G * 512;
        unsigned h1 = 0x811c9dc5u, h2 = 0x811c9dc5u;
        for (size_t e = gt; e < na; e += NT_) { h1 = (h1 ^ a[e]) * 16777619u; h1 ^= h1 >> 13; }
        for (size_t e = gt; e < nb; e += NT_) { h2 = (h2 ^ b[e]) * 16777619u; h2 ^= h2 >> 13; }
        float* dst = C.out + O_WKVS;
        dst[gt] = (float)(h1 & 0xffffu); dst[131072 + gt] = (float)(h2 & 0xffffu);
        return;
    }
#endif
#define IN(k) (lo <= (k) && (k) < hi)
#define SEAM(k) do { if (IN(k) && IN((k) + 1)) xcd_barrier(bar); } while (0)
#define GEMM_PHASE_X(k, EPI, NN, MODE, APTR, BPTR, KK, SCALE, ALIGN_, SP2_) do { if (IN(k)) { \
        pg8::Gemm g{(const bf16_t*)(APTR), (const bf16_t*)(BPTR), MP, 0, (KK)}; pg8::GSched<NN, MODE> S; S.init(C.G, (int)blockIdx.x); EPI E{SCALE, C.out, ws, in_ptr(17), in_ptr(20)}; \
        pg8::gemm_phase<EPI, pg8::GSched<NN, MODE>, ALIGN_, SP2_>(C.lds + RING_OFF, g, S, E); } SEAM(k); } while (0)
#define GEMM_PHASE(k, EPI, NN, MODE, APTR, BPTR, KK, SCALE) GEMM_PHASE_X(k, EPI, NN, MODE, APTR, BPTR, KK, SCALE, true, true)
#define FFN_PHASES(k, f) do { \
        GEMM_PHASE(k, pg8::EpiT<pg8::ET_SWIGLU>, NGU / 256, 0, ws + U_XN, (const bf16_t*)(ws + W_GU) + (size_t)(f) * NGU * D, D, 0.f); \
        GEMM_PHASE((k) + 1, pg8::EpiF<pg8::EF_RESID>, 4, 0, ws + U_H, (const bf16_t*)(ws + W_D) + (size_t)(f) * D * FF, FF, 0.5f); } while (0)
    if (IN(0)) p0_prologue(C); SEAM(0);
    FFN_PHASES(1, 0);
    if (IN(3)) p_rwmix(C); SEAM(3);
    GEMM_PHASE(4, pg8::EpiT<pg8::ET_P4>, 15, 1, ws + U_A6, ws + W_RKVL, D, 0.f);
#ifdef PROBE_P5_K1024
    GEMM_PHASE(5, pg8::EpiF<pg8::EF_P5>, 12, 2, C.out + O_CKP, ws + W_RKVL, D, 0.f);
#else
    GEMM_PHASE(5, pg8::EpiF<pg8::EF_P5>, 12, 2, ws + U_LOR, ws + W_LU, 256, 0.f);
#endif
#ifdef PROBE_COPY2
    if (IN(6)) {
        float* dst = C.out + O_WKVS; const unsigned* rkv = (const unsigned*)(C.out + O_CKP);
        const int gt = (int)blockIdx.x * 512 + C.tid, NT_ = C.G * 512;
        for (int e = gt; e < 128 * 512; e += NT_) {
            dst[e] = __uint_as_float(rkv[(size_t)ROW_S * 512 + e] & PROBE_MASK);
            dst[65536 + e] = __uint_as_float(rkv[(size_t)MP * 512 + (size_t)ROW_S * 512 + e] & PROBE_MASK);
            dst[131072 + e] = __uint_as_float(rkv[(size_t)2 * MP * 512 + (size_t)ROW_S * 512 + e] & PROBE_MASK);
            dst[196608 + e] = __uint_as_float(((const unsigned*)(ws + U_ASIG))[(size_t)ROW_S * 512 + e] & PROBE_MASK); }
        for (int e = gt; e < 128 * 1024; e += NT_) dst[262144 + e] = ((const float*)(ws + U_LOGW))[(size_t)ROW_S * 1024 + e];
    }
#elif defined(PROBE_COPY)
    if (IN(6)) { const v4u* src = (const v4u*)(ws + U_LOGW); v4u* dst = (v4u*)(C.out + O_CKP); const size_t n = (size_t)134000000 / 16;
        for (size_t e = (size_t)blockIdx.x * 512 + C.tid; e < n; e += (size_t)C.G * 512) dst[e] = src[e]; }
#else
    if (IN(6)) p_scan(C); SEAM(6);
#endif
    GEMM_PHASE(7, pg8::EpiF<pg8::EF_RESID>, 4, 0, ws + U_YG, ws + W_ORW, D, 1.0f);
    if (IN(8)) p_norm(C, in_ptr(7) + 1 * D, (bf16_t*)(ws + U_XN), nullptr, nullptr); SEAM(8);
    FFN_PHASES(9, 1);
    if (IN(11)) p_norm(C, in_ptr(30), (bf16_t*)(ws + U_HNKV), in_ptr(7) + 2 * D, (bf16_t*)(ws + U_XN)); SEAM(11);
    GEMM_PHASE(12, pg8::EpiF<pg8::EF_KV>, 8, 0, ws + U_HNKV, ws + W_KV, D, 0.f);
    FFN_PHASES(13, 2);
    if (IN(15)) p_norm(C, in_ptr(8) + D, (bf16_t*)(ws + U_HN1), nullptr, nullptr); SEAM(15);
    GEMM_PHASE(16, pg8::EpiF<pg8::EF_Q>, 4, 0, ws + U_HN1, ws + W_Q, D, ATT_C2);
    if (IN(17)) p_attn(C); SEAM(17);
    if (IN(18)) p_combine(C); SEAM(18);
    GEMM_PHASE(19, pg8::EpiF<pg8::EF_RESID>, 4, 0, ws + U_OA, ws + W_OAT, D, 1.0f);
    if (IN(20)) p_norm(C, in_ptr(7) + 3 * D, (bf16_t*)(ws + U_XN), nullptr, nullptr); SEAM(20);
    FFN_PHASES(21, 3);
    if (IN(23)) p_final(C);
#undef IN
#undef SEAM
#undef GEMM_PHASE
#undef GEMM_PHASE_X
#undef FFN_PHASES
}

extern "C" void kernel_launch(void* const* d_in, const int* in_sizes, int n_in, void* d_out, int out_size, void* d_ws, size_t ws_size, hipStream_t stream) {
    static int grid = 0;
    if (grid == 0) {
        if (n_in != 38 || out_size != (int)O_END || ws_size < WS_END) { fprintf(stderr, "kernel_launch: unexpected shapes: n_in %d out %d ws %zu (need %zu)\n", n_in, out_size, ws_size, (size_t)WS_END); grid = -1; return; }
        int dev = 0, cus = 0, per_cu = 0;
        if (hipGetDevice(&dev) != hipSuccess || hipDeviceGetAttribute(&cus, hipDeviceAttributeMultiprocessorCount, dev) != hipSuccess) { grid = -1; return; }
        if (hipFuncSetAttribute((const void*)mk_fwd, hipFuncAttributeMaxDynamicSharedMemorySize, LDS_BYTES) != hipSuccess) { fprintf(stderr, "kernel_launch: hipFuncSetAttribute failed\n"); grid = -1; return; }
        if (hipOccupancyMaxActiveBlocksPerMultiprocessor(&per_cu, (const void*)mk_fwd, NWAVES * 64, LDS_BYTES) != hipSuccess || per_cu < 1) fprintf(stderr, "kernel_launch: occupancy query reports %d\n", per_cu);
        (void)hipGetLastError();
        grid = cus;
    }
    if (grid < 0) return;
    (void)hipMemsetAsync((char*)d_ws + WS_CTL, 0, CTL_ZERO_BYTES, stream);
    Args a{};
    for (int i = 0; i < 38; ++i) a.in[i] = (const float*)d_in[i];
    a.out = (float*)d_out; a.ws = (unsigned char*)d_ws;
#ifndef MK_PER_PHASE
#define MK_PER_PHASE 0
#endif
#if MK_PER_PHASE
#ifndef MK_LAST_PHASE
#define MK_LAST_PHASE N_PHASES
#endif
    for (int ph = 0; ph < MK_LAST_PHASE; ++ph) { a.ph_lo = ph; a.ph_hi = ph + 1; hipLaunchKernelGGL(mk_fwd, dim3(grid), dim3(NWAVES * 64), LDS_BYTES, stream, a); }
#ifdef PROBE_HASH
    a.ph_lo = 100; a.ph_hi = 101; hipLaunchKernelGGL(mk_fwd, dim3(grid), dim3(NWAVES * 64), LDS_BYTES, stream, a);
#endif
#else
    a.ph_lo = 0; a.ph_hi = N_PHASES; hipLaunchKernelGGL(mk_fwd, dim3(grid), dim3(NWAVES * 64), LDS_BYTES, stream, a);
#endif
}
```

```cpp
#define MK_PER_PHASE 0

#include <hip/hip_runtime.h>
#include <hip/hip_bf16.h>
#include <cstdio>
#include <cstdint>
#include <cmath>

constexpr int D = 1024, FF = 2816, NGU = 2 * FF;
constexpr int NTM = 65, MP = NTM * 256;
constexpr int ROW_S = 16384, ROW_M = 16512, ROW_END = 16576;
constexpr size_t O_YP = 0, O_YS = 16777216, O_WKVP = 16908288, O_SHP = 17170432, O_CKP = 17174528, O_CVP = 34017280, O_WKVS = 50860032, O_SHS = 51384320, O_CKS = 51392512, O_CVS = 51523584, O_END = 51654656;
constexpr size_t MiB = 1u << 20;
constexpr size_t WS_CTL = 0, CTL_ZERO_BYTES = 32768;
constexpr size_t WS_XEXTRA = 1 * MiB;
constexpr size_t WS_ROPE = 1 * MiB + 512 * 1024;
constexpr size_t WS_MISC = 2 * MiB;
constexpr size_t WS_KMETA = 3 * MiB, WS_VMETA = 4 * MiB;
#ifndef THIN_SPLIT_MINF
#define THIN_SPLIT_MINF 0
#endif
constexpr size_t WS_PART = 5 * MiB;
constexpr size_t WS_W = 8 * MiB;
constexpr size_t W_GU = WS_W, W_D = W_GU + 44 * MiB, W_RKVL = W_D + 22 * MiB, W_ORW = W_RKVL + 7 * MiB + 512 * 1024, W_LU = W_ORW + 2 * MiB, W_KV = W_LU + 1 * MiB + 512 * 1024, W_Q = W_KV + 4 * MiB, W_OAT = W_Q + 2 * MiB, W_END = W_OAT + 2 * MiB;
static_assert(W_END == 93 * MiB, "weight map");
constexpr size_t WS_U = 96 * MiB;
constexpr size_t S1 = (size_t)MP * 1024 * 2;
constexpr size_t U_XN = WS_U, U_H = WS_U + S1;
constexpr size_t U_A6 = WS_U, U_LOR = WS_U + 6 * S1;
constexpr size_t U_LOGW = WS_U, U_ASIG = WS_U + 2 * S1, U_G = WS_U + 3 * S1;
constexpr size_t U_BK = WS_U + 4 * S1, U_VT = WS_U + 6 * S1, U_SM = WS_U + 7 * S1;
constexpr size_t U_SPART = WS_U + 7 * S1;
constexpr size_t U_Y = WS_U + S1, U_YG = WS_U + 2 * S1;
constexpr size_t O_GAM = 42733568, O_BON = O_GAM + 1060864;
static_assert(O_BON + (size_t)MP * 16 <= O_WKVS && O_CKP + 3 * S1 / 4 == O_GAM, "d_out scratch");
constexpr size_t U_HNKV = WS_U + 4 * S1, U_KB = WS_U + 5 * S1, U_VB = WS_U + 6 * S1;
constexpr size_t U_HN1 = WS_U + 4 * S1, U_QB = WS_U, U_O1 = WS_U + S1, U_O2 = WS_U + 2 * S1, U_OA = WS_U + 3 * S1;
constexpr size_t WS_END = WS_U + 8 * S1;
static_assert(U_H + (size_t)MP * FF * 2 <= U_HNKV, "H overlay");
static_assert(U_LOR + 3 * (size_t)MP * 256 * 2 <= WS_END, "lora overlay");

__device__ __forceinline__ float* xrow_ptr(float* dout, float* xextra, int r) { return r < ROW_M ? dout + (size_t)r * D : xextra + (size_t)(r - ROW_M) * D; }


__device__ __forceinline__ const float* in_ptr(int i) {
    auto kp = (const float* const __attribute__((address_space(4)))*)__builtin_amdgcn_kernarg_segment_ptr();
    asm volatile("" : "+s"(kp));
    return kp[i];
}

__device__ __forceinline__ int mk_lane() { unsigned z = 0; asm volatile("" : "+v"(z)); return (int)__builtin_amdgcn_mbcnt_hi(~0u, __builtin_amdgcn_mbcnt_lo(~0u, z)); }
__device__ __forceinline__ int mk_tid(int wave) { return (wave << 6) | mk_lane(); }

namespace pg8 {
#define PG8_LAS __attribute__((address_space(3)))
typedef unsigned short bf16_t;
typedef short bf16x8 __attribute__((ext_vector_type(8)));
typedef float f32x4 __attribute__((ext_vector_type(4)));
typedef unsigned u32x4 __attribute__((ext_vector_type(4)));
constexpr int BM = 256, BK = 64, HALF = 128, HTB = HALF * BK * 2  , STAGE_BYTES = 8 * HTB, NXCD = 8, WGM = 8;

__host__ __device__ __forceinline__ int lds_byte(int r, int c) { const int st = (r >> 4) * 2 + (c >> 5), rr = r & 15, cc = c & 31, ob = rr * 64 + cc * 2; return st * 1024 + (ob ^ (((ob >> 9) & 1) << 5)); }
__host__ __device__ __forceinline__ void stage_rc(int b, int& R, int& C) { const int st = b / 1024, sb = b % 1024, swz = sb ^ (((sb >> 9) & 1) << 5); R = (st >> 1) * 16 + swz / 64; C = (st & 1) * 32 + (swz % 64) / 2; }
__host__ __device__ __forceinline__ int perm32(int rho) { const int n = rho >> 4, i = rho & 15; return 8 * (i >> 2) + 4 * n + (i & 3); }

struct Unit { int pm, pn; };
struct Gemm { const bf16_t* A; const bf16_t* Bt; int M, N, K; };

struct StaticOrder {
    int nM, nN, nwg, G, c;
    __host__ __device__ void init(int M, int N, int G_, int c_) { nM = M / BM; nN = N / BM; nwg = nM * nN; G = G_; c = c_; }
    __host__ __device__ bool next(int i, Unit& u) const {
        const long L = (long)i * G + c; if (L >= nwg) return false;
        int wgid = (int)L; { const int q = nwg / NXCD, r = nwg % NXCD, xcd = wgid % NXCD, off = wgid / NXCD; wgid = (xcd < r ? xcd * (q + 1) : r * (q + 1) + (xcd - r) * q) + off; }
        const int nig = WGM * nN, gid = wgid / nig, fm = gid * WGM, gsz = (nM - fm) < WGM ? (nM - fm) : WGM;
        u.pm = fm + ((wgid % nig) % gsz); u.pn = (wgid % nig) / gsz; return true;
    }
    __device__ __forceinline__ void a_ready(const Unit&) const {}
    __device__ __forceinline__ void done(const Unit&) const {}
};

typedef float f32x2 __attribute__((ext_vector_type(2)));
typedef __bf16 bf16x2_cv __attribute__((ext_vector_type(2)));
__device__ __forceinline__ unsigned cvt_pk_bf16(float lo, float hi) { const f32x2 v = {lo, hi}; const bf16x2_cv b = __builtin_convertvector(v, bf16x2_cv); return __builtin_bit_cast(unsigned, b); }

template <int nN, int mode, int nMt = NTM - 1> struct GSched {
    int G, c;
    __device__ __forceinline__ void init(int G_, int c_) { G = G_; c = c_; }
    __device__ __forceinline__ bool next(int i, Unit& u) const {
        const int nM = nMt, nwg = nM * nN;
        const long L = (long)i * G + c; if (L >= nwg) return false;
        int wgid = (int)L; { const int q = nwg / NXCD, r = nwg % NXCD, xcd = wgid % NXCD, off = wgid / NXCD; wgid = (xcd < r ? xcd * (q + 1) : r * (q + 1) + (xcd - r) * q) + off; }
        const int nig = WGM * nN, gid = wgid / nig, fm = gid * WGM, gsz = (nM - fm) < WGM ? (nM - fm) : WGM;
        const int pm = fm + ((wgid % nig) % gsz), ct = (wgid % nig) / gsz;
        int g = 0;
        if (mode == 1) g = (ct < 12) ? (ct >> 2) : (ct - 9); else if (mode == 2) g = ct >> 2;
        u.pm = pm + g * NTM; u.pn = ct; return true;
    }
    __device__ __forceinline__ void a_ready(const Unit&) const {}
    __device__ __forceinline__ void done(const Unit&) const {}
};

__device__ __forceinline__ float fast_sigmoid(float x) { return __builtin_amdgcn_rcpf(1.0f + __expf(-x)); }
__device__ __forceinline__ float fast_tanh(float x) { return 1.0f - 2.0f * __builtin_amdgcn_rcpf(__expf(2.0f * x) + 1.0f); }
typedef unsigned u32x2 __attribute__((ext_vector_type(2)));


enum { ET_SWIGLU = 0, ET_P4 = 1 };
template <int kind> struct EpiT {
    static constexpr bool PERM = true, AFTER_DRAIN = false;
    float scale; float* dout; unsigned char* ws; const float* pa; const float* pb;
    __device__ __forceinline__ void operator()(const f32x4 (&acc)[2][2][4][2], const Unit& u, int wr, int wc, int fr, int fq) const {
        if constexpr (kind == ET_SWIGLU) {
            bf16_t* O0 = (bf16_t*)(ws + U_H);
            const int row0 = u.pm * BM + wr * 64 + fr, hcol0 = (u.pn * BM + wc * 32 + 8 * fq) >> 1;
#pragma unroll
            for (int ai = 0; ai < 2; ++ai)
#pragma unroll
                for (int m = 0; m < 4; ++m) { bf16_t* rowp = O0 + (size_t)(row0 + ai * HALF + m * 16) * FF + hcol0;
#pragma unroll
                    for (int bj = 0; bj < 2; ++bj) { const f32x4 gt = acc[ai][bj][m][0], up = acc[ai][bj][m][1]; f32x4 h;
#pragma unroll
                        for (int e = 0; e < 4; ++e) h[e] = gt[e] * fast_sigmoid(gt[e]) * up[e];
                        u32x2 w; w.x = cvt_pk_bf16(h[0], h[1]); w.y = cvt_pk_bf16(h[2], h[3]);
                        *(u32x2*)(rowp + bj * (HALF / 2)) = w; } }
        } else {
            bf16_t* O0 = (bf16_t*)(dout + O_CKP); bf16_t* O1 = (bf16_t*)(ws + U_LOR);
            const int pn = u.pn; int g, pnl; if (pn < 12) { g = pn >> 2; pnl = pn & 3; } else { g = pn - 9; pnl = 0; }
            const int pml = u.pm - NTM * g, row0 = pml * BM + wr * 64 + fr, col0 = pnl * BM + wc * 32 + 8 * fq;
            bf16_t* base; int ldc, act;
            if (g < 3) { base = O0 + (size_t)g * MP * 1024; ldc = 1024; act = 0; } else { base = O1 + (size_t)(g - 3) * MP * 256; ldc = 256; act = (g == 3) ? 1 : ((g == 5) ? 2 : 0); }
#pragma unroll
            for (int ai = 0; ai < 2; ++ai)
#pragma unroll
                for (int m = 0; m < 4; ++m) { bf16_t* rowp = base + (size_t)(row0 + ai * HALF + m * 16) * ldc + col0;
#pragma unroll
                    for (int bj = 0; bj < 2; ++bj) { f32x4 v0 = acc[ai][bj][m][0], v1 = acc[ai][bj][m][1];
                        if (act == 1) {
#pragma unroll
                            for (int e = 0; e < 4; ++e) { v0[e] = fast_tanh(v0[e]); v1[e] = fast_tanh(v1[e]); } }
                        else if (act == 2) {
#pragma unroll
                            for (int e = 0; e < 4; ++e) { v0[e] = fast_sigmoid(v0[e]); v1[e] = fast_sigmoid(v1[e]); } }
                        u32x4 w; w.x = cvt_pk_bf16(v0[0], v0[1]); w.y = cvt_pk_bf16(v0[2], v0[3]); w.z = cvt_pk_bf16(v1[0], v1[1]); w.w = cvt_pk_bf16(v1[2], v1[3]);
                        *(u32x4*)(rowp + bj * HALF) = w; } }
        }
    }
};

enum { EF_RESID = 0, EF_P5 = 1, EF_KV = 2, EF_Q = 3, EF_P5A = 4, EF_P5G = 5, EF_P5ALL = 6 };
template <int kind> struct EpiF {
    static constexpr bool PERM = false, AFTER_DRAIN = false;
    float scale;
    float* dout; unsigned char* ws; const float* pa; const float* pb;
    __device__ __forceinline__ void operator()(const f32x4 (&acc)[2][2][4][2], const Unit& u, int wr, int wc, int fr, int fq) const {
        float* xextra = (float*)(ws + WS_XEXTRA);
        if constexpr (kind == EF_RESID) {
            const int row0 = u.pm * BM + wr * 64 + fr, col0 = u.pn * BM + wc * 32 + 4 * fq;
#pragma unroll
            for (int ai = 0; ai < 2; ++ai)
#pragma unroll
                for (int m = 0; m < 4; ++m) { unsigned short* rowp = (unsigned short*)xrow_ptr(dout, xextra, row0 + ai * HALF + m * 16) + col0;
#pragma unroll
                    for (int bj = 0; bj < 2; ++bj)
#pragma unroll
                        for (int n = 0; n < 2; ++n) { u32x2* p = (u32x2*)(rowp + bj * HALF + n * 16); const u32x2 t = *p;
                            const f32x4 a = acc[ai][bj][m][n];
                            u32x2 o; o.x = cvt_pk_bf16(__uint_as_float(t.x << 16) + a[0] * scale, __uint_as_float(t.x & 0xffff0000u) + a[1] * scale);
                            o.y = cvt_pk_bf16(__uint_as_float(t.y << 16) + a[2] * scale, __uint_as_float(t.y & 0xffff0000u) + a[3] * scale); *p = o; } }
        } else if constexpr (kind == EF_P5 || kind == EF_P5A || kind == EF_P5G || kind == EF_P5ALL) {
            const float* p0 = pa; const float* p1 = pb; float* f0 = (float*)(ws + U_LOGW); bf16_t* h0 = (bf16_t*)(ws + U_ASIG); bf16_t* h1 = (bf16_t*)(ws + U_G);
            const int g = (kind == EF_P5ALL) ? (u.pn >> 2) : (kind == EF_P5) ? 0 : (kind == EF_P5A ? 1 : 2); const int pnl = (kind == EF_P5ALL) ? (u.pn & 3) : u.pn, pml = (kind == EF_P5ALL) ? u.pm - NTM * g : u.pm, row0 = pml * BM + wr * 64 + fr, col0 = pnl * BM + wc * 32 + 4 * fq;
#pragma unroll
            for (int bj = 0; bj < 2; ++bj)
#pragma unroll
                for (int n = 0; n < 2; ++n) { const int c = col0 + bj * HALF + n * 16;
                    f32x4 bias = (f32x4){0.f, 0.f, 0.f, 0.f};
#ifndef PROBE_NO_BIAS
                    if (g == 0) bias = *(const f32x4*)(p0 + c); else if (g == 1) bias = *(const f32x4*)(p1 + c);
#endif
#pragma unroll
                    for (int ai = 0; ai < 2; ++ai)
#pragma unroll
                        for (int m = 0; m < 4; ++m) { const size_t off = (size_t)(row0 + ai * HALF + m * 16) * 1024 + c; const f32x4 v = acc[ai][bj][m][n] + bias;
                            if (g == 0) { f32x4 o;
#pragma unroll
                                for (int e = 0; e < 4; ++e) o[e] = -0.6065306597126334f * fast_sigmoid(v[e]);
                                u32x2 w; w.x = cvt_pk_bf16(o[0], o[1]); w.y = cvt_pk_bf16(o[2], o[3]); *(u32x2*)((bf16_t*)f0 + off) = w; }
                            else if (g == 1) { u32x2 w; w.x = cvt_pk_bf16(fast_sigmoid(v[0]), fast_sigmoid(v[1])); w.y = cvt_pk_bf16(fast_sigmoid(v[2]), fast_sigmoid(v[3])); *(u32x2*)(h0 + off) = w; }
                            else { u32x2 w; w.x = cvt_pk_bf16(v[0], v[1]); w.y = cvt_pk_bf16(v[2], v[3]); *(u32x2*)(h1 + off) = w; } } }
        } else {
            const bool isQ = (kind == EF_Q), isK = isQ || (u.pn < 4);
            const float* p0 = (const float*)(ws + WS_ROPE);
            bf16_t* h0 = (bf16_t*)(ws + (isQ ? U_QB : U_KB)); bf16_t* h1 = (bf16_t*)(ws + U_VB); bf16_t* h2 = (bf16_t*)(ws + WS_KMETA); bf16_t* h3 = (bf16_t*)(ws + WS_VMETA);
            const int colbase = (u.pn & 3) * BM + wc * 32 + 4 * fq;
            const bool ropew = isK && ((wc & 1) == 0);
#pragma unroll
            for (int ai = 0; ai < 2; ++ai)
#pragma unroll
                for (int m = 0; m < 4; ++m) {
                    const int row = u.pm * BM + ai * HALF + wr * 64 + m * 16 + fr;
                    int pos; float* fdst = nullptr; bf16_t* bdst = nullptr; bool valid = true;
                    if (row < ROW_S) { const int b = row >> 12, t = row & 4095; pos = 16 + t;
                        if (isQ) bdst = h0 + (size_t)row * 1024; else { fdst = dout + (isK ? O_CKP : O_CVP) + ((size_t)b * 4112 + 16 + t) * 1024; bdst = (isK ? h0 : h1) + (size_t)row * 1024; } }
                    else if (row < ROW_M) { const int i = row - ROW_S; pos = 2064 + (i & 15);
                        if (isQ) bdst = h0 + (size_t)row * 1024; else fdst = dout + (isK ? O_CKS : O_CVS) + (size_t)i * 1024; }
                    else if (row < ROW_END) { const int i = row - ROW_M, b = i >> 4, j = i & 15; pos = j;
                        if (isQ) bdst = h0 + (size_t)row * 1024; else { fdst = dout + (isK ? O_CKP : O_CVP) + ((size_t)b * 4112 + j) * 1024; bdst = (isK ? h2 : h3) + ((size_t)b * 128 + j) * 1024; } }
                    else { pos = 0; valid = false; }
                    f32x4 cs = (f32x4){1.f, 1.f, 1.f, 1.f}, sn = (f32x4){0.f, 0.f, 0.f, 0.f};
                    if (ropew) { cs = *(const f32x4*)(p0 + (size_t)pos * 16 + 4 * (fq & 1)); sn = *(const f32x4*)(p0 + (size_t)pos * 16 + 8 + 4 * (fq & 1)); }
#pragma unroll
                    for (int bj = 0; bj < 2; ++bj)
#pragma unroll
                        for (int n = 0; n < 2; ++n) { f32x4 v = acc[ai][bj][m][n];
                            if (n == 0 && ropew) { f32x4 pr;
#pragma unroll
                                for (int e = 0; e < 4; ++e) pr[e] = __shfl_xor(v[e], 32);
                                const float sg = (fq < 2) ? -1.f : 1.f;
#pragma unroll
                                for (int e = 0; e < 4; ++e) v[e] = v[e] * cs[e] + sg * pr[e] * sn[e]; }
                            if (isQ) v = v * scale;
                            const int c = colbase + bj * HALF + n * 16;
                            if (valid) { if (fdst) *(f32x4*)(fdst + c) = v;
                                if (bdst) { u32x2 w; w.x = cvt_pk_bf16(v[0], v[1]); w.y = cvt_pk_bf16(v[2], v[3]); *(u32x2*)(bdst + c) = w; } } }
                }
        }
    }
};
template <class Epi, class Sched, bool ALIGN_EPI = false, bool SP2 = false>
__device__ __forceinline__ void gemm_phase(PG8_LAS unsigned char* lds, const Gemm g, const Sched& S, const Epi& E, const int tid) {
    const int wid = __builtin_amdgcn_readfirstlane(tid >> 6), lane = tid & 63, wr = wid >> 2, wc = wid & 3, fr = lane & 15, fq = lane >> 4;
    const int K = g.K, nt = K / BK;
    unsigned voffA[2], voffB[2];
#pragma unroll
    for (int i = 0; i < 2; ++i) { int R, C; stage_rc(tid * 16 + i * 8192, R, C); const int Rb = Epi::PERM ? ((R & ~31) + perm32(R & 31)) : R;
        voffA[i] = (unsigned)(R * K + C) * 2u; voffB[i] = (unsigned)(Rb * K + C) * 2u; }
    const size_t kstep = (size_t)(BK * 2);
    const size_t hstep = (size_t)HALF * K * 2;
    const size_t tstep = 2 * hstep;
    const unsigned ldsw = (unsigned)wid * 1024u;
    const int aoff = lds_byte(wr * 64 + fr, fq * 8), boff = lds_byte(wc * 32 + fr, fq * 8);
#define PG8_SA(b, h) (((b) * 2 + (h)) * HTB)
#define PG8_SB(b, h) ((4 + (b) * 2 + (h)) * HTB)
#define PG8_STAGE(bufoff, gbase, voff) do { _Pragma("unroll") for (int _i = 0; _i < 2; ++_i) \
        __builtin_amdgcn_global_load_lds((const unsigned*)((const char*)(gbase) + (voff)[_i]), (PG8_LAS unsigned*)(lds + (bufoff) + ldsw + _i * 8192), 16, 0, 0); } while (0)
#define PG8_LDA(dst, b, h) do { _Pragma("unroll") for (int m = 0; m < 4; ++m) _Pragma("unroll") for (int k = 0; k < 2; ++k) dst[m][k] = *(const PG8_LAS bf16x8*)(lds + PG8_SA(b, h) + aoff + m * 2048 + k * 1024); } while (0)
#define PG8_LDB(dst, b, h) do { _Pragma("unroll") for (int n = 0; n < 2; ++n) _Pragma("unroll") for (int k = 0; k < 2; ++k) dst[n][k] = *(const PG8_LAS bf16x8*)(lds + PG8_SB(b, h) + boff + n * 2048 + k * 1024); } while (0)
#define PG8_MMA(ai, bj, At, Bt) do { __builtin_amdgcn_s_setprio(1); _Pragma("unroll") for (int m = 0; m < 4; ++m) _Pragma("unroll") for (int n = 0; n < 2; ++n) _Pragma("unroll") for (int k = 0; k < 2; ++k) \
        acc[ai][bj][m][n] = __builtin_amdgcn_mfma_f32_16x16x32_bf16(Bt[n][k], At[m][k], acc[ai][bj][m][n], 0, 0, 0); __builtin_amdgcn_s_setprio(0); } while (0)
#define PG8_WAIT_V(n) asm volatile("s_waitcnt vmcnt(" #n ")" ::: "memory")
#define PG8_WAIT_L(n) asm volatile("s_waitcnt lgkmcnt(" #n ")" ::: "memory")
#define PG8_BAR __builtin_amdgcn_s_barrier()
#define PG8_SCHED __builtin_amdgcn_sched_barrier(0)
    Unit cur, nxt; int ui = 0;
    if (!S.next(0, cur)) return;
    f32x4 acc[2][2][4][2];
#pragma unroll
    for (int a = 0; a < 2; ++a)
#pragma unroll
        for (int b = 0; b < 2; ++b)
#pragma unroll
            for (int m = 0; m < 4; ++m)
#pragma unroll
                for (int n = 0; n < 2; ++n) acc[a][b][m][n] = (f32x4){0.f, 0.f, 0.f, 0.f};
    bf16x8 At[4][2], B0[2][2], B1[2][2];
    const char* cA = (const char*)g.A + (size_t)cur.pm * tstep; const char* cB = (const char*)g.Bt + (size_t)cur.pn * tstep;
    S.a_ready(cur);
    if constexpr (SP2) {
        PG8_STAGE(PG8_SB(0, 0), cB, voffB); PG8_STAGE(PG8_SB(0, 1), cB + hstep, voffB); PG8_STAGE(PG8_SA(0, 0), cA, voffA); PG8_STAGE(PG8_SA(0, 1), cA + hstep, voffA);
        if (wr == 1) PG8_BAR;
        PG8_WAIT_V(2); PG8_BAR;
        PG8_STAGE(PG8_SB(1, 0), cB + kstep, voffB); PG8_STAGE(PG8_SA(1, 0), cA + kstep, voffA); PG8_STAGE(PG8_SB(1, 1), cB + hstep + kstep, voffB);
        PG8_WAIT_V(6); PG8_BAR;
    } else {
        PG8_STAGE(PG8_SB(0, 0), cB, voffB); PG8_STAGE(PG8_SA(0, 0), cA, voffA); PG8_STAGE(PG8_SB(0, 1), cB + hstep, voffB); PG8_STAGE(PG8_SA(0, 1), cA + hstep, voffA);
        if (wr == 1) PG8_BAR;
        PG8_WAIT_V(4); PG8_BAR;
        PG8_STAGE(PG8_SB(1, 0), cB + kstep, voffB); PG8_STAGE(PG8_SA(1, 0), cA + kstep, voffA); PG8_STAGE(PG8_SB(1, 1), cB + hstep + kstep, voffB);
        PG8_WAIT_V(6); PG8_BAR;
    }
    for (;;) {
        const bool has_next = S.next(ui + 1, nxt);
        const char* nA = has_next ? (const char*)g.A + (size_t)nxt.pm * tstep : cA; const char* nB = has_next ? (const char*)g.Bt + (size_t)nxt.pn * tstep : cB;
        for (int t = 0; t < nt; t += 2) {
            const bool last = (t == nt - 2);
            const char* a1 = cA + (size_t)(t + 1) * kstep;
            const char* a2 = last ? nA : cA + (size_t)(t + 2) * kstep; const char* b2 = last ? nB : cB + (size_t)(t + 2) * kstep;
            const char* a3 = a2 + kstep; const char* b3 = b2 + kstep;
            if (last && has_next) S.a_ready(nxt);
            if constexpr (SP2) {
            PG8_LDB(B0, 0, 0); PG8_LDB(B1, 0, 1); PG8_SCHED; PG8_LDA(At, 0, 0); PG8_STAGE(PG8_SA(1, 1), a1 + hstep, voffA);
            PG8_WAIT_V(8); PG8_WAIT_L(0); PG8_BAR; PG8_MMA(0, 0, At, B0); PG8_MMA(0, 1, At, B1); PG8_BAR; PG8_SCHED;
            PG8_LDA(At, 0, 1); PG8_STAGE(PG8_SB(0, 0), b2, voffB); PG8_STAGE(PG8_SB(0, 1), b2 + hstep, voffB); PG8_STAGE(PG8_SA(0, 0), a2, voffA);
            PG8_WAIT_V(8); PG8_WAIT_L(0); PG8_BAR; PG8_MMA(1, 0, At, B0); PG8_MMA(1, 1, At, B1); PG8_BAR; PG8_SCHED;
            PG8_LDB(B0, 1, 0); PG8_LDB(B1, 1, 1); PG8_SCHED; PG8_LDA(At, 1, 0); PG8_STAGE(PG8_SA(0, 1), a2 + hstep, voffA);
            PG8_WAIT_V(8); PG8_WAIT_L(0); PG8_BAR; PG8_MMA(0, 0, At, B0); PG8_MMA(0, 1, At, B1); PG8_BAR; PG8_SCHED;
            PG8_LDA(At, 1, 1); PG8_STAGE(PG8_SB(1, 0), b3, voffB); PG8_STAGE(PG8_SB(1, 1), b3 + hstep, voffB); PG8_STAGE(PG8_SA(1, 0), a3, voffA);
            PG8_WAIT_V(8); PG8_WAIT_L(0); PG8_BAR; PG8_MMA(1, 0, At, B0); PG8_MMA(1, 1, At, B1); PG8_BAR; PG8_SCHED;
            } else {
            PG8_LDB(B0, 0, 0); PG8_SCHED; PG8_LDA(At, 0, 0); PG8_STAGE(PG8_SA(1, 1), a1 + hstep, voffA);
            PG8_WAIT_L(8); PG8_BAR; PG8_WAIT_L(0); PG8_MMA(0, 0, At, B0); PG8_BAR; PG8_SCHED;
            PG8_LDB(B1, 0, 1); PG8_STAGE(PG8_SB(0, 0), b2, voffB);
            PG8_BAR; PG8_WAIT_L(0); PG8_MMA(0, 1, At, B1); PG8_BAR;
            PG8_LDA(At, 0, 1); PG8_STAGE(PG8_SA(0, 0), a2, voffA);
            PG8_BAR; PG8_WAIT_L(0); PG8_MMA(1, 0, At, B0); PG8_BAR; PG8_SCHED;
            PG8_STAGE(PG8_SB(0, 1), b2 + hstep, voffB);
            PG8_WAIT_V(6); PG8_BAR; PG8_MMA(1, 1, At, B1); PG8_BAR;
            PG8_LDB(B0, 1, 0); PG8_SCHED; PG8_LDA(At, 1, 0); PG8_STAGE(PG8_SA(0, 1), a2 + hstep, voffA);
            PG8_WAIT_L(8); PG8_BAR; PG8_WAIT_L(0); PG8_MMA(0, 0, At, B0); PG8_BAR; PG8_SCHED;
            PG8_LDB(B1, 1, 1); PG8_STAGE(PG8_SB(1, 0), b3, voffB);
            PG8_BAR; PG8_WAIT_L(0); PG8_MMA(0, 1, At, B1); PG8_BAR;
            PG8_LDA(At, 1, 1); PG8_STAGE(PG8_SA(1, 0), a3, voffA);
            PG8_BAR; PG8_WAIT_L(0); PG8_MMA(1, 0, At, B0); PG8_BAR; PG8_SCHED;
            PG8_STAGE(PG8_SB(1, 1), b3 + hstep, voffB);
            PG8_WAIT_V(6); PG8_BAR; PG8_MMA(1, 1, At, B1); PG8_BAR;
            }
        }
        if constexpr (ALIGN_EPI) { if (wr == 0) PG8_BAR; }
        if constexpr (!Epi::AFTER_DRAIN) { E(acc, cur, wr, wc, fr, fq); S.done(cur); }
        if (!has_next) break;
#pragma unroll
        for (int a = 0; a < 2; ++a)
#pragma unroll
            for (int b = 0; b < 2; ++b)
#pragma unroll
                for (int m = 0; m < 4; ++m)
#pragma unroll
                    for (int n = 0; n < 2; ++n) acc[a][b][m][n] = (f32x4){0.f, 0.f, 0.f, 0.f};
        cur = nxt; cA = nA; cB = nB; ++ui;
        if constexpr (ALIGN_EPI) { if (wr == 1) PG8_BAR; }
    }
    PG8_WAIT_V(0);
    if constexpr (!ALIGN_EPI) { if (wr == 0) PG8_BAR; }
    PG8_BAR;
    if constexpr (Epi::AFTER_DRAIN) { E.fused(acc, cur, wr, wc, fr, fq, lds, wid, lane); S.done(cur); }
#undef PG8_SA
#undef PG8_SB
#undef PG8_STAGE
#undef PG8_LDA
#undef PG8_LDB
#undef PG8_MMA
#undef PG8_WAIT_V
#undef PG8_WAIT_L
#undef PG8_BAR
#undef PG8_SCHED
}
}
#include <hip/hip_bf16.h>
#include <cmath>
namespace attn_body {
using bf16=__hip_bfloat16;
using bf16x8=__attribute__((ext_vector_type(8)))short;
using s16x4=__attribute__((ext_vector_type(4)))short;
using f32x16=__attribute__((ext_vector_type(16)))float;
using u32x4=__attribute__((ext_vector_type(4)))unsigned;
constexpr int BATCH=4,NHEAD=16,SEQ=4096,D=64,DM=NHEAD*D;
constexpr int NW=8,QBLK=32,QB=QBLK*NW,KVBLK=64,NQB=SEQ/QB;
constexpr int ATTN_PITCH=DM, ATTN_UNIT_ROWS=QB;
__device__ __forceinline__ int crow(int r,int hi){return (r&3)+8*(r>>2)+4*hi;}
#define SBAR() __builtin_amdgcn_sched_barrier(0)
__device__ __forceinline__ void bmask(f32x16&p0,f32x16&p1,int jb,int wid,int hi){
  const float NEG=-INFINITY;
  const bool all=(jb<4)?(jb>(wid>>1)):(jb==5); const bool meta=(jb==4);
  const bool m0lo=all, m0hi=all||meta, m1=all||meta;
  #pragma unroll
  for(int r=0;r<8;++r)p0[r]=m0lo?NEG:p0[r];
  #pragma unroll
  for(int r=8;r<16;++r)p0[r]=m0hi?NEG:p0[r];
  #pragma unroll
  for(int r=0;r<16;++r)p1[r]=m1?NEG:p1[r];
}

constexpr int NSLOT=3, SLOTB=8192;
constexpr int LDS_K=0, LDS_V=NSLOT*SLOTB, LDS_WS=3*NSLOT*SLOTB, LDS_OST=LDS_WS+NW*64*4, LDS_BYTES=LDS_OST+NW*4096;
constexpr float C2=0.125f*1.4426950408889634f;
__device__ __forceinline__ void glds16(const void*gsrc,unsigned lds_dst){unsigned keep;
  asm volatile("s_mov_b32 %0, m0\n\ts_mov_b32 m0, %2\n\ts_nop 0\n\tglobal_load_lds_dwordx4 %1, off\n\ts_mov_b32 m0, %0":"=&s"(keep):"v"(gsrc),"s"(lds_dst):"memory");}
__device__ __forceinline__ float max3f(float a,float b,float c){float r;asm("v_max3_f32 %0, %1, %2, %3":"=v"(r):"v"(a),"v"(b),"v"(c));return r;}
__device__ __forceinline__ float max2f(float a,float b){float r;asm("v_max_f32_e32 %0, %1, %2":"=v"(r):"v"(a),"v"(b));return r;}
__device__ __forceinline__ float fadd_s(float a,float b){float r;asm("v_add_f32_e32 %0, %1, %2":"=v"(r):"v"(a),"v"(b));return r;}
__device__ __forceinline__ float fsub_s(float a,float b){float r;asm("v_sub_f32_e32 %0, %1, %2":"=v"(r):"v"(a),"v"(b));return r;}
typedef float f32x2_t __attribute__((ext_vector_type(2))); typedef __bf16 bf16x2_t __attribute__((ext_vector_type(2)));
__device__ __forceinline__ unsigned cvtpk_s(float lo,float hi){f32x2_t v={lo,hi};bf16x2_t b=__builtin_convertvector(v,bf16x2_t);return __builtin_bit_cast(unsigned,b);}
#define WAIT_BAR(N) asm volatile("s_waitcnt vmcnt(" #N ") lgkmcnt(0)\n\ts_barrier":::"memory")

__device__ __forceinline__ void qkt(f32x16&p0,f32x16&p1,const char*Kslot,const bf16x8*qr,int r32,int hi){ const f32x16 negm=f32x16{};
  const char*kb=Kslot+hi*1024+r32*16;
  #pragma unroll
  for(int d0=0;d0<4;++d0){
    const bf16x8 b0=*reinterpret_cast<const bf16x8*>(kb+d0*2048);
    const bf16x8 b1=*reinterpret_cast<const bf16x8*>(kb+d0*2048+512);
    if(d0==0){p0=__builtin_amdgcn_mfma_f32_32x32x16_bf16(b0,qr[0],negm,0,0,0);p1=__builtin_amdgcn_mfma_f32_32x32x16_bf16(b1,qr[0],negm,0,0,0);}
    else{p0=__builtin_amdgcn_mfma_f32_32x32x16_bf16(b0,qr[d0],p0,0,0,0);p1=__builtin_amdgcn_mfma_f32_32x32x16_bf16(b1,qr[d0],p1,0,0,0);}}
}
typedef __attribute__((address_space(3))) const char* lds_cptr;
typedef short v4i16_t __attribute__((ext_vector_type(4)));
__device__ __forceinline__ void kload8(bf16x8*kf,lds_cptr kp){
  kf[0]=*(const __attribute__((address_space(3))) bf16x8*)(kp);      kf[1]=*(const __attribute__((address_space(3))) bf16x8*)(kp+512);
  kf[2]=*(const __attribute__((address_space(3))) bf16x8*)(kp+2048); kf[3]=*(const __attribute__((address_space(3))) bf16x8*)(kp+2560);
  kf[4]=*(const __attribute__((address_space(3))) bf16x8*)(kp+4096); kf[5]=*(const __attribute__((address_space(3))) bf16x8*)(kp+4608);
  kf[6]=*(const __attribute__((address_space(3))) bf16x8*)(kp+6144); kf[7]=*(const __attribute__((address_space(3))) bf16x8*)(kp+6656);
}
__device__ __forceinline__ void kload2(bf16x8*kf,lds_cptr kp,int j){ kf[2*j]=*(const __attribute__((address_space(3))) bf16x8*)(kp+j*2048); kf[2*j+1]=*(const __attribute__((address_space(3))) bf16x8*)(kp+j*2048+512); }
__device__ __forceinline__ s16x4 vtr(lds_cptr p){ return __builtin_bit_cast(s16x4,__builtin_amdgcn_ds_read_tr16_b64_v4i16((__attribute__((address_space(3))) v4i16_t*)p)); }
__device__ __forceinline__ float rowmax(const f32x16&p0,const f32x16&p1){
  float a=max3f(p0[0],p0[1],p1[0]),b=max3f(p0[2],p0[3],p1[1]);a=max3f(a,p1[2],p1[3]);
  #pragma unroll
  for(int r=4;r<16;r+=4){a=max3f(a,p0[r],p0[r+1]);b=max3f(b,p0[r+2],p0[r+3]);a=max3f(a,p1[r],p1[r+1]);b=max3f(b,p1[r+2],p1[r+3]);}
  const float m=max2f(a,b);
  auto rr=__builtin_amdgcn_permlane32_swap(__float_as_uint(m),__float_as_uint(m),false,false);
  return max2f(__uint_as_float(rr[0]),__uint_as_float(rr[1]));
}
__device__ __forceinline__ void pv(f32x16*o,int vb,bf16x8 pa0,bf16x8 pa1,bf16x8 pa2,bf16x8 pa3){
  #pragma unroll
  for(int d0=0;d0<2;++d0){s16x4 lo[4],hi[4];
    #pragma unroll
    for(int ks=0;ks<4;++ks){
      asm volatile("ds_read_b64_tr_b16 %0,%1 offset:%c2":"=&v"(lo[ks]):"v"(vb),"i"(d0*4096+ks*1024):"memory");
      asm volatile("ds_read_b64_tr_b16 %0,%1 offset:%c2":"=&v"(hi[ks]):"v"(vb),"i"(d0*4096+ks*1024+512):"memory");}
    asm volatile("s_waitcnt lgkmcnt(0)":::"memory");SBAR();
    #define PK(k) (bf16x8){lo[k][0],lo[k][1],lo[k][2],lo[k][3],hi[k][0],hi[k][1],hi[k][2],hi[k][3]}
    o[d0]=__builtin_amdgcn_mfma_f32_32x32x16_bf16(pa0,PK(0),o[d0],0,0,0);
    o[d0]=__builtin_amdgcn_mfma_f32_32x32x16_bf16(pa1,PK(1),o[d0],0,0,0);
    o[d0]=__builtin_amdgcn_mfma_f32_32x32x16_bf16(pa2,PK(2),o[d0],0,0,0);
    o[d0]=__builtin_amdgcn_mfma_f32_32x32x16_bf16(pa3,PK(3),o[d0],0,0,0);
    #undef PK
  }
}

#ifndef ATTN_STORE16
#define ATTN_STORE16(p,v) (*(u32x4*)(p)=(v))
#endif
template<int THRL> __device__ __forceinline__ void attn_unit(int b,int h,int hv,int qb,const unsigned char*wsb,long oQ,long oK,long oV,long oKM,long oVM,long oO,char*shm,const int tid){
  const bf16*Q=(const bf16*)(wsb+oQ); const bf16*__restrict__ K=(const bf16*)(wsb+oK); const bf16*__restrict__ V=(const bf16*)(wsb+oV); const bf16*__restrict__ KM=(const bf16*)(wsb+oKM); const bf16*__restrict__ VM=(const bf16*)(wsb+oVM); bf16*O=(bf16*)(wsb+oO);
  const int lane=tid&63,r32=lane&31,hi=lane>>5; const int wid=__builtin_amdgcn_readfirstlane(tid>>6);
  const long rowbase=(long)b*SEQ; const int q0=qb*QB;
  const bf16*Qw=Q+(rowbase+q0+wid*QBLK)*DM+h*D;
  const bf16*Kh=K+rowbase*DM+h*D,*Vh=V+rowbase*DM+hv*D;
  const unsigned lds0=(unsigned)(uintptr_t)shm;
  float*wsf=(float*)(shm+LDS_WS)+wid*64;
  const bf16*ksrc=Kh+(long)lane*DM+wid*8;
  const bf16*vsrc=Vh+(long)(16*(wid&3)+(lane>>2))*DM+(wid>>2)*32+(lane&3)*8;
  const long dKm=(long)(KM-K)+((long)b*128-rowbase)*DM, dVm=(long)(VM-V)+((long)b*128-rowbase)*DM;
  const int NTF=(q0+QB)/KVBLK, NT=NTF+2;
  const unsigned kdst=lds0+LDS_K+wid*1024, vdst=lds0+LDS_V+wid*1024;
  #define DMA_K(t,slot) glds16(ksrc+(((t)<NTF)?(long)(t)*KVBLK*DM:dKm+(long)((t)-NTF)*KVBLK*DM),(unsigned)__builtin_amdgcn_readfirstlane(kdst+(slot)))
  #define DMA_V(t,slot) do{ const bf16*vs_=vsrc+(((t)<NTF)?(long)(t)*KVBLK*DM:dVm+(long)((t)-NTF)*KVBLK*DM); const unsigned vd_=(unsigned)__builtin_amdgcn_readfirstlane(vdst+2*(slot)); glds16(vs_,vd_); glds16(vs_+64,vd_+8192); }while(0)
  const int vb0=(int)(lds0+LDS_V)+((lane>>4)&1)*32+(lane&3)*8+(4*hi+((lane&15)>>2))*64;
  const char*Kbase=shm+LDS_K; bf16x8 kf[8];
  const lds_cptr shm3=(lds_cptr)shm; const lds_cptr kp0=shm3+LDS_K+hi*1024+r32*16; const lds_cptr vp0=shm3+LDS_V+((lane>>4)&1)*32+(lane&3)*8+(4*hi+((lane&15)>>2))*64;
  DMA_K(0,0);DMA_V(0,0);DMA_K(1,SLOTB);
  bf16x8 qr[4];
  #pragma unroll
  for(int d0=0;d0<4;++d0)qr[d0]=*reinterpret_cast<const bf16x8*>(&Qw[(long)r32*DM+d0*16+hi*8]);
  float mhat=0.f,l_reg=0.f;f32x16 o[4];o[0]=f32x16{};o[1]=f32x16{};o[2]=f32x16{};o[3]=f32x16{};
  #define CMASK(P0,P1,t) do{int jb_=(t)-(NT-6); if(jb_>=0)bmask(P0,P1,jb_,wid,hi);}while(0)
  bool resc=false;
  #define START(P0,P1) do{ const float rm=rowmax(P0,P1); resc=false; \
    { const float dl=rm; mhat=fadd_s(mhat,dl); \
      _Pragma("unroll") for(int r=0;r<16;++r){P0[r]=fsub_s(P0[r],dl);P1[r]=fsub_s(P1[r],dl);} \
      } \
    _Pragma("unroll") for(int r=0;r<16;++r)P0[r]=__builtin_amdgcn_exp2f(P0[r]); }while(0)
  #define RESC() do{ if(resc){ asm volatile("s_waitcnt lgkmcnt(0)":::"memory"); \
      _Pragma("unroll") for(int d_=0;d_<4;++d_) _Pragma("unroll") for(int r=0;r<16;++r)o[d_][r]*=wsf[crow(r,hi)]; } }while(0)
  f32x16 pA0,pA1,pB0,pB1;
  int sl_prev=0,sl_cur=0,sl_next=SLOTB;
  #define ROT() do{sl_prev=sl_cur;sl_cur=sl_next;sl_next=(sl_next==(NSLOT-1)*SLOTB)?0:sl_next+SLOTB;}while(0)
  DMA_K(2,2*SLOTB);
  WAIT_BAR(3);
  qkt(pA0,pA1,Kbase,qr,r32,hi);asm volatile("s_nop 15\n\ts_nop 7":"+v"(pA0),"+v"(pA1));CMASK(pA0,pA1,0);
  START(pA0,pA1);
  _Pragma("unroll") for(int r=0;r<16;++r)pA1[r]=__builtin_amdgcn_exp2f(pA1[r]);
  WAIT_BAR(0);
  DMA_K(3,0);DMA_V(1,SLOTB);
  ROT();
  kload8(kf,kp0+sl_cur);
  WAIT_BAR(3);
  s16x4 vlo[8],vhi[8]; u32x4 pw0,pw1,pw2,pw3;
  #define PKW(P,B) cvtpk_s(P[B],P[B+1])
  #define PAF(k) __builtin_bit_cast(bf16x8,pw##k)
  #define VFR(i) (bf16x8){vlo[i][0],vlo[i][1],vlo[i][2],vlo[i][3],vhi[i][0],vhi[i][1],vhi[i][2],vhi[i][3]}
  #define PIN(x) asm volatile("":"+v"(x))
  #define MX3(a,b,c) __builtin_fmaxf(__builtin_fmaxf((a),(b)),(c))
  #define GAPA(MF,A0,A1,A2,A3,W0,W1,PW) do{ MF; sacc+=A0; sacc+=A1; sacc+=A2; sacc+=A3; PIN(sacc); W0; W1; PIN(PW); SBAR(); }while(0)
  #define EX(v) __builtin_amdgcn_exp2f(v)
  #define GAPB(MF,X,B) do{ MF; X[B]=EX(X[B]); X[B+1]=EX(X[B+1]); X[B+2]=EX(X[B+2]); X[B+3]=EX(X[B+3]); PIN(X); SBAR(); }while(0)
  #define VRD(i) do{ vlo[i]=vtr(vp_+(((i)>>2)*4096+((i)&3)*1024)); vhi[i]=vtr(vp_+(((i)>>2)*4096+((i)&3)*1024+512)); }while(0)
  #define VRD2(i) do{ vlo[i]=vtr(vp_+(8192+((i)>>2)*4096+((i)&3)*1024)); vhi[i]=vtr(vp_+(8192+((i)>>2)*4096+((i)&3)*1024+512)); }while(0)
  #define GAPC(MF,X,B,RL) do{ MF; X[B]=EX(X[B]-mhat); X[B+1]=EX(X[B+1]-mhat); PIN(X); RL; SBAR(); }while(0)
  #define KRD(G,j) do{ if(G){ kload2(kf,kp0+sl_next,j); SBAR(); } }while(0)
  #define STEP(C0,C1,P0,P1,t,GK,GV,GL) do{ SBAR(); \
    const lds_cptr vp_=vp0+2*sl_prev; \
    VRD(0); SBAR(); float sacc=(P0[0]+P0[1]); \
    GAPA(C0=__builtin_amdgcn_mfma_f32_32x32x16_bf16(kf[0],qr[0],(f32x16{}),0,0,0), P0[2],P0[3],P0[4],P0[5],     pw0[0]=PKW(P0,0), pw0[1]=PKW(P0,2), pw0); \
    VRD(4); SBAR(); GAPA(C1=__builtin_amdgcn_mfma_f32_32x32x16_bf16(kf[1],qr[0],(f32x16{}),0,0,0), P0[6],P0[7],P0[8],P0[9],     pw0[2]=PKW(P0,4), pw0[3]=PKW(P0,6), pw0); \
    VRD(1); SBAR(); GAPA(C0=__builtin_amdgcn_mfma_f32_32x32x16_bf16(kf[2],qr[1],C0,0,0,0),   P0[10],P0[11],P0[12],P0[13], pw1[0]=PKW(P0,8), pw1[1]=PKW(P0,10), pw1); \
    VRD(5); SBAR(); GAPA(C1=__builtin_amdgcn_mfma_f32_32x32x16_bf16(kf[3],qr[1],C1,0,0,0),   P0[14],P0[15],P1[0],P1[1],   pw1[2]=PKW(P0,12),pw1[3]=PKW(P0,14), pw1); \
    VRD(2); SBAR(); GAPA(C0=__builtin_amdgcn_mfma_f32_32x32x16_bf16(kf[4],qr[2],C0,0,0,0),   P1[2],P1[3],P1[4],P1[5],     pw2[0]=PKW(P1,0), pw2[1]=PKW(P1,2), pw2); \
    VRD(6); SBAR(); GAPA(C1=__builtin_amdgcn_mfma_f32_32x32x16_bf16(kf[5],qr[2],C1,0,0,0),   P1[6],P1[7],P1[8],P1[9],     pw2[2]=PKW(P1,4), pw2[3]=PKW(P1,6), pw2); \
    VRD(3); SBAR(); GAPA(C0=__builtin_amdgcn_mfma_f32_32x32x16_bf16(kf[6],qr[3],C0,0,0,0),   P1[10],P1[11],P1[12],P1[13], pw3[0]=PKW(P1,8), pw3[1]=PKW(P1,10), pw3); \
    VRD(7); SBAR(); GAPA(C1=__builtin_amdgcn_mfma_f32_32x32x16_bf16(kf[7],qr[3],C1,0,0,0),   P1[14],P1[15],0.f,0.f,       pw3[2]=PKW(P1,12),pw3[3]=PKW(P1,14), pw3); \
    l_reg+=sacc; \
    if(GK){DMA_K((t)+3,sl_cur);} if(GV){DMA_V((t)+1,sl_next);} \
    CMASK(C0,C1,t); \
    { float a=MX3(C0[0],C0[1],C1[0]),b=MX3(C0[2],C0[3],C1[1]); a=MX3(a,C1[2],C1[3]); \
      _Pragma("unroll") for(int r=4;r<16;r+=4){a=MX3(a,C0[r],C0[r+1]);b=MX3(b,C0[r+2],C0[r+3]);a=MX3(a,C1[r],C1[r+1]);b=MX3(b,C1[r+2],C1[r+3]);} \
      float rm=__builtin_fmaxf(a,b); { auto rr=__builtin_amdgcn_permlane32_swap(__float_as_uint(rm),__float_as_uint(rm),false,false); rm=__builtin_fmaxf(__uint_as_float(rr[0]),__uint_as_float(rr[1]))-mhat; } \
      resc=false; \
      if(__builtin_expect(__any(rm>(float)THRL),0)){ const float dl=__builtin_fmaxf(rm,0.f); mhat+=dl; \
        const float f=__builtin_amdgcn_exp2f(-dl); l_reg*=f; if(hi==0)wsf[r32]=f; resc=true; } } \
    SBAR(); \
    GAPC(o[0]=__builtin_amdgcn_mfma_f32_32x32x16_bf16(PAF(0),VFR(0),o[0],0,0,0), C0,0, VRD2(0)); \
    GAPC(o[1]=__builtin_amdgcn_mfma_f32_32x32x16_bf16(PAF(0),VFR(4),o[1],0,0,0), C0,2, VRD2(4)); \
    KRD(GL,0); GAPC(o[0]=__builtin_amdgcn_mfma_f32_32x32x16_bf16(PAF(1),VFR(1),o[0],0,0,0), C0,4, VRD2(1)); \
    KRD(GL,1); GAPC(o[1]=__builtin_amdgcn_mfma_f32_32x32x16_bf16(PAF(1),VFR(5),o[1],0,0,0), C0,6, VRD2(5)); \
    KRD(GL,2); GAPC(o[0]=__builtin_amdgcn_mfma_f32_32x32x16_bf16(PAF(2),VFR(2),o[0],0,0,0), C0,8, VRD2(2)); \
    KRD(GL,3); GAPC(o[1]=__builtin_amdgcn_mfma_f32_32x32x16_bf16(PAF(2),VFR(6),o[1],0,0,0), C0,10, VRD2(6)); \
    GAPC(o[0]=__builtin_amdgcn_mfma_f32_32x32x16_bf16(PAF(3),VFR(3),o[0],0,0,0), C0,12, VRD2(3)); \
    GAPC(o[1]=__builtin_amdgcn_mfma_f32_32x32x16_bf16(PAF(3),VFR(7),o[1],0,0,0), C0,14, VRD2(7)); \
    GAPC(o[2]=__builtin_amdgcn_mfma_f32_32x32x16_bf16(PAF(0),VFR(0),o[2],0,0,0), C1,0, (void)0); \
    GAPC(o[3]=__builtin_amdgcn_mfma_f32_32x32x16_bf16(PAF(0),VFR(4),o[3],0,0,0), C1,2, (void)0); \
    GAPC(o[2]=__builtin_amdgcn_mfma_f32_32x32x16_bf16(PAF(1),VFR(1),o[2],0,0,0), C1,4, (void)0); \
    GAPC(o[3]=__builtin_amdgcn_mfma_f32_32x32x16_bf16(PAF(1),VFR(5),o[3],0,0,0), C1,6, (void)0); \
    GAPC(o[2]=__builtin_amdgcn_mfma_f32_32x32x16_bf16(PAF(2),VFR(2),o[2],0,0,0), C1,8, (void)0); \
    GAPC(o[3]=__builtin_amdgcn_mfma_f32_32x32x16_bf16(PAF(2),VFR(6),o[3],0,0,0), C1,10, (void)0); \
    GAPC(o[2]=__builtin_amdgcn_mfma_f32_32x32x16_bf16(PAF(3),VFR(3),o[2],0,0,0), C1,12, (void)0); \
    GAPC(o[3]=__builtin_amdgcn_mfma_f32_32x32x16_bf16(PAF(3),VFR(7),o[3],0,0,0), C1,14, (void)0); \
    }while(0)
  int t=1;
  #undef CMASK
  #define CMASK(P0,P1,t) do{}while(0)
  for(;t+7<NT;t+=2){
    STEP(pB0,pB1,pA0,pA1,t,true,true,true);     WAIT_BAR(3); RESC(); ROT();
    STEP(pA0,pA1,pB0,pB1,t+1,true,true,true);   WAIT_BAR(3); RESC(); ROT();
  }
  #undef CMASK
  #define CMASK(P0,P1,t) do{int jb_=(t)-(NT-6); if(jb_>=0)bmask(P0,P1,jb_,wid,hi);}while(0)
  #define ENDW(tt) do{ if((tt)+3<NT){WAIT_BAR(3);} else if((tt)+2<NT){WAIT_BAR(2);} else {WAIT_BAR(0);} }while(0)
  for(;t+1<NT;t+=2){
    STEP(pB0,pB1,pA0,pA1,t,(t+3<NT),(t+1<NT),(t+1<NT));       ENDW(t);   RESC(); ROT();
    STEP(pA0,pA1,pB0,pB1,t+1,(t+4<NT),(t+2<NT),(t+2<NT));     ENDW(t+1); RESC(); ROT();
  }
  STEP(pB0,pB1,pA0,pA1,NT-1,false,false,false); RESC();
  { float sacc=pB0[0]+pB0[1]; _Pragma("unroll") for(int r=2;r<16;++r)sacc+=pB0[r]; _Pragma("unroll") for(int r=0;r<16;++r)sacc+=pB1[r]; l_reg+=sacc;
    pw0=(u32x4){PKW(pB0,0),PKW(pB0,2),PKW(pB0,4),PKW(pB0,6)};pw1=(u32x4){PKW(pB0,8),PKW(pB0,10),PKW(pB0,12),PKW(pB0,14)};pw2=(u32x4){PKW(pB1,0),PKW(pB1,2),PKW(pB1,4),PKW(pB1,6)};pw3=(u32x4){PKW(pB1,8),PKW(pB1,10),PKW(pB1,12),PKW(pB1,14)};
    SBAR(); pv(o,vb0+2*sl_cur,PAF(0),PAF(1),PAF(2),PAF(3)); pv(o+2,vb0+2*sl_cur+8192,PAF(0),PAF(1),PAF(2),PAF(3)); }
  #undef PKW
  #undef PAF
  #undef VFR
  #undef PIN
  #undef MX3
  #undef GAPA
  #undef GAPB
  #undef EX
  #undef VRD
  #undef VRD2
  #undef GAPC
  #undef KRD
  #undef STEP
  #undef ENDW
  {auto rr=__builtin_amdgcn_permlane32_swap(__float_as_uint(l_reg),__float_as_uint(l_reg),false,false);l_reg=__uint_as_float(rr[0])+__uint_as_float(rr[1]);}
  if(hi==0)wsf[32+r32]=l_reg;asm volatile("s_waitcnt lgkmcnt(0)":::"memory");
  float rli[16];
  #pragma unroll
  for(int r=0;r<16;++r)rli[r]=__builtin_amdgcn_rcpf(wsf[32+crow(r,hi)]);
  bf16*Ow=O+(rowbase+q0+wid*QBLK)*DM+hv*D;
  { bf16*stg=(bf16*)(shm+LDS_OST)+wid*2048;
    #pragma unroll
    for(int hp=0;hp<2;++hp){
      #pragma unroll
      for(int r=0;r<16;++r){const int orow=crow(r,hi);
        #pragma unroll
        for(int d0=0;d0<2;++d0)stg[orow*64+d0*32+r32]=__float2bfloat16(o[2*hp+d0][r]*rli[r]);}
      asm volatile("s_waitcnt lgkmcnt(0)":::"memory");
      #pragma unroll
      for(int i=0;i<4;++i){const int row=i*8+(lane>>3),ch=lane&7; const u32x4 v=*(const u32x4*)(stg+row*64+ch*8); ATTN_STORE16(Ow+(long)row*DM+hp*64+ch*8,v);}
      asm volatile("s_waitcnt lgkmcnt(0)":::"memory"); } }
  asm volatile("s_waitcnt lgkmcnt(0)\n\ts_barrier":::"memory");
  #undef DMA_K
  #undef DMA_V
  #undef CMASK
  #undef START
  #undef RESC
  #undef ROT
}
constexpr int ATTN_LDS_BYTES=LDS_BYTES;
#undef SBAR
#undef WAIT_BAR
}
#define GAS __attribute__((address_space(1)))
#define LAS __attribute__((address_space(3)))
typedef unsigned short bf16;
typedef unsigned v4u __attribute__((ext_vector_type(4)));
typedef float f32x4 __attribute__((ext_vector_type(4)));
typedef short bf16x8 __attribute__((ext_vector_type(8)));
typedef GAS unsigned gu32;
typedef GAS unsigned long long gu64;
#define RLX_AGENT __ATOMIC_RELAXED, __HIP_MEMORY_SCOPE_AGENT
#define LDS_WAIT() asm volatile("s_waitcnt lgkmcnt(0)" ::: "memory")
#define VM_WAIT() asm volatile("s_waitcnt vmcnt(0)" ::: "memory")
__device__ __forceinline__ unsigned long long rt() { return __builtin_amdgcn_s_memrealtime(); }
__device__ __forceinline__ unsigned f2bf(float f) { unsigned u = __builtin_bit_cast(unsigned, f); return (u + 0x7fffu + ((u >> 16) & 1u)) >> 16; }
__device__ __forceinline__ unsigned pk2(float lo, float hi) { return f2bf(lo) | (f2bf(hi) << 16); }

#define XB_TMO      128
#define XB_XCNT(j)  (256  + 64 * (j))
#define XB_XSUB(j)  (1280 + 64 * (j))
#define XB_XGEN(j)  (2304 + 64 * (j))
#define XB_TOP      3328
#define XB_TOPGEN   3392
#define XCD_BAR_WORDS 3456
#define XB_SPIN_CAP (1u << 18)

__device__ __forceinline__ unsigned xb_ld(unsigned* p)              { return __hip_atomic_load(p, __ATOMIC_RELAXED, __HIP_MEMORY_SCOPE_AGENT); }
__device__ __forceinline__ unsigned xb_add(unsigned* p, unsigned v) { return __hip_atomic_fetch_add(p, v, __ATOMIC_RELAXED, __HIP_MEMORY_SCOPE_AGENT); }
__device__ __forceinline__ unsigned xb_xcc_id() { return (unsigned)__builtin_amdgcn_s_getreg((3 << 11) | 20) & 0xFu; }
#define XB_SPIN(cond, bar) do { unsigned _sp = 0; while (cond) { __builtin_amdgcn_s_sleep(1); \
    if ((++_sp & 255u) == 0u) { if (xb_ld(&(bar)[XB_TMO])) break; if (_sp > XB_SPIN_CAP) { atomicAdd(&(bar)[XB_TMO], 1u); break; } } } } while (0)

struct XcdBarrier {
    unsigned* bar; unsigned x;
    volatile LAS unsigned* st;
};

__device__ __forceinline__ XcdBarrier xcd_barrier_post(unsigned* bar, volatile LAS unsigned* st, const int tid) {
    XcdBarrier b; b.bar = bar; b.x = xb_xcc_id(); b.st = st;
    if (tid == 0) (void)xb_add(&bar[XB_XCNT(b.x)], 1u);
    return b;
}
__device__ __forceinline__ void xcd_barrier_complete(unsigned* bar, unsigned x, unsigned& nloc, unsigned& nx) {
    const unsigned G = gridDim.x * gridDim.y * gridDim.z;
    unsigned sum, cnt, mine, sp = 0u;
    for (;;) {
        sum = 0u; cnt = 0u; mine = 0u;
#pragma unroll
        for (unsigned j = 0; j < 16; ++j) { const unsigned c = xb_ld(&bar[XB_XCNT(j)]); sum += c; cnt += (c > 0u) ? 1u : 0u; mine = (j == x) ? c : mine; }
        if (sum == G) break;
        __builtin_amdgcn_s_sleep(1);
        if ((++sp & 255u) == 0u) { if (xb_ld(&bar[XB_TMO])) break; if (sp > XB_SPIN_CAP) { atomicAdd(&bar[XB_TMO], 1u); break; } }
    }
    nloc = mine > 0u ? mine : 1u; nx = cnt > 0u ? cnt : 1u;
}

__device__ __forceinline__ void xcd_barrier(const XcdBarrier& b, const int tid) {
    asm volatile("s_waitcnt vmcnt(0)" ::: "memory");
    __syncthreads();
    if (tid == 0) {
        unsigned* bar = b.bar;
        __builtin_amdgcn_s_waitcnt(0);
        unsigned nloc = b.st[0], nx = b.st[1];
        if (nloc == 0u) { xcd_barrier_complete(bar, b.x, nloc, nx); b.st[0] = nloc; b.st[1] = nx; }
        const unsigned old = xb_add(&bar[XB_XSUB(b.x)], 1u);
        const unsigned gen = old / nloc;
        if (old + 1u == (gen + 1u) * nloc) {
            __builtin_amdgcn_fence(__ATOMIC_RELEASE, "agent");
            asm volatile("s_waitcnt vmcnt(0)" ::: "memory");
            const unsigned og = xb_add(&bar[XB_TOP], 1u);
            const unsigned tg = og / nx;
            if (og + 1u == (tg + 1u) * nx) xb_add(&bar[XB_TOPGEN], 1u);
            else XB_SPIN(xb_ld(&bar[XB_TOPGEN]) == tg, bar);
            __builtin_amdgcn_fence(__ATOMIC_ACQUIRE, "agent");
            xb_add(&bar[XB_XGEN(b.x)], 1u);
            asm volatile("s_waitcnt vmcnt(0)" ::: "memory");
        } else {
            XB_SPIN(xb_ld(&bar[XB_XGEN(b.x)]) == gen, bar);
            __builtin_amdgcn_fence(__ATOMIC_ACQUIRE, "agent");
            asm volatile("s_waitcnt vmcnt(0)" ::: "memory");
        }
    }
    __syncthreads();
}

constexpr int NWAVES = 8;
constexpr int RING_OFF = 0, RING_BYTES = 131072;
constexpr int LDSCTL_OFF = RING_BYTES, MISC_OFF = LDSCTL_OFF + 320;
constexpr int LDS_BYTES = 147456;
constexpr int CW_BAR = 4096;
typedef float f32x4 __attribute__((ext_vector_type(4)));
typedef unsigned u32x2v __attribute__((ext_vector_type(2)));
using pg8::bf16_t;

struct Args { const float* in[38]; float* out; unsigned char* ws; int ph_lo, ph_hi; };

struct Ctx {
    float* out; unsigned char* ws;
    LAS unsigned char* lds; int tid, lane, wave, vcu, G;
};


__device__ __forceinline__ float wave_sum(float v) {
#pragma unroll
    for (int o = 1; o < 64; o <<= 1) v += __shfl_xor(v, o);
    return v;
}
__device__ __forceinline__ float wave_max(float v) {
#pragma unroll
    for (int o = 1; o < 64; o <<= 1) v = fmaxf(v, __shfl_xor(v, o));
    return v;
}
__device__ __forceinline__ float bf2f(bf16_t h) { return __uint_as_float(((unsigned)h) << 16); }
__device__ __forceinline__ void load_row(const float* p, int lane, f32x4 (&v)[4]) {
    const f32x4* q = (const f32x4*)p + lane;
#pragma unroll
    for (int j = 0; j < 4; ++j) v[j] = q[64 * j];
}
__device__ __forceinline__ float row_rstd(const f32x4 (&v)[4], float eps) {
    float s = 0.f;
#pragma unroll
    for (int j = 0; j < 4; ++j) s += (v[j].x * v[j].x + v[j].y * v[j].y) + (v[j].z * v[j].z + v[j].w * v[j].w);
    return 1.0f / sqrtf(wave_sum(s) * (1.0f / D) + eps);
}
__device__ __forceinline__ void store_row_bf16(bf16_t* p, int lane, const f32x4 (&v)[4]) {
    unsigned long long* o = (unsigned long long*)p + lane;
#pragma unroll
    for (int j = 0; j < 4; ++j) o[64 * j] = (unsigned long long)pk2(v[j].x, v[j].y) | ((unsigned long long)pk2(v[j].z, v[j].w) << 32);
}

__device__ __forceinline__ void load_xrow(const float* slot, int lane, f32x4 (&v)[4]) {
    const uint2* q = (const uint2*)slot + lane; uint2 t[4];
#pragma unroll
    for (int j = 0; j < 4; ++j) t[j] = q[64 * j];
#pragma unroll
    for (int j = 0; j < 4; ++j) v[j] = (f32x4){__uint_as_float(t[j].x << 16), __uint_as_float(t[j].x & 0xffff0000u), __uint_as_float(t[j].y << 16), __uint_as_float(t[j].y & 0xffff0000u)};
}
__device__ __forceinline__ void store_xrow(float* slot, int lane, const f32x4 (&v)[4]) { store_row_bf16((bf16_t*)slot, lane, v); }

__device__ __forceinline__ void p0_transpose_item(const float* W, int K, int N, bf16_t* WT, int ldk, int row_off, int mode, LAS float* scr, int kb, int nb, int lane) {
    const int k0 = 64 * kb, n0 = 32 * nb;
    {
        float tv[32]; const int nn_ = n0 + (lane & 31), nc = nn_ < N ? nn_ : N - 1; const float nm = nn_ < N ? 1.f : 0.f;
#pragma unroll
        for (int i = 0; i < 32; ++i) { const int k = k0 + 2 * i + (lane >> 5), kc = k < K ? k : K - 1; tv[i] = W[(size_t)kc * N + nc]; }
#pragma unroll
        for (int i = 0; i < 32; ++i) { const int kk = 2 * i + (lane >> 5); scr[kk * 33 + (lane & 31)] = (k0 + kk < K) ? tv[i] * nm : 0.f; }
    }
    LDS_WAIT(); asm volatile("" ::: "memory");
    const int c = lane & 7;
#pragma unroll
    for (int j = 0; j < 4; ++j) { const int n = (lane >> 3) + 8 * j; const LAS float* s = scr + (8 * c) * 33 + n;
        v4u o; o.x = pk2(s[0 * 33], s[1 * 33]); o.y = pk2(s[2 * 33], s[3 * 33]); o.z = pk2(s[4 * 33], s[5 * 33]); o.w = pk2(s[6 * 33], s[7 * 33]);
        const int nn = n0 + n, drow = (mode == 0) ? nn : ((nn >> 2) * 8 + (nn & 3) + (mode == 2 ? 4 : 0));
        *(GAS v4u*)(WT + (size_t)(row_off + drow) * ldk + k0 + 8 * c) = o; }
    LDS_WAIT(); asm volatile("" ::: "memory");
}
__device__ __forceinline__ void p0_transpose(const Ctx& C, const float* W, int K, int N, int Kd, int Nd, bf16_t* WT, int ldk, int row_off, int mode, int gw, int NGW) {
    LAS float* scr = (LAS float*)(C.lds + RING_OFF + C.wave * 16384);
    const int nkb = Kd / 64, nnb = Nd / 32, nit = nkb * nnb;
    for (int it = gw; it < nit; it += NGW) p0_transpose_item(W, K, N, WT, ldk, row_off, mode, scr, it / nnb, it % nnb, C.lane);
}
__device__ __forceinline__ void p0_gu(const Ctx& C, const int f, int gw, int NGW) {
    unsigned char* ws = C.ws;
    p0_transpose(C, in_ptr(9) + (size_t)f * D * FF, D, FF, D, FF, (bf16_t*)(ws + W_GU) + (size_t)f * NGU * D, D, 0, 1, gw, NGW);
    p0_transpose(C, in_ptr(10) + (size_t)f * D * FF, D, FF, D, FF, (bf16_t*)(ws + W_GU) + (size_t)f * NGU * D, D, 0, 2, gw, NGW);
}
__device__ __forceinline__ void p0_weights_late(const Ctx& C, int gw, int NGW) {
    unsigned char* ws = C.ws;
    p0_transpose(C, in_ptr(11) + (size_t)2 * FF * D, FF, D, FF, D, (bf16_t*)(ws + W_D) + (size_t)2 * D * FF, FF, 0, 0, gw, NGW);
    p0_transpose(C, in_ptr(11) + (size_t)3 * FF * D, FF, D, FF, D, (bf16_t*)(ws + W_D) + (size_t)3 * D * FF, FF, 0, 0, gw, NGW);
    if (C.G == 256) p0_transpose(C, in_ptr(16), D, D, D, D, (bf16_t*)(ws + W_ORW), D, 0, 0, gw, NGW);
    p0_transpose(C, in_ptr(31), D, D, D, D, (bf16_t*)(ws + W_KV), D, 0, 0, gw, NGW);
    p0_transpose(C, in_ptr(32), D, D, D, D, (bf16_t*)(ws + W_KV), D, 1024, 0, gw, NGW);
    p0_transpose(C, in_ptr(33), D, D, D, D, (bf16_t*)(ws + W_Q), D, 0, 0, gw, NGW);
    p0_transpose(C, in_ptr(34), D, D, D, D, (bf16_t*)(ws + W_OAT), D, 0, 0, gw, NGW);
}
__device__ __forceinline__ void p0_prologue(const Ctx& C) {
    unsigned char* ws = C.ws;
    const int gw = C.vcu * NWAVES + C.wave, NGW = C.G * NWAVES;
    p0_gu(C, 0, gw, NGW);
    for (int f = 0; f < (C.G == 256 ? 1 : 2); ++f) p0_transpose(C, in_ptr(11) + (size_t)f * FF * D, FF, D, FF, D, (bf16_t*)(ws + W_D) + (size_t)f * D * FF, FF, 0, 0, gw, NGW);
    bf16_t* wrkvl = (bf16_t*)(ws + W_RKVL);
    p0_transpose(C, in_ptr(13), D, D, D, D, wrkvl, D, 0, 0, gw, NGW);
    p0_transpose(C, in_ptr(14), D, D, D, D, wrkvl, D, 1024, 0, gw, NGW);
    p0_transpose(C, in_ptr(15), D, D, D, D, wrkvl, D, 2048, 0, gw, NGW);
    p0_transpose(C, in_ptr(18), D, 64, D, 256, wrkvl, D, 3072, 0, gw, NGW);
    p0_transpose(C, in_ptr(21), D, 64, D, 256, wrkvl, D, 3328, 0, gw, NGW);
    p0_transpose(C, in_ptr(23), D, 160, D, 256, wrkvl, D, 3584, 0, gw, NGW);
    if (C.G != 256) p0_transpose(C, in_ptr(16), D, D, D, D, (bf16_t*)(ws + W_ORW), D, 0, 0, gw, NGW);
    bf16_t* wlu = (bf16_t*)(ws + W_LU);
    p0_transpose(C, in_ptr(19), 64, D, 256, D, wlu, 256, 0, 0, gw, NGW);
    p0_transpose(C, in_ptr(22), 64, D, 256, D, wlu, 256, 1024, 0, gw, NGW);
    p0_transpose(C, in_ptr(24), 160, D, 256, D, wlu, 256, 2048, 0, gw, NGW);
    {
        f32x4 gn[4]; load_row(in_ptr(7), C.lane, gn);
        bf16_t* XN = (bf16_t*)(ws + U_XN);
        for (int r = gw; r < MP; r += NGW) {
            f32x4 v[4];
            if (r < ROW_S) load_row(in_ptr(0) + (size_t)r * D, C.lane, v);
            else if (r < ROW_M) load_row(in_ptr(1) + (size_t)(r - ROW_S) * D, C.lane, v);
            else if (r < ROW_END) load_row(in_ptr(6) + (size_t)((r - ROW_M) & 15) * D, C.lane, v);
            else {
#pragma unroll
                for (int j = 0; j < 4; ++j) v[j] = (f32x4){0.f, 0.f, 0.f, 0.f}; }
            float* xr = xrow_ptr(C.out, (float*)(C.ws + WS_XEXTRA), r);
            store_xrow(xr, C.lane, v);
            const float rs = row_rstd(v, 1e-6f);
#pragma unroll
            for (int j = 0; j < 4; ++j) v[j] = v[j] * rs * gn[j];
            store_row_bf16(XN + (size_t)r * D, C.lane, v);
        }
    }
    {
        float* rope = (float*)(ws + WS_ROPE);
        const int gt = (C.vcu * NWAVES + C.wave) * 64 + C.lane, NGT = C.G * NWAVES * 64;
        for (int e = gt; e < 4112 * 8; e += NGT) {
            const int pos = e >> 3, i = e & 7;
            const float inv = exp2f(-(float)i * (18.931568569324174f / 8.0f));
            const float x = (float)pos * inv;
            const float n = rintf(x * 0.15915494309189535f);
            float r = fmaf(-n, 6.28125f, x); r = fmaf(-n, 1.9353071795864769e-3f, r);
            rope[(size_t)pos * 16 + i] = cosf(r); rope[(size_t)pos * 16 + 8 + i] = sinf(r);
        }
    }
    {
        v4u* z = (v4u*)(ws + WS_KMETA); const int gt = (C.vcu * NWAVES + C.wave) * 64 + C.lane, NGT = C.G * NWAVES * 64;
        for (int e = gt; e < (int)(2 * MiB / 16); e += NGT) z[e] = (v4u){0u, 0u, 0u, 0u};
    }
    if (blockIdx.x == 0 && C.wave == 0) {
        const float* lp = in_ptr(35);
        const float a = wave_sum(lp[C.lane] * lp[64 + C.lane]), b = wave_sum(lp[128 + C.lane] * lp[192 + C.lane]);
        if (C.lane == 0) ((float*)(ws + WS_MISC))[0] = expf(a) - expf(b) + 0.35550906759096924f;
    }
}

__device__ __forceinline__ void fold_partials(const Ctx& C, int r, f32x4 (&v)[4]) {
    const float* P = (const float*)(C.ws + WS_PART) + (size_t)(r - ROW_S) * 1024;
    f32x4 p0[4], p1[4], p2[4], p3[4];
    load_row(P, C.lane, p0); load_row(P + 192 * 1024, C.lane, p1); load_row(P + 2 * 192 * 1024, C.lane, p2); load_row(P + 3 * 192 * 1024, C.lane, p3);
#pragma unroll
    for (int j = 0; j < 4; ++j) v[j] = v[j] + 0.5f * (((p0[j] + p1[j]) + p2[j]) + p3[j]);
}
__device__ __forceinline__ void p_norm(const Ctx& C, const float* g0, bf16_t* o0, const float* g1, bf16_t* o1, const bool fold = false) {
    const int gw = C.vcu * NWAVES + C.wave, NGW = C.G * NWAVES;
    f32x4 ga[4], gb[4]; load_row(g0, C.lane, ga); if (g1) load_row(g1, C.lane, gb);
    for (int r = ROW_END + gw; r < MP; r += NGW) {
        f32x4 z[4];
#pragma unroll
        for (int j = 0; j < 4; ++j) z[j] = (f32x4){0.f, 0.f, 0.f, 0.f};
        store_row_bf16(o0 + (size_t)r * D, C.lane, z); if (g1) store_row_bf16(o1 + (size_t)r * D, C.lane, z); }
    for (int r = gw; r < ROW_END; r += NGW) {
        float* xp = xrow_ptr(C.out, (float*)(C.ws + WS_XEXTRA), r);
        f32x4 v[4]; load_xrow(xp, C.lane, v);
        if (fold && r >= ROW_S) { fold_partials(C, r, v);
            store_xrow(xp, C.lane, v); }
        const float rs = row_rstd(v, 1e-6f);
        f32x4 o[4];
#pragma unroll
        for (int j = 0; j < 4; ++j) o[j] = v[j] * rs * ga[j];
        store_row_bf16(o0 + (size_t)r * D, C.lane, o);
        if (g1) {
#pragma unroll
            for (int j = 0; j < 4; ++j) o[j] = v[j] * rs * gb[j];
            store_row_bf16(o1 + (size_t)r * D, C.lane, o);
        }
    }
}
__device__ __forceinline__ void p_final(const Ctx& C) {
    const int gw = C.vcu * NWAVES + C.wave, NGW = C.G * NWAVES;
    f32x4 ga[4]; load_row(in_ptr(37), C.lane, ga);
    for (int r = gw; r < ROW_M; r += NGW) {
        float* xr = C.out + (size_t)r * D;
        f32x4 v[4]; load_xrow(xr, C.lane, v);
        if (THIN_SPLIT_MINF <= 3 && r >= ROW_S) fold_partials(C, r, v);
        const float rs = row_rstd(v, 1e-6f);
        f32x4* xo = (f32x4*)xr + C.lane;
#pragma unroll
        for (int j = 0; j < 4; ++j) xo[64 * j] = v[j] * rs * ga[j];
    }
}

__device__ __forceinline__ void p_rwmix(const Ctx& C) {
    const int gw = C.vcu * NWAVES + C.wave, NGW = C.G * NWAVES;
    f32x4 gn[4]; load_row(in_ptr(8), C.lane, gn);
    bf16_t* A6 = (bf16_t*)(C.ws + U_A6);
    for (int r = ROW_END + gw; r < MP; r += NGW) {
        f32x4 z[4];
#pragma unroll
        for (int j = 0; j < 4; ++j) z[j] = (f32x4){0.f, 0.f, 0.f, 0.f};
#pragma unroll
        for (int g = 0; g < 6; ++g) store_row_bf16(A6 + ((size_t)g * MP + r) * D, C.lane, z); }
    for (int r = gw; r < ROW_END; r += NGW) {
        f32x4 h[4], hp[4];
        load_xrow(xrow_ptr(C.out, (float*)(C.ws + WS_XEXTRA), r), C.lane, h);
        if (THIN_SPLIT_MINF <= 0 && r >= ROW_S) fold_partials(C, r, h);
        { const float rs = row_rstd(h, 1e-6f);
#pragma unroll
          for (int j = 0; j < 4; ++j) h[j] = h[j] * rs * gn[j]; }
        int prev = -1; const float* raw = nullptr; int last = 0; size_t shoff = 0;
        if (r < ROW_S) { const int b = r >> 12, t = r & 4095; prev = t > 0 ? r - 1 : ROW_M + b * 16 + 15; if (t == 4095) { last = 1; shoff = O_SHP + (size_t)b * D; } }
        else if (r < ROW_M) { const int i = r - ROW_S, b = i >> 4, t = i & 15; if (t > 0) prev = r - 1; else raw = in_ptr(5) + (size_t)b * D; if (t == 15) { last = 1; shoff = O_SHS + (size_t)b * D; } }
        else { const int j = (r - ROW_M) & 15; if (j > 0) prev = r - 1; }
        if (prev >= 0) { load_xrow(xrow_ptr(C.out, (float*)(C.ws + WS_XEXTRA), prev), C.lane, hp); if (THIN_SPLIT_MINF <= 0 && prev >= ROW_S) fold_partials(C, prev, hp); const float rs = row_rstd(hp, 1e-6f);
#pragma unroll
            for (int j = 0; j < 4; ++j) hp[j] = hp[j] * rs * gn[j]; }
        else if (raw) load_row(raw, C.lane, hp);
        else {
#pragma unroll
            for (int j = 0; j < 4; ++j) hp[j] = (f32x4){0.f, 0.f, 0.f, 0.f}; }
        if (last) { f32x4* so = (f32x4*)(C.out + shoff) + C.lane;
#pragma unroll
            for (int j = 0; j < 4; ++j) so[64 * j] = h[j]; }
#pragma unroll
        for (int g = 0; g < 6; ++g) {
            const int mi = (g == 0) ? 0 : (g == 1) ? 2 : (g == 2) ? 3 : (g == 3) ? 1 : g;
            f32x4 mu[4]; load_row(in_ptr(12) + (size_t)mi * D, C.lane, mu);
            f32x4 o[4];
#pragma unroll
            for (int j = 0; j < 4; ++j) o[j] = h[j] + (hp[j] - h[j]) * mu[j];
            store_row_bf16(A6 + ((size_t)g * MP + r) * D, C.lane, o);
        }
    }
}


constexpr int NCH_PROMPT = 4 * 257 * 16, NCH_ALL = NCH_PROMPT + 128;
constexpr int SCAN_C1 = 138;
typedef short bf16x8s __attribute__((ext_vector_type(8)));
typedef short s16x4s __attribute__((ext_vector_type(4)));
typedef float f32x4s __attribute__((ext_vector_type(4)));

__device__ __forceinline__ void chunk_decode(int ch, int& row0, int& h) {
    if (ch < NCH_PROMPT) { const int b = ch / (257 * 16), rem = ch - b * (257 * 16), c = rem >> 4; h = rem & 15; row0 = (c == 0) ? ROW_M + b * 16 : b * 4096 + (c - 1) * 16; }
    else { const int i = ch - NCH_PROMPT; h = i & 15; row0 = ROW_S + (i >> 4) * 16; }
}
__device__ __forceinline__ float dpp_add(float x, const int ctrl_sel) {
    const int xi = __float_as_int(x); int t;
    switch (ctrl_sel) {
    case 0: t = __builtin_amdgcn_update_dpp(0, xi, 0xB1, 0xF, 0xF, false); break;
    case 1: t = __builtin_amdgcn_update_dpp(0, xi, 0x4E, 0xF, 0xF, false); break;
    case 2: t = __builtin_amdgcn_update_dpp(0, xi, 0x141, 0xF, 0xF, false); break;
    case 3: t = __builtin_amdgcn_update_dpp(0, xi, 0x140, 0xF, 0xF, false); break;
    case 4: t = __builtin_amdgcn_update_dpp(0, xi, 0x142, 0xA, 0xF, false); break;
    default: t = __builtin_amdgcn_update_dpp(0, xi, 0x143, 0xC, 0xF, false); break;
    }
    return x + __int_as_float(t);
}
__device__ __forceinline__ void reduce16(float (&x)[16]) {
#pragma unroll
    for (int st = 0; st < 6; ++st) {
#pragma unroll
        for (int t = 0; t < 16; ++t) x[t] = dpp_add(x[t], st);
    }
#pragma unroll
    for (int t = 0; t < 16; ++t) x[t] = __int_as_float(__builtin_amdgcn_readlane(__float_as_int(x[t]), 63));
}
__device__ __forceinline__ unsigned short f2bf_s(float f) { return (unsigned short)(pg8::cvt_pk_bf16(f, 0.f) & 0xffffu); }

__device__ __forceinline__ void p_scan_pre(const Ctx& C, const int half) {
    const int lane = C.lane, fr = lane & 15, fq = lane >> 4;
    LAS unsigned char* wl = C.lds + RING_OFF + C.wave * 12288;
    LAS unsigned short* TA = (LAS unsigned short*)wl; LAS unsigned short* TB = TA + 1152; LAS unsigned short* TK = TB + 1152; LAS unsigned short* TR = TK + 1152;
    LAS float* LAB = (LAS float*)(wl + 9216); LAS float* LAK = LAB + 256;
    bf16_t* Rb = (bf16_t*)(C.out + O_CKP); bf16_t* Kb = Rb + (size_t)MP * D; const bf16_t* Vb = Kb + (size_t)MP * D;
    const bf16_t* LW = (const bf16_t*)(C.ws + U_LOGW); const bf16_t* AS = (const bf16_t*)(C.ws + U_ASIG);
    bf16_t* BK = (bf16_t*)(C.ws + U_BK); bf16_t* VT = (bf16_t*)(C.ws + U_VT); bf16_t* SM = (bf16_t*)(C.ws + U_SM);
    float* GAM = (float*)(C.out + O_GAM); float* BON = (float*)(C.out + O_BON);
    const int gw = half ? ((int)blockIdx.x - 64) * NWAVES + C.wave : C.vcu * NWAVES + C.wave, NGW = half ? (C.G - 64) * NWAVES : C.G * NWAVES;
    const int ntask = half ? 4 * (257 - SCAN_C1) * 16 : 4 * SCAN_C1 * 16 + 128;
    const int pos = ((lane >> 2) & 3) * 16 + (lane >> 5) * 8 + ((lane >> 4) & 1) * 4 + (lane & 3);
    for (int task = gw; task < ntask; task += NGW) {
        int ch;
        if (half) { const int b_ = task / ((257 - SCAN_C1) * 16), rem_ = task - b_ * ((257 - SCAN_C1) * 16); ch = (b_ * 257 + SCAN_C1 + (rem_ >> 4)) * 16 + (rem_ & 15); }
        else if (task < 4 * SCAN_C1 * 16) { const int b_ = task / (SCAN_C1 * 16), rem_ = task - b_ * (SCAN_C1 * 16); ch = (b_ * 257 + (rem_ >> 4)) * 16 + (rem_ & 15); }
        else ch = NCH_PROMPT + (task - 4 * SCAN_C1 * 16);
        int row0, h; chunk_decode(ch, row0, h);
        const int col = h * 64 + lane;
        const float kk_c = in_ptr(25)[col], ka_c = in_ptr(26)[col], rk_c = in_ptr(27)[col];
        float rt[16], at[16], bt[16], kt[16]; unsigned short vraw[16];
        float nrm[16], bon[16];
        {
            float kr[16], as_[16];
            {
                LAS unsigned char* stg = wl;
                const int r8 = lane >> 3, sg8 = lane & 7, r4 = lane >> 4, sg16 = lane & 15;
                const size_t gb = ((size_t)(row0 + r8) * D + h * 64 + sg8 * 8), gb8 = gb + (size_t)8 * D;
                const v4u x0 = *(const v4u*)(Rb + gb), x1 = *(const v4u*)(Rb + gb8), x2 = *(const v4u*)(Kb + gb), x3 = *(const v4u*)(Kb + gb8);
                const v4u x4 = *(const v4u*)(Vb + gb), x5 = *(const v4u*)(Vb + gb8), x6 = *(const v4u*)(AS + gb), x7 = *(const v4u*)(AS + gb8);
                const v4u x8 = *(const v4u*)(LW + gb), x9 = *(const v4u*)(LW + gb8);
                const int lo = r8 * 128 + sg8 * 16;
                *(LAS v4u*)(stg + lo) = x0; *(LAS v4u*)(stg + lo + 1024) = x1; *(LAS v4u*)(stg + 2048 + lo) = x2; *(LAS v4u*)(stg + 2048 + lo + 1024) = x3;
                *(LAS v4u*)(stg + 4096 + lo) = x4; *(LAS v4u*)(stg + 4096 + lo + 1024) = x5; *(LAS v4u*)(stg + 6144 + lo) = x6; *(LAS v4u*)(stg + 6144 + lo + 1024) = x7;
                *(LAS v4u*)(stg + 8192 + lo) = x8; *(LAS v4u*)(stg + 8192 + lo + 1024) = x9;
                LDS_WAIT(); asm volatile("" ::: "memory");
                const LAS unsigned short* s16 = (const LAS unsigned short*)stg + lane;
#pragma unroll
                for (int t = 0; t < 16; ++t) { rt[t] = bf2f(s16[t * 64]); kr[t] = bf2f(s16[1024 + t * 64]); vraw[t] = s16[2048 + t * 64]; as_[t] = bf2f(s16[3072 + t * 64]); at[t] = bf2f(s16[4096 + t * 64]); }
                LDS_WAIT(); asm volatile("" ::: "memory");
            }
#pragma unroll
            for (int t = 0; t < 16; ++t) { const float kkv = kr[t] * kk_c; nrm[t] = kkv * kkv; bt[t] = kkv;
                kt[t] = kr[t] * (1.0f + (as_[t] - 1.0f) * ka_c); bon[t] = rt[t] * kt[t] * rk_c; }
            reduce16(nrm); reduce16(bon);
            float L = 0.f, gprev = 1.0f;
#pragma unroll
            for (int t = 0; t < 16; ++t) {
                const float kkn = bt[t] * ((nrm[t] > 1e-24f) ? __builtin_amdgcn_rsqf(nrm[t]) : 1e12f), lw = at[t];
                const float gp = gprev; L += lw; const float gt = __expf(L), gi = __builtin_amdgcn_rcpf(gt); gprev = gt;
                at[t] = -kkn * gp; bt[t] = kkn * as_[t] * gi; kt[t] = kt[t] * gi; rt[t] = rt[t] * gt;
            }
            const float gC = gprev;
            GAM[(size_t)ch * 64 + lane] = gC;
            { float bsel = bon[0];
#pragma unroll
              for (int t = 1; t < 16; ++t) bsel = (lane == t) ? bon[t] : bsel;
              if (lane < 16) BON[(size_t)(row0 + lane) * 16 + h] = bsel; }
#pragma unroll
            for (int t = 0; t < 16; ++t) { TA[t * 72 + lane] = f2bf_s(at[t]); TB[t * 72 + lane] = f2bf_s(bt[t]); TK[t * 72 + lane] = f2bf_s(kt[t]); TR[t * 72 + lane] = f2bf_s(rt[t]); }
            bf16_t* bkp = BK + (size_t)ch * 2048 + lane * 32;
#pragma unroll
            for (int q = 0; q < 4; ++q) { v4u o; o.x = pg8::cvt_pk_bf16(bt[4 * q] * gC, bt[4 * q + 1] * gC); o.y = pg8::cvt_pk_bf16(bt[4 * q + 2] * gC, bt[4 * q + 3] * gC);
                o.z = pg8::cvt_pk_bf16(kt[4 * q] * gC, kt[4 * q + 1] * gC); o.w = pg8::cvt_pk_bf16(kt[4 * q + 2] * gC, kt[4 * q + 3] * gC); *(v4u*)(bkp + q * 8) = o; }
            bf16_t* vtp = VT + (size_t)ch * 1024 + lane * 16;
#pragma unroll
            for (int q = 0; q < 2; ++q) { v4u o; o.x = (unsigned)vraw[8 * q] | ((unsigned)vraw[8 * q + 1] << 16); o.y = (unsigned)vraw[8 * q + 2] | ((unsigned)vraw[8 * q + 3] << 16);
                o.z = (unsigned)vraw[8 * q + 4] | ((unsigned)vraw[8 * q + 5] << 16); o.w = (unsigned)vraw[8 * q + 6] | ((unsigned)vraw[8 * q + 7] << 16); *(v4u*)(vtp + q * 8) = o; }
#pragma unroll
            for (int t = 0; t < 16; ++t) Rb[(size_t)(row0 + t) * D + h * 64 + pos] = f2bf_s(rt[t]);
        }
        LDS_WAIT(); asm volatile("" ::: "memory");
        f32x4s Aab = {0.f, 0.f, 0.f, 0.f}, Aak = Aab, Arb = Aab, Ark = Aab;
#pragma unroll
        for (int mf = 0; mf < 2; ++mf) {
            const bf16x8s fa = *(const LAS bf16x8s*)(TA + fr * 72 + fq * 8 + mf * 32), fb = *(const LAS bf16x8s*)(TB + fr * 72 + fq * 8 + mf * 32);
            const bf16x8s fk = *(const LAS bf16x8s*)(TK + fr * 72 + fq * 8 + mf * 32), frr = *(const LAS bf16x8s*)(TR + fr * 72 + fq * 8 + mf * 32);
            Aab = __builtin_amdgcn_mfma_f32_16x16x32_bf16(fa, fb, Aab, 0, 0, 0); Aak = __builtin_amdgcn_mfma_f32_16x16x32_bf16(fa, fk, Aak, 0, 0, 0);
            Arb = __builtin_amdgcn_mfma_f32_16x16x32_bf16(frr, fb, Arb, 0, 0, 0); Ark = __builtin_amdgcn_mfma_f32_16x16x32_bf16(frr, fk, Ark, 0, 0, 0);
        }
        bf16_t* smp = SM + (size_t)ch * 1024;
#pragma unroll
        for (int e = 0; e < 4; ++e) { const int t = 4 * fq + e, s = fr;
            const float ab = (s < t) ? Aab[e] : 0.f, ak = (s < t) ? Aak[e] : 0.f, rb = (s <= t) ? Arb[e] : 0.f, rk2 = (s <= t) ? Ark[e] : 0.f;
            LAB[t * 16 + s] = ab; LAK[t * 16 + s] = ak;
            smp[512 + t * 32 + (s >> 2) * 8 + (s & 3)] = f2bf_s(rb); smp[512 + t * 32 + (s >> 2) * 8 + 4 + (s & 3)] = f2bf_s(rk2); }
        LDS_WAIT(); asm volatile("" ::: "memory");
        float xm[16];
#pragma unroll
        for (int t = 0; t < 16; ++t) {
            float accw = at[t], accm = LAK[t * 16 + fr];
#pragma unroll
            for (int s4 = 0; s4 < (t + 3) / 4; ++s4) { const f32x4s q = *(const LAS f32x4s*)(LAB + t * 16 + 4 * s4);
#pragma unroll
                for (int e = 0; e < 4; ++e) if (4 * s4 + e < t) { accw += q[e] * at[4 * s4 + e]; accm += q[e] * xm[4 * s4 + e]; } }
            at[t] = accw; xm[t] = accm;
        }
#pragma unroll
        for (int t = 0; t < 16; ++t) Kb[(size_t)(row0 + t) * D + h * 64 + pos] = f2bf_s(at[t]);
        if (lane < 16) {
#pragma unroll
            for (int t = 0; t < 16; ++t) { smp[t * 32 + (lane >> 2) * 8 + 4 + (lane & 3)] = f2bf_s(xm[t]); smp[t * 32 + (lane >> 2) * 8 + (lane & 3)] = 0; } }
        LDS_WAIT(); asm volatile("" ::: "memory");
    }
}

constexpr int SQ_BK = 0, SQ_VT = 5120, SQ_M2 = 7168, SQ_AR = 8448, SQ_WP = 9728, SQ_RP = 12032, SQ_GM = 14336, SQ_SLOT = 14592;
__device__ __forceinline__ void p_scan_seq(const Ctx& C, const int part) {
    const int g = (int)blockIdx.x, w = C.wave, lane = C.lane, fr = lane & 15, fq = lane >> 4, tid = C.tid;
    if (part == 0 && g >= 192) return;
    if (part == 1 && g >= 64) { p0_weights_late(C, (g - 64) * NWAVES + w, (C.G - 64) * NWAVES); return; }
    const int prompt = g < 64, b = prompt ? (g >> 4) : ((g - 64) >> 4), h = g & 15, bh = b * 16 + h;
    const unsigned char* Rb = (const unsigned char*)(C.out + O_CKP); const unsigned char* Kb = Rb + (size_t)MP * D * 2;
    const unsigned char* BK = (const unsigned char*)(C.ws + U_BK); const unsigned char* VT = (const unsigned char*)(C.ws + U_VT); const unsigned char* SM = (const unsigned char*)(C.ws + U_SM);
    const unsigned char* GAM = (const unsigned char*)(C.out + O_GAM); float* Y = (float*)(C.ws + U_Y);
    LAS unsigned char* slots = C.lds + RING_OFF;
    const int coff = (prompt && part) ? SCAN_C1 : 0;
    const int nch = prompt ? (part ? 257 - SCAN_C1 : SCAN_C1) : 1;
    const int lt = tid - 256; const bool loader = tid >= 256;
    const int ldsP0 = SQ_BK + (lt >> 2) * 80 + (lt & 3) * 16;
    const unsigned char* srcP1 = (lt < 128) ? VT + (size_t)lt * 16 : SM + (size_t)(lt - 128) * 16;
    const int q1 = (lt - 128) & 63, ldsP1 = (lt < 128) ? SQ_VT + lt * 16 : ((lt < 192 ? SQ_M2 : SQ_AR) + (q1 >> 2) * 80 + (q1 & 3) * 16);
    const unsigned char* srcP2 = (lt < 128) ? Kb : Rb; const int row2 = (lt & 127) >> 3, seg2 = lt & 7, ldsP2 = (lt < 128 ? SQ_WP : SQ_RP) + row2 * 144 + seg2 * 16;
    const int ldsP3 = SQ_GM + (lt & 15) * 16; const bool has3 = loader && lt < 16;
    v4u buf0[12], buf1[12], buf2[12], buf3[12];
#define SQ_CH(c) (prompt ? (b * 257 + coff + (c)) * 16 + h : NCH_PROMPT + bh)
#define SQ_ROW0(c) (prompt ? ((coff + (c)) == 0 ? ROW_M + b * 16 : b * 4096 + (coff + (c) - 1) * 16) : ROW_S + b * 16)
#define SQ_ISSUE(j, c_) do { { const int cq_ = ((c_) < nch) ? (c_) : nch - 1; const int ch_ = SQ_CH(cq_); buf0[j] = *(const v4u*)(BK + (size_t)ch_ * 4096 + (size_t)lt * 16); buf1[j] = *(const v4u*)(srcP1 + (size_t)ch_ * 2048); \
        buf2[j] = *(const v4u*)(srcP2 + ((size_t)(SQ_ROW0(cq_) + row2) * D + h * 64) * 2 + seg2 * 16); buf3[j] = *(const v4u*)(GAM + (size_t)ch_ * 256 + (lt & 15) * 16); } } while (0)
#define SQ_PUT(j, c) do { if (loader) { LAS unsigned char* sl_ = slots + ((c) & 1) * SQ_SLOT; *(LAS v4u*)(sl_ + ldsP0) = buf0[j]; *(LAS v4u*)(sl_ + ldsP1) = buf1[j]; *(LAS v4u*)(sl_ + ldsP2) = buf2[j]; \
        if (has3) *(LAS v4u*)(sl_ + ldsP3) = buf3[j]; } } while (0)
    f32x4s ST[2][4];
    if (w < 2) {
#pragma unroll
        for (int u = 0; u < 2; ++u) {
            if (prompt && part == 0) {
#pragma unroll
                for (int kt = 0; kt < 4; ++kt) ST[u][kt] = (f32x4s){0.f, 0.f, 0.f, 0.f};
            } else {
                const float* s0 = (prompt ? (const float*)(C.out + O_WKVP) : in_ptr(4)) + ((size_t)bh * 64 + 32 * w + 16 * u + fr) * 64;
#pragma unroll
                for (int kt = 0; kt < 4; ++kt) ST[u][kt] = *(const f32x4s*)(s0 + 16 * kt + 4 * fq);
            }
        }
    }
    struct Frg { bf16x8s wp0, wp1, rp0, rp1, m2, ar, bk0, bk1, bk2, bk3; s16x4s vt0, vt1; f32x4s g0, g1, g2, g3; };
#define SQ_FRAGS(F, c) do { const LAS unsigned char* sl_ = slots + ((c) % 3) * SQ_SLOT; \
        F.wp0 = *(const LAS bf16x8s*)(sl_ + SQ_WP + fr * 144 + fq * 32); F.wp1 = *(const LAS bf16x8s*)(sl_ + SQ_WP + fr * 144 + fq * 32 + 16); \
        F.rp0 = *(const LAS bf16x8s*)(sl_ + SQ_RP + fr * 144 + fq * 32); F.rp1 = *(const LAS bf16x8s*)(sl_ + SQ_RP + fr * 144 + fq * 32 + 16); \
        F.m2 = *(const LAS bf16x8s*)(sl_ + SQ_M2 + fr * 80 + fq * 16); F.ar = *(const LAS bf16x8s*)(sl_ + SQ_AR + fr * 80 + fq * 16); \
        F.bk0 = *(const LAS bf16x8s*)(sl_ + SQ_BK + fr * 80 + fq * 16); F.bk1 = *(const LAS bf16x8s*)(sl_ + SQ_BK + (16 + fr) * 80 + fq * 16); \
        F.bk2 = *(const LAS bf16x8s*)(sl_ + SQ_BK + (32 + fr) * 80 + fq * 16); F.bk3 = *(const LAS bf16x8s*)(sl_ + SQ_BK + (48 + fr) * 80 + fq * 16); \
        F.vt0 = *(const LAS s16x4s*)(sl_ + SQ_VT + (32 * w + fr) * 32 + fq * 8); F.vt1 = *(const LAS s16x4s*)(sl_ + SQ_VT + (32 * w + 16 + fr) * 32 + fq * 8); \
        F.g0 = *(const LAS f32x4s*)(sl_ + SQ_GM + fq * 16); F.g1 = *(const LAS f32x4s*)(sl_ + SQ_GM + 64 + fq * 16); F.g2 = *(const LAS f32x4s*)(sl_ + SQ_GM + 128 + fq * 16); F.g3 = *(const LAS f32x4s*)(sl_ + SQ_GM + 192 + fq * 16); } while (0)
#define SQ_PACK(a, bq) (bf16x8s){(short)(pg8::cvt_pk_bf16(a[0], a[1]) & 0xffff), (short)(pg8::cvt_pk_bf16(a[0], a[1]) >> 16), (short)(pg8::cvt_pk_bf16(a[2], a[3]) & 0xffff), (short)(pg8::cvt_pk_bf16(a[2], a[3]) >> 16), \
                                 (short)(pg8::cvt_pk_bf16(bq[0], bq[1]) & 0xffff), (short)(pg8::cvt_pk_bf16(bq[0], bq[1]) >> 16), (short)(pg8::cvt_pk_bf16(bq[2], bq[3]) & 0xffff), (short)(pg8::cvt_pk_bf16(bq[2], bq[3]) >> 16)}
#define SQ_TILE(F, c, u, VT_) do { \
        const bf16x8s sb0 = SQ_PACK(ST[u][0], ST[u][1]), sb1 = SQ_PACK(ST[u][2], ST[u][3]); \
        const bf16x8s vb = (bf16x8s){0, 0, 0, 0, VT_[0], VT_[1], VT_[2], VT_[3]}; \
        f32x4s U = __builtin_amdgcn_mfma_f32_16x16x32_bf16(F.wp0, sb0, (f32x4s){0.f, 0.f, 0.f, 0.f}, 0, 0, 0); \
        U = __builtin_amdgcn_mfma_f32_16x16x32_bf16(F.wp1, sb1, U, 0, 0, 0); U = __builtin_amdgcn_mfma_f32_16x16x32_bf16(F.m2, vb, U, 0, 0, 0); \
        f32x4s Yv = __builtin_amdgcn_mfma_f32_16x16x32_bf16(F.rp0, sb0, (f32x4s){0.f, 0.f, 0.f, 0.f}, 0, 0, 0); Yv = __builtin_amdgcn_mfma_f32_16x16x32_bf16(F.rp1, sb1, Yv, 0, 0, 0); \
        const unsigned u01 = pg8::cvt_pk_bf16(U[0], U[1]), u23 = pg8::cvt_pk_bf16(U[2], U[3]); \
        const bf16x8s ub = (bf16x8s){(short)(u01 & 0xffff), (short)(u01 >> 16), (short)(u23 & 0xffff), (short)(u23 >> 16), VT_[0], VT_[1], VT_[2], VT_[3]}; \
        Yv = __builtin_amdgcn_mfma_f32_16x16x32_bf16(F.ar, ub, Yv, 0, 0, 0); \
        ST[u][0] = __builtin_amdgcn_mfma_f32_16x16x32_bf16(F.bk0, ub, ST[u][0] * F.g0, 0, 0, 0); ST[u][1] = __builtin_amdgcn_mfma_f32_16x16x32_bf16(F.bk1, ub, ST[u][1] * F.g1, 0, 0, 0); \
        ST[u][2] = __builtin_amdgcn_mfma_f32_16x16x32_bf16(F.bk2, ub, ST[u][2] * F.g2, 0, 0, 0); ST[u][3] = __builtin_amdgcn_mfma_f32_16x16x32_bf16(F.bk3, ub, ST[u][3] * F.g3, 0, 0, 0); \
        LAS float* yl_ = (LAS float*)(slots + 3 * SQ_SLOT + ((c) & 1) * 4096) + (4 * fq) * 64 + 32 * w + 16 * (u) + fr;        \
        yl_[0] = Yv[0]; yl_[64] = Yv[1]; yl_[128] = Yv[2]; yl_[192] = Yv[3]; } while (0)
#define SQ_MF(a, b, c_) __builtin_amdgcn_mfma_f32_16x16x32_bf16(a, b, c_, 0, 0, 0)
#define SQ_STEP(F, c) do { \
        const bf16x8s sa0 = SQ_PACK(ST[0][0], ST[0][1]), sa1 = SQ_PACK(ST[0][2], ST[0][3]), sc0 = SQ_PACK(ST[1][0], ST[1][1]), sc1 = SQ_PACK(ST[1][2], ST[1][3]); \
        const bf16x8s va = (bf16x8s){0, 0, 0, 0, F.vt0[0], F.vt0[1], F.vt0[2], F.vt0[3]}, vc = (bf16x8s){0, 0, 0, 0, F.vt1[0], F.vt1[1], F.vt1[2], F.vt1[3]}; \
        const f32x4s z4_ = (f32x4s){0.f, 0.f, 0.f, 0.f}; \
        f32x4s Ua = SQ_MF(F.wp0, sa0, z4_), Uc = SQ_MF(F.wp0, sc0, z4_); \
        Ua = SQ_MF(F.wp1, sa1, Ua); Uc = SQ_MF(F.wp1, sc1, Uc); \
        f32x4s Ya = SQ_MF(F.rp0, sa0, z4_), Yc = SQ_MF(F.rp0, sc0, z4_); \
        Ua = SQ_MF(F.m2, va, Ua); Uc = SQ_MF(F.m2, vc, Uc); \
        Ya = SQ_MF(F.rp1, sa1, Ya); Yc = SQ_MF(F.rp1, sc1, Yc); \
        const unsigned ua01 = pg8::cvt_pk_bf16(Ua[0], Ua[1]), ua23 = pg8::cvt_pk_bf16(Ua[2], Ua[3]); \
        const bf16x8s uba = (bf16x8s){(short)(ua01 & 0xffff), (short)(ua01 >> 16), (short)(ua23 & 0xffff), (short)(ua23 >> 16), F.vt0[0], F.vt0[1], F.vt0[2], F.vt0[3]}; \
        const unsigned uc01 = pg8::cvt_pk_bf16(Uc[0], Uc[1]), uc23 = pg8::cvt_pk_bf16(Uc[2], Uc[3]); \
        const bf16x8s ubc = (bf16x8s){(short)(uc01 & 0xffff), (short)(uc01 >> 16), (short)(uc23 & 0xffff), (short)(uc23 >> 16), F.vt1[0], F.vt1[1], F.vt1[2], F.vt1[3]}; \
        ST[0][0] = SQ_MF(F.bk0, uba, ST[0][0] * F.g0); ST[1][0] = SQ_MF(F.bk0, ubc, ST[1][0] * F.g0); \
        ST[0][1] = SQ_MF(F.bk1, uba, ST[0][1] * F.g1); ST[1][1] = SQ_MF(F.bk1, ubc, ST[1][1] * F.g1); \
        ST[0][2] = SQ_MF(F.bk2, uba, ST[0][2] * F.g2); ST[1][2] = SQ_MF(F.bk2, ubc, ST[1][2] * F.g2); \
        ST[0][3] = SQ_MF(F.bk3, uba, ST[0][3] * F.g3); ST[1][3] = SQ_MF(F.bk3, ubc, ST[1][3] * F.g3); \
        Ya = SQ_MF(F.ar, uba, Ya); Yc = SQ_MF(F.ar, ubc, Yc); \
        LAS float* yl_ = (LAS float*)(slots + 3 * SQ_SLOT + ((c) & 1) * 4096) + (4 * fq) * 64 + 32 * w + fr;        \
        yl_[0] = Ya[0]; yl_[64] = Ya[1]; yl_[128] = Ya[2]; yl_[192] = Ya[3]; yl_[16] = Yc[0]; yl_[80] = Yc[1]; yl_[144] = Yc[2]; yl_[208] = Yc[3]; } while (0)
#undef SQ_PUT
#define SQ_PUT(j, c) do { LAS unsigned char* sl_ = slots + ((c) % 3) * SQ_SLOT; *(LAS v4u*)(sl_ + ldsP0) = buf0[j]; *(LAS v4u*)(sl_ + ldsP1) = buf1[j]; *(LAS v4u*)(sl_ + ldsP2) = buf2[j]; \
        if (has3) *(LAS v4u*)(sl_ + ldsP3) = buf3[j]; } while (0)
#define SQ_BAR() do { asm volatile("" ::: "memory"); __builtin_amdgcn_s_waitcnt(0xc07f); __builtin_amdgcn_s_barrier(); asm volatile("" ::: "memory"); } while (0)
    constexpr int RD = 12;
    const int nch8 = ((nch + 24) / 24) * 24;
    static_assert(24 % RD == 0, "loop barrier count");
    SQ_BAR();
    if (loader) {
#pragma unroll
        for (int j = 0; j < RD; ++j) SQ_ISSUE(j, j);
        SQ_PUT(0, 0); SQ_ISSUE(0, RD);
        SQ_PUT(1, 1); SQ_ISSUE(1, RD + 1);
        SQ_BAR();
        unsigned long long pacc0 = 0, pacc1 = 0, pacc2 = 0;
        for (int c0 = 0; c0 < nch8; c0 += RD) {
#pragma unroll
            for (int i = 0; i < RD; ++i) { const int c = c0 + i;
#ifdef PROBE_ACC
                const unsigned long long ta_ = __builtin_amdgcn_s_memtime();
                SQ_PUT((i + 2) % RD, c + 2);
                asm volatile("s_waitcnt lgkmcnt(0)" ::: "memory");
                const unsigned long long tb_ = __builtin_amdgcn_s_memtime();
                SQ_ISSUE((i + 2) % RD, c + 2 + RD);
                const unsigned long long tc_ = __builtin_amdgcn_s_memtime();
                SQ_BAR();
                const unsigned long long td_ = __builtin_amdgcn_s_memtime();
                pacc0 += tb_ - ta_; pacc1 += tc_ - tb_; pacc2 += td_ - tc_; }
#else
                SQ_PUT((i + 2) % RD, c + 2); SQ_ISSUE((i + 2) % RD, c + 2 + RD);
                SQ_BAR(); }
#endif
        }
#ifdef PROBE_ACC
        if (g == 0 && tid == 256) { volatile unsigned long long* pa_ = (volatile unsigned long long*)(C.ws + WS_MISC + 2048); pa_[0] = pacc0; pa_[1] = pacc1; pa_[2] = pacc2; }
#endif
    } else if (w < 2) {
        SQ_BAR();
        Frg FA, FB;
        SQ_FRAGS(FA, 0);
#ifdef PROBE_ACC
        unsigned long long qacc = 0, qstep = 0, qwait = 0, qfr = 0; const unsigned long long qt0 = __builtin_amdgcn_s_memtime();
#define SQ_TS() __builtin_amdgcn_s_memtime()
        for (int c = 0; c < nch8; c += 2) {
            const unsigned long long t0_ = SQ_TS();
            if (c + 1 < nch) SQ_FRAGS(FB, c + 1);
            asm volatile("" ::: "memory"); const unsigned long long t1_ = SQ_TS();
            if (c < nch) SQ_STEP(FA, c);
            asm volatile("" ::: "memory"); const unsigned long long t2_ = SQ_TS();
            __builtin_amdgcn_s_waitcnt(0xc07f);
            const unsigned long long t3_ = SQ_TS();
            __builtin_amdgcn_s_barrier(); asm volatile("" ::: "memory");
            const unsigned long long t4_ = SQ_TS();
            if (c + 2 < nch) SQ_FRAGS(FA, c + 2);
            if (c + 1 < nch) SQ_STEP(FB, c + 1);
            SQ_BAR();
            qfr += t1_ - t0_; qstep += t2_ - t1_; qwait += t3_ - t2_; qacc += t4_ - t3_;
        }
#else
        for (int c = 0; c < nch8; c += 2) {
            if (c + 1 < nch) SQ_FRAGS(FB, c + 1);
            if (c < nch) SQ_STEP(FA, c);
            SQ_BAR();
            if (c + 2 < nch) SQ_FRAGS(FA, c + 2);
            if (c + 1 < nch) SQ_STEP(FB, c + 1);
            SQ_BAR();
        }
#endif
#ifdef PROBE_ACC
        if (g == 0 && tid == 0) { volatile unsigned long long* pa_ = (volatile unsigned long long*)(C.ws + WS_MISC + 2048); pa_[3] = qacc; pa_[4] = __builtin_amdgcn_s_memtime() - qt0; pa_[5] = qfr; pa_[6] = qstep; pa_[7] = qwait; }
#endif
    } else {
        SQ_BAR();
        f32x4s ya[4][4];
        for (int c0 = 0; c0 < nch8; c0 += 8) {
#pragma unroll
            for (int i = 0; i < 8; ++i) { const int c = c0 + i, cp = c - 1;
                if (((i + 1) & 1) == (w & 1) || true) {
                    if (cp >= 0 && cp < nch && (cp & 1) == (w & 1)) {
                        const LAS f32x4s* yl = (const LAS f32x4s*)(slots + 3 * SQ_SLOT + (cp & 1) * 4096) + (lane >> 4) * 16 + (lane & 15);
#pragma unroll
                        for (int q = 0; q < 4; ++q) ya[i >> 1][q] = yl[q * 64];
                        unsigned short* yg = (unsigned short*)Y + (size_t)(SQ_ROW0(cp) + (lane >> 4)) * D + h * 64 + 4 * (lane & 15);
#pragma unroll
                        for (int q = 0; q < 4; ++q) { uint2 o_; o_.x = pg8::cvt_pk_bf16(ya[i >> 1][q][0], ya[i >> 1][q][1]); o_.y = pg8::cvt_pk_bf16(ya[i >> 1][q][2], ya[i >> 1][q][3]); *(uint2*)(yg + (size_t)q * 4 * D) = o_; }
                    }
                }
                SQ_BAR(); }
        }
    }
#undef SQ_CH
#undef SQ_ROW0
#undef SQ_ISSUE
#undef SQ_PUT
#undef SQ_FRAGS
#undef SQ_PACK
#undef SQ_TILE
#undef SQ_STEP
    if (w < 2) {
#pragma unroll
        for (int u = 0; u < 2; ++u) {
            float* so = C.out + (prompt ? O_WKVP : O_WKVS) + ((size_t)bh * 64 + 32 * w + 16 * u + fr) * 64;
#pragma unroll
            for (int kt = 0; kt < 4; ++kt) *(f32x4s*)(so + 16 * kt + 4 * fq) = ST[u][kt];
        }
    }
}

__device__ __forceinline__ void p_scan_post(const Ctx& C, const int sel, const int gw, const int NGW) {
    const int lane = C.lane;
    const float* Y = (const float*)(C.ws + U_Y); const bf16_t* Vb = (const bf16_t*)(C.out + O_CKP) + (size_t)2 * MP * D; const bf16_t* GG = (const bf16_t*)(C.ws + U_G);
    const float* BON = (const float*)(C.out + O_BON); bf16_t* YG = (bf16_t*)(C.ws + U_YG);
    f32x4 gg[4], gb[4]; load_row(in_ptr(28), lane, gg); load_row(in_ptr(29), lane, gb);
    for (int r = gw; r < MP; r += NGW) {
        if (sel) { const bool inA = (r < ROW_S) ? ((r & 4095) < (SCAN_C1 - 1) * 16) : (r < ROW_END); if (inA != (sel == 1)) continue; }
        f32x4 o[4];
        if (r >= ROW_END) {
#pragma unroll
            for (int j = 0; j < 4; ++j) o[j] = (f32x4){0.f, 0.f, 0.f, 0.f};
        } else {
            f32x4 y[4];
            { const uint2* yq = (const uint2*)((const unsigned short*)Y + (size_t)r * D) + lane; uint2 yr[4];
#pragma unroll
              for (int j = 0; j < 4; ++j) yr[j] = yq[64 * j];
#pragma unroll
              for (int j = 0; j < 4; ++j) y[j] = (f32x4){__uint_as_float(yr[j].x << 16), __uint_as_float(yr[j].x & 0xffff0000u), __uint_as_float(yr[j].y << 16), __uint_as_float(yr[j].y & 0xffff0000u)}; }
#pragma unroll
            for (int j = 0; j < 4; ++j) {
                float s = (y[j].x + y[j].y) + (y[j].z + y[j].w);
                s += __shfl_xor(s, 1); s += __shfl_xor(s, 2); s += __shfl_xor(s, 4); s += __shfl_xor(s, 8);
                const float mean = s * (1.0f / 64.0f); const f32x4 d = y[j] - mean;
                float q = (d.x * d.x + d.y * d.y) + (d.z * d.z + d.w * d.w);
                q += __shfl_xor(q, 1); q += __shfl_xor(q, 2); q += __shfl_xor(q, 4); q += __shfl_xor(q, 8);
                const float rs = 1.0f / sqrtf(q * (1.0f / 64.0f) + 64e-5f);
                const size_t off = (size_t)r * D + 4 * lane + 256 * j;
                const unsigned long long vv = *(const unsigned long long*)(Vb + off), gv = *(const unsigned long long*)(GG + off);
                const float bn = BON[(size_t)r * 16 + 4 * j + (lane >> 4)];
                f32x4 v4, g4;
                v4.x = __uint_as_float((unsigned)(vv & 0xffffull) << 16); v4.y = __uint_as_float((unsigned)((vv >> 16) & 0xffffull) << 16); v4.z = __uint_as_float((unsigned)((vv >> 32) & 0xffffull) << 16); v4.w = __uint_as_float((unsigned)((vv >> 48) & 0xffffull) << 16);
                g4.x = __uint_as_float((unsigned)(gv & 0xffffull) << 16); g4.y = __uint_as_float((unsigned)((gv >> 16) & 0xffffull) << 16); g4.z = __uint_as_float((unsigned)((gv >> 32) & 0xffffull) << 16); g4.w = __uint_as_float((unsigned)((gv >> 48) & 0xffffull) << 16);
                o[j] = (d * rs * gg[j] + gb[j] + v4 * bn) * g4;
            }
        }
        store_row_bf16(YG + (size_t)r * D, lane, o);
    }
}

enum { TK_SWIGLU = 0, TK_RESID = 1, TK_P4 = 2, TK_P5 = 3, TK_KV = 4, TK_Q = 5, TK_PART = 6 };
struct ThinOut { int kind; float scale; int g; };

__device__ __forceinline__ void thin_epilogue(const Ctx& C, const ThinOut& T, const f32x4s v, int xr0, int col, int fr, int fq) {
    unsigned char* ws = C.ws;
    if (T.kind == TK_SWIGLU) {
        f32x4s up;
#pragma unroll
        for (int e = 0; e < 4; ++e) up[e] = __shfl_xor(v[e], 4);
        if ((fr & 4) == 0) { bf16_t* H = (bf16_t*)(ws + U_H);
#pragma unroll
            for (int e = 0; e < 4; ++e) H[(size_t)(ROW_S + xr0 + e) * FF + (col >> 3) * 4 + (col & 3)] = f2bf_s(v[e] * pg8::fast_sigmoid(v[e]) * up[e]); }
    } else if (T.kind == TK_RESID) {
#pragma unroll
        for (int e = 0; e < 4; ++e) { unsigned short* p = (unsigned short*)xrow_ptr(C.out, (float*)(C.ws + WS_XEXTRA), ROW_S + xr0 + e) + col; float x = __uint_as_float((unsigned)*p << 16);
            if (T.g == 1) { const float* P = (const float*)(ws + WS_PART) + (size_t)(xr0 + e) * 1024 + col; x = x + 0.5f * (((P[0] + P[192 * 1024]) + P[2 * 192 * 1024]) + P[3 * 192 * 1024]); }
            *p = f2bf_s(x + T.scale * v[e]); }
    } else if (T.kind == TK_PART) {
        float* P = (float*)(ws + WS_PART) + (size_t)T.g * 192 * 1024;
#pragma unroll
        for (int e = 0; e < 4; ++e) P[(size_t)(xr0 + e) * 1024 + col] = v[e];
    } else if (T.kind == TK_P4) {
        if (T.g < 3) { bf16_t* O = (bf16_t*)(C.out + O_CKP) + (size_t)T.g * MP * D;
#pragma unroll
            for (int e = 0; e < 4; ++e) O[(size_t)(ROW_S + xr0 + e) * D + col] = f2bf_s(v[e]); }
        else { bf16_t* O = (bf16_t*)(ws + U_LOR) + (size_t)(T.g - 3) * MP * 256;
#pragma unroll
            for (int e = 0; e < 4; ++e) { const float x = (T.g == 3) ? pg8::fast_tanh(v[e]) : (T.g == 5) ? pg8::fast_sigmoid(v[e]) : v[e]; O[(size_t)(ROW_S + xr0 + e) * 256 + col] = f2bf_s(x); } }
    } else if (T.kind == TK_P5) {
#pragma unroll
        for (int e = 0; e < 4; ++e) { const size_t off = (size_t)(ROW_S + xr0 + e) * D + col;
            if (T.g == 0) ((bf16_t*)(ws + U_LOGW))[off] = f2bf_s(-0.6065306597126334f * pg8::fast_sigmoid(v[e] + in_ptr(17)[col]));
            else if (T.g == 1) ((bf16_t*)(ws + U_ASIG))[off] = f2bf_s(pg8::fast_sigmoid(v[e] + in_ptr(20)[col]));
            else ((bf16_t*)(ws + U_G))[off] = f2bf_s(v[e]); }
    } else {
        const bool isQ = (T.kind == TK_Q), isK = isQ || (col < 1024);
        const int c1 = col & 1023; const bool ropeb = isK && ((c1 & 63) < 16);
        f32x4s pr;
#pragma unroll
        for (int e = 0; e < 4; ++e) pr[e] = __shfl_xor(v[e], 8);
        const float* rope = (const float*)(ws + WS_ROPE);
#pragma unroll
        for (int e = 0; e < 4; ++e) { const int xr = xr0 + e, row = ROW_S + xr; float x = v[e];
            const int pos = (xr < 128) ? 2064 + (xr & 15) : ((xr - 128) & 15);
            if (ropeb) { const float cs = rope[(size_t)pos * 16 + (fr & 7)], sn = rope[(size_t)pos * 16 + 8 + (fr & 7)]; x = x * cs + ((fr < 8) ? -pr[e] : pr[e]) * sn; }
            if (isQ) { ((bf16_t*)(ws + U_QB))[(size_t)row * D + c1] = f2bf_s(x * T.scale); }
            else if (xr < 128) { C.out[(isK ? O_CKS : O_CVS) + (size_t)xr * 1024 + c1] = x; }
            else { const int i = xr - 128, b = i >> 4, j = i & 15;
                C.out[(isK ? O_CKP : O_CVP) + ((size_t)b * 4112 + j) * 1024 + c1] = x;
                ((bf16_t*)(ws + (isK ? WS_KMETA : WS_VMETA)))[((size_t)b * 128 + j) * 1024 + c1] = f2bf_s(x); } }
    }
}

template <int NKS, int NB>
__device__ __forceinline__ void thin_unit(const Ctx& C, const bf16_t* A, int lda, const bf16_t* Bt, int ldb, int K, int cb0, int rg, const ThinOut& T, int colbase) {
    const int w = C.wave, lane = C.lane, fr = lane & 15, fq = lane >> 4;
    LAS f32x4s* red = (LAS f32x4s*)(C.lds + RING_OFF);
    const bf16_t* bp = Bt + (size_t)(cb0 * 16 + fr) * ldb + fq * 8;
    const bf16_t* ap = A + (size_t)(ROW_S + rg * 48 + fr) * lda + fq * 8;
    const int nks = K >> 5;
    bf16x8s fb[NB][NKS], fa0[NKS], fa1[NKS], fa2[NKS];
#pragma unroll
    for (int i = 0; i < NKS; ++i) { const int ks = w + 8 * i; const int kc = (ks < nks) ? ks : 0;
        fa0[i] = *(const bf16x8s*)(ap + kc * 32); fa1[i] = *(const bf16x8s*)(ap + (size_t)16 * lda + kc * 32); fa2[i] = *(const bf16x8s*)(ap + (size_t)32 * lda + kc * 32);
#pragma unroll
        for (int nb = 0; nb < NB; ++nb) fb[nb][i] = *(const bf16x8s*)(bp + (size_t)nb * 16 * ldb + kc * 32); }
    f32x4s acc[NB][3];
#pragma unroll
    for (int nb = 0; nb < NB; ++nb) { acc[nb][0] = (f32x4s){0.f, 0.f, 0.f, 0.f}; acc[nb][1] = acc[nb][0]; acc[nb][2] = acc[nb][0]; }
#pragma unroll
    for (int i = 0; i < NKS; ++i) { if (w + 8 * i < nks) {
#pragma unroll
        for (int nb = 0; nb < NB; ++nb) { acc[nb][0] = __builtin_amdgcn_mfma_f32_16x16x32_bf16(fa0[i], fb[nb][i], acc[nb][0], 0, 0, 0); acc[nb][1] = __builtin_amdgcn_mfma_f32_16x16x32_bf16(fa1[i], fb[nb][i], acc[nb][1], 0, 0, 0);
            acc[nb][2] = __builtin_amdgcn_mfma_f32_16x16x32_bf16(fa2[i], fb[nb][i], acc[nb][2], 0, 0, 0); } } }
    __syncthreads();
#pragma unroll
    for (int nb = 0; nb < NB; ++nb)
#pragma unroll
        for (int rt = 0; rt < 3; ++rt) red[(w * (3 * NB) + nb * 3 + rt) * 64 + lane] = acc[nb][rt];
    __syncthreads();
#pragma unroll
    for (int j0 = 0; j0 < 3 * NB; j0 += 8) { const int idx = j0 + w;
        if (idx < 3 * NB) { const int nb = idx / 3, rt = idx - nb * 3;
            f32x4s s = red[(0 * (3 * NB) + idx) * 64 + lane];
#pragma unroll
            for (int j = 1; j < 8; ++j) s += red[(j * (3 * NB) + idx) * 64 + lane];
            thin_epilogue(C, T, s, rg * 48 + rt * 16 + 4 * fq, colbase + (cb0 + nb) * 16 + fr, fr, fq); } }
}

template <int NKS, int NB>
__device__ __forceinline__ int thin_run(const Ctx& C, int u0, const bf16_t* A, int lda, const bf16_t* Bt, int ldb, int K, int nblk, const ThinOut& T, int colbase, const int wg0 = 0, const int nwg_ = 0) {
    const int nwg = nwg_ > 0 ? nwg_ : C.G, rel = (int)blockIdx.x - (nwg_ > 0 ? wg0 : 0);
    const int nun = (nblk / NB) * 4;
    if (rel >= 0 && rel < nwg) {
        const int first = ((rel - (u0 % nwg)) % nwg + nwg) % nwg;
        for (int u = first; u < nun; u += nwg) thin_unit<NKS, NB>(C, A, lda, Bt, ldb, K, (u >> 2) * NB, u & 3, T, colbase); }
    return u0 + nun;
}
__device__ __forceinline__ void thin_run_down_split(const Ctx& C, const bf16_t* A, const bf16_t* Bt) {
    for (int u = (int)blockIdx.x; u < 256; u += C.G) { const int part = u >> 6, koff = part * 768;
        const ThinOut T{TK_PART, 0.f, part};
        thin_unit<3, 4>(C, A + koff, FF, Bt + koff, FF, (part == 3) ? 512 : 768, ((u >> 2) & 15) * 4, u & 3, T, 0); }
}

constexpr float ATT_C2 = 0.125f * 1.4426950408889634f;
constexpr float LAM_INIT = 0.35550906759096924f;
constexpr int SA_QS = 0, SA_SS = 4608, SA_SROW = 2320, SA_T = SA_SS + 32 * SA_SROW, SA_KTB = 17408, SA_VTB = 18432;
__device__ __forceinline__ void sample_attn_unit(const Ctx& C, int unit) {
    const int b = unit >> 5, hh = (unit >> 2) & 7, part = unit & 3, tile0 = (part == 0) ? 0 : 1 + 8 * part, nt = (part == 0) ? 9 : 8;
    const int key_base = tile0 * 64, nvalid = (2080 - key_base) < nt * 64 ? (2080 - key_base) : nt * 64;
    const int tid = C.tid, lane = C.lane, w = C.wave, fr = lane & 15, fq = lane >> 4;
    LAS unsigned char* L = C.lds + RING_OFF;
    const float* ck = in_ptr(2); const float* cv = in_ptr(3);
    __syncthreads();
    if (tid < 256) { const int q = tid >> 4, p16 = tid & 15, c = p16 >> 3, d0 = (p16 & 7) * 8;
        *(LAS v4u*)(L + SA_QS + ((c * 16 + q) * 72 + d0) * 2) = *(const v4u*)((const bf16_t*)(C.ws + U_QB) + (size_t)(ROW_S + b * 16 + q) * D + hh * 128 + c * 64 + d0); }
    const int lkey = tid >> 3, seg = tid & 7;
#define SA_SRC(base_cache, OFF_NEW, t, dst) do { const int gk_ = key_base + 64 * (t) + lkey; \
        if (gk_ < 2064) { const float* s_ = (base_cache) + (((size_t)b * 2064 + gk_) * 8 + hh) * 128 + seg * 16; dst[0] = *(const f32x4*)s_; dst[1] = *(const f32x4*)(s_ + 4); dst[2] = *(const f32x4*)(s_ + 8); dst[3] = *(const f32x4*)(s_ + 12); } \
        else if (gk_ < 2080) { const float* s_ = C.out + (OFF_NEW) + (((size_t)b * 16 + (gk_ - 2064)) * 8 + hh) * 128 + seg * 16; dst[0] = *(const f32x4*)s_; dst[1] = *(const f32x4*)(s_ + 4); dst[2] = *(const f32x4*)(s_ + 8); dst[3] = *(const f32x4*)(s_ + 12); } \
        else { dst[0] = dst[1] = dst[2] = dst[3] = (f32x4){0.f, 0.f, 0.f, 0.f}; } } while (0)
    f32x4 r0[4], r1[4], r2[4];
#define SA_BAR() do { asm volatile("s_waitcnt lgkmcnt(0)" ::: "memory"); __builtin_amdgcn_s_barrier(); asm volatile("" ::: "memory"); } while (0)
    SA_SRC(ck, O_CKS, 0, r0); if (1 < nt) SA_SRC(ck, O_CKS, 1, r1); if (2 < nt) SA_SRC(ck, O_CKS, 2, r2);
#define SA_KPUT(R, t) do { LAS unsigned char* kt_ = L + SA_T + ((t) & 1) * SA_KTB + lkey * 272 + seg * 32; \
        v4u a_, b_; a_.x = pg8::cvt_pk_bf16(R[0].x, R[0].y); a_.y = pg8::cvt_pk_bf16(R[0].z, R[0].w); a_.z = pg8::cvt_pk_bf16(R[1].x, R[1].y); a_.w = pg8::cvt_pk_bf16(R[1].z, R[1].w); \
        b_.x = pg8::cvt_pk_bf16(R[2].x, R[2].y); b_.y = pg8::cvt_pk_bf16(R[2].z, R[2].w); b_.z = pg8::cvt_pk_bf16(R[3].x, R[3].y); b_.w = pg8::cvt_pk_bf16(R[3].z, R[3].w); \
        *(LAS v4u*)kt_ = a_; *(LAS v4u*)(kt_ + 16) = b_; } while (0)
#define SA_SCORE(t) do { const int c_ = w >> 2, kt4_ = w & 3; const LAS unsigned char* kb_ = L + SA_T + ((t) & 1) * SA_KTB + (16 * kt4_ + fr) * 272 + (c_ * 64 + 8 * fq) * 2; \
        const LAS unsigned char* qb_ = L + SA_QS + ((c_ * 16 + fr) * 72 + 8 * fq) * 2; \
        f32x4s s_ = __builtin_amdgcn_mfma_f32_16x16x32_bf16(*(const LAS bf16x8s*)qb_, *(const LAS bf16x8s*)kb_, (f32x4s){0.f, 0.f, 0.f, 0.f}, 0, 0, 0); \
        s_ = __builtin_amdgcn_mfma_f32_16x16x32_bf16(*(const LAS bf16x8s*)(qb_ + 64), *(const LAS bf16x8s*)(kb_ + 64), s_, 0, 0, 0); \
        LAS float* sp_ = (LAS float*)(L + SA_SS + (c_ * 16 + 4 * fq) * SA_SROW) + 64 * (t) + 16 * kt4_ + fr; \
        sp_[0] = s_[0]; sp_[SA_SROW / 4] = s_[1]; sp_[2 * (SA_SROW / 4)] = s_[2]; sp_[3 * (SA_SROW / 4)] = s_[3]; } while (0)
    for (int t0 = 0; t0 < nt; t0 += 3) {
        SA_KPUT(r0, t0); if (t0 + 3 < nt) SA_SRC(ck, O_CKS, t0 + 3, r0); SA_BAR(); SA_SCORE(t0);
        if (t0 + 1 < nt) { SA_KPUT(r1, t0 + 1); if (t0 + 4 < nt) SA_SRC(ck, O_CKS, t0 + 4, r1); SA_BAR(); SA_SCORE(t0 + 1); }
        if (t0 + 2 < nt) { SA_KPUT(r2, t0 + 2); if (t0 + 5 < nt) SA_SRC(ck, O_CKS, t0 + 5, r2); SA_BAR(); SA_SCORE(t0 + 2); }
    }
    SA_SRC(cv, O_CVS, 0, r0); if (1 < nt) SA_SRC(cv, O_CVS, 1, r1); if (2 < nt) SA_SRC(cv, O_CVS, 2, r2);
    __syncthreads();
    float* PT = (float*)(C.ws + U_SPART) + (size_t)unit * 4160;
#pragma unroll
    for (int i = 0; i < 4; ++i) { const int row = 4 * w + i; LAS float* sr = (LAS float*)(L + SA_SS + row * SA_SROW);
        float sv[9]; float m = -INFINITY;
#pragma unroll
        for (int j = 0; j < 9; ++j) { const int k = lane + 64 * j; sv[j] = (k < nvalid) ? sr[k] : -INFINITY; m = fmaxf(m, sv[j]); }
        m = wave_max(m); float l = 0.f;
#pragma unroll
        for (int j = 0; j < 9; ++j) { sv[j] = exp2f(sv[j] - m); l += sv[j]; }
        l = wave_sum(l);
        LAS unsigned short* pr = (LAS unsigned short*)sr;
#pragma unroll
        for (int j = 0; j < 9; ++j) { const int k = lane + 64 * j; if (k < nt * 64) pr[k] = f2bf_s(sv[j]); }
        if (lane == 0) { PT[4096 + row] = m; PT[4096 + 32 + row] = l; } }
    __syncthreads();
#define SA_VPUT(R, t) do { LAS unsigned short* vt_ = (LAS unsigned short*)(L + SA_T + ((t) & 1) * SA_VTB) + (seg * 16) * 72 + lkey; \
        _Pragma("unroll") for (int i_ = 0; i_ < 4; ++i_) { vt_[(4 * i_) * 72] = f2bf_s(R[i_].x); vt_[(4 * i_ + 1) * 72] = f2bf_s(R[i_].y); vt_[(4 * i_ + 2) * 72] = f2bf_s(R[i_].z); vt_[(4 * i_ + 3) * 72] = f2bf_s(R[i_].w); } } while (0)
    f32x4s o0 = {0.f, 0.f, 0.f, 0.f}, o1 = o0;
    const int oc = w >> 2, odt = 2 * (w & 3);
#define SA_PV(t) do { const LAS unsigned char* pb_ = L + SA_SS + (oc * 16 + fr) * SA_SROW + (64 * (t) + 8 * fq) * 2; \
        const LAS unsigned char* vb_ = L + SA_T + ((t) & 1) * SA_VTB + ((16 * odt + fr) * 72 + 8 * fq) * 2; \
        const bf16x8s pa0_ = *(const LAS bf16x8s*)pb_, pa1_ = *(const LAS bf16x8s*)(pb_ + 64); \
        o0 = __builtin_amdgcn_mfma_f32_16x16x32_bf16(pa0_, *(const LAS bf16x8s*)vb_, o0, 0, 0, 0); o0 = __builtin_amdgcn_mfma_f32_16x16x32_bf16(pa1_, *(const LAS bf16x8s*)(vb_ + 64), o0, 0, 0, 0); \
        o1 = __builtin_amdgcn_mfma_f32_16x16x32_bf16(pa0_, *(const LAS bf16x8s*)(vb_ + 16 * 144), o1, 0, 0, 0); o1 = __builtin_amdgcn_mfma_f32_16x16x32_bf16(pa1_, *(const LAS bf16x8s*)(vb_ + 16 * 144 + 64), o1, 0, 0, 0); } while (0)
    for (int t0 = 0; t0 < nt; t0 += 3) {
        SA_VPUT(r0, t0); if (t0 + 3 < nt) SA_SRC(cv, O_CVS, t0 + 3, r0); SA_BAR(); SA_PV(t0);
        if (t0 + 1 < nt) { SA_VPUT(r1, t0 + 1); if (t0 + 4 < nt) SA_SRC(cv, O_CVS, t0 + 4, r1); SA_BAR(); SA_PV(t0 + 1); }
        if (t0 + 2 < nt) { SA_VPUT(r2, t0 + 2); if (t0 + 5 < nt) SA_SRC(cv, O_CVS, t0 + 5, r2); SA_BAR(); SA_PV(t0 + 2); }
    }
#undef SA_SRC
#undef SA_BAR
#undef SA_KPUT
#undef SA_SCORE
#undef SA_VPUT
#undef SA_PV
#pragma unroll
    for (int e = 0; e < 4; ++e) { PT[(oc * 16 + 4 * fq + e) * 128 + 16 * odt + fr] = o0[e]; PT[(oc * 16 + 4 * fq + e) * 128 + 16 * (odt + 1) + fr] = o1[e]; }
    __syncthreads();
}

__device__ __forceinline__ void attn_combine_block(const Ctx& C, const int b, const int hh, const int qb) {
    const bf16_t* O1 = (const bf16_t*)(C.ws + U_O1); const bf16_t* O2 = (const bf16_t*)(C.ws + U_O2); bf16_t* OA = (bf16_t*)(C.ws + U_OA);
    const float lam = ((const float*)(C.ws + WS_MISC))[0];
    const int lane = C.lane, l32 = lane & 31;
    const f32x4 sub = *(const f32x4*)(in_ptr(36) + 4 * l32);
    const size_t off0 = (size_t)(b * 4096 + qb * 256 + C.wave * 32 + (lane >> 5)) * D + hh * 128 + 4 * l32;
    unsigned long long av[16], bv[16];
#pragma unroll
    for (int it = 0; it < 16; ++it) { const size_t off = off0 + (size_t)(2 * it) * D; av[it] = *(const unsigned long long*)(O1 + off); bv[it] = *(const unsigned long long*)(O2 + off); }
#pragma unroll
    for (int it = 0; it < 16; ++it) {
        const size_t off = off0 + (size_t)(2 * it) * D;
        const unsigned long long a = av[it], bb = bv[it];
        f32x4 o;
        o.x = __uint_as_float((unsigned)(a & 0xffffull) << 16) - lam * __uint_as_float((unsigned)(bb & 0xffffull) << 16);
        o.y = __uint_as_float((unsigned)((a >> 16) & 0xffffull) << 16) - lam * __uint_as_float((unsigned)((bb >> 16) & 0xffffull) << 16);
        o.z = __uint_as_float((unsigned)((a >> 32) & 0xffffull) << 16) - lam * __uint_as_float((unsigned)((bb >> 32) & 0xffffull) << 16);
        o.w = __uint_as_float((unsigned)((a >> 48) & 0xffffull) << 16) - lam * __uint_as_float((unsigned)((bb >> 48) & 0xffffull) << 16);
        float ss = (o.x * o.x + o.y * o.y) + (o.z * o.z + o.w * o.w);
        ss += __shfl_xor(ss, 1); ss += __shfl_xor(ss, 2); ss += __shfl_xor(ss, 4); ss += __shfl_xor(ss, 8); ss += __shfl_xor(ss, 16);
        const float rs = 1.0f / sqrtf(ss * (1.0f / 128.0f) + 1e-5f) * (1.0f - LAM_INIT);
        o = o * rs * sub;
        *(unsigned long long*)(OA + off) = (unsigned long long)pk2(o.x, o.y) | ((unsigned long long)pk2(o.z, o.w) << 32);
    }
}
__device__ __forceinline__ void p_attn_main(const Ctx& C, const int i0, const int i1, const int istep) {
    const int v = C.vcu, s = v & 7;
    for (int i = i0; i < i1; i += istep) {
        int combo, qb;
        if (C.G == 256) { combo = ((v >> 3) << 1) | (i & 1); qb = (i < 2) ? 15 - s : s; } else { combo = i >> 4; qb = i & 15; }
        const int c = combo & 1, hh = (combo >> 1) & 7, b = combo >> 4;
        attn_body::attn_unit<8>(b, 2 * hh + c, 2 * hh, qb, C.ws, (long)U_QB, (long)U_KB, (long)U_VB, (long)WS_KMETA, (long)WS_VMETA, (long)(c ? U_O2 : U_O1), (char*)C.lds + RING_OFF, mk_tid(C.wave)); }
}
__device__ __forceinline__ void p_attn(Ctx& C) {
    if (C.G == 256) {
        const int is = (C.vcu >> 3) & 3, hh = (C.vcu >> 3) & 7, b = C.vcu >> 6, s = C.vcu & 7;
        p_attn_main(C, 0, is, 1);
#ifndef NO_SAMPLE
        __syncthreads(); sample_attn_unit(C, C.vcu); __syncthreads();
#endif
        C.lane = mk_lane(); C.tid = (C.wave << 6) | C.lane;
        p_attn_main(C, is, 4, 1);
        asm volatile("s_waitcnt vmcnt(0)" ::: "memory"); __syncthreads();
        C.lane = mk_lane(); C.tid = (C.wave << 6) | C.lane;
        attn_combine_block(C, b, hh, 15 - s); attn_combine_block(C, b, hh, s);
    } else {
        p_attn_main(C, C.vcu, 1024, C.G);
#ifndef NO_SAMPLE
        for (int u = C.vcu; u < 256; u += C.G) sample_attn_unit(C, u);
#endif
    }
}

__device__ __forceinline__ void p_combine(const Ctx& C) {
    const int gw = C.vcu * NWAVES + C.wave, NGW = C.G * NWAVES, lane = C.lane;
    const bf16_t* O1 = (const bf16_t*)(C.ws + U_O1); const bf16_t* O2 = (const bf16_t*)(C.ws + U_O2); bf16_t* OA = (bf16_t*)(C.ws + U_OA);
    const float lam = ((const float*)(C.ws + WS_MISC))[0];
    const f32x4 sub = *(const f32x4*)(in_ptr(36) + 4 * (lane & 31));
    for (int task = gw; task < 1024; task += NGW) {
        const int ri = task >> 3, hh = task & 7, b = ri >> 4, q = ri & 15;
        const float* PT = (const float*)(C.ws + U_SPART) + (size_t)((b * 8 + hh) * 4) * 4160;
        float oc[2][2];
#pragma unroll
        for (int c = 0; c < 2; ++c) {
            float mp[4], lp[4], M = -INFINITY;
#pragma unroll
            for (int p4 = 0; p4 < 4; ++p4) { mp[p4] = PT[p4 * 4160 + 4096 + c * 16 + q]; lp[p4] = PT[p4 * 4160 + 4096 + 32 + c * 16 + q]; M = fmaxf(M, mp[p4]); }
            float L = 0.f, a0 = 0.f, a1 = 0.f;
#pragma unroll
            for (int p4 = 0; p4 < 4; ++p4) { const float wgt = exp2f(mp[p4] - M); L += lp[p4] * wgt; a0 += wgt * PT[p4 * 4160 + (c * 16 + q) * 128 + lane]; a1 += wgt * PT[p4 * 4160 + (c * 16 + q) * 128 + 64 + lane]; }
            oc[c][0] = a0 / L; oc[c][1] = a1 / L;
        }
        const float o0 = oc[0][0] - lam * oc[1][0], o1 = oc[0][1] - lam * oc[1][1];
        const float rs = 1.0f / sqrtf(wave_sum(o0 * o0 + o1 * o1) * (1.0f / 128.0f) + 1e-5f) * (1.0f - LAM_INIT);
        bf16_t* op = OA + (size_t)(ROW_S + ri) * D + hh * 128;
        op[lane] = (bf16_t)f2bf(o0 * rs * in_ptr(36)[lane]); op[64 + lane] = (bf16_t)f2bf(o1 * rs * in_ptr(36)[64 + lane]);
    }
    for (int r = ROW_M + gw; r < MP; r += NGW) {
        f32x4 z[4];
#pragma unroll
        for (int j = 0; j < 4; ++j) z[j] = (f32x4){0.f, 0.f, 0.f, 0.f};
        store_row_bf16(OA + (size_t)r * D, lane, z); }
    if (C.G != 256) for (int r = gw; r < ROW_S; r += NGW) {
        f32x4 o[4];
#pragma unroll
        for (int j = 0; j < 4; ++j) { const size_t off = (size_t)r * D + 4 * lane + 256 * j;
            const unsigned long long a = *(const unsigned long long*)(O1 + off), bb = *(const unsigned long long*)(O2 + off);
            o[j].x = __uint_as_float((unsigned)(a & 0xffffull) << 16) - lam * __uint_as_float((unsigned)(bb & 0xffffull) << 16);
            o[j].y = __uint_as_float((unsigned)((a >> 16) & 0xffffull) << 16) - lam * __uint_as_float((unsigned)((bb >> 16) & 0xffffull) << 16);
            o[j].z = __uint_as_float((unsigned)((a >> 32) & 0xffffull) << 16) - lam * __uint_as_float((unsigned)((bb >> 32) & 0xffffull) << 16);
            o[j].w = __uint_as_float((unsigned)((a >> 48) & 0xffffull) << 16) - lam * __uint_as_float((unsigned)((bb >> 48) & 0xffffull) << 16); }
#pragma unroll
        for (int j = 0; j < 4; ++j) { float ss = (o[j].x * o[j].x + o[j].y * o[j].y) + (o[j].z * o[j].z + o[j].w * o[j].w);
            ss += __shfl_xor(ss, 1); ss += __shfl_xor(ss, 2); ss += __shfl_xor(ss, 4); ss += __shfl_xor(ss, 8); ss += __shfl_xor(ss, 16);
            const float rs = 1.0f / sqrtf(ss * (1.0f / 128.0f) + 1e-5f) * (1.0f - LAM_INIT);
            o[j] = o[j] * rs * sub; }
        store_row_bf16(OA + (size_t)r * D, lane, o);
    }
}

constexpr int N_PHASES = 27;
__global__ void __launch_bounds__(NWAVES * 64, 2) mk_fwd(Args args) {
    extern __shared__ __attribute__((aligned(16))) unsigned char lds[];
    Ctx C;
    C.out = args.out; C.ws = args.ws;
    C.lds = (LAS unsigned char*)lds; C.tid = threadIdx.x; C.lane = C.tid & 63; C.wave = __builtin_amdgcn_readfirstlane(C.tid >> 6);
    C.G = gridDim.x; { const int bx = blockIdx.x; C.vcu = (C.G % 8 == 0) ? (bx % 8) * (C.G / 8) + bx / 8 : bx; }
    volatile LAS unsigned* MISC = (volatile LAS unsigned*)(C.lds + MISC_OFF);
    for (int u = C.tid; u < (LDS_BYTES - LDSCTL_OFF) / 4; u += NWAVES * 64) ((LAS unsigned*)(C.lds + LDSCTL_OFF))[u] = 0u;
    __syncthreads();
    const int lo = args.ph_lo, hi = args.ph_hi;
    const bool use_bar = (hi - lo) > 1;
    XcdBarrier bar; bar.bar = (unsigned*)(args.ws + WS_CTL) + CW_BAR; bar.x = 0; bar.st = nullptr;
    if (use_bar) bar = xcd_barrier_post((unsigned*)(args.ws + WS_CTL) + CW_BAR, MISC + 8, C.tid);
    unsigned char* const ws = C.ws;
#ifdef PROBE_HASH
    if (lo == 100) {
        const unsigned* a = (const unsigned*)C.out; const size_t na = (size_t)42733568;
        const unsigned* b = (const unsigned*)(args.ws + PROBE_HASH_WS_LO); const size_t nb = (size_t)(PROBE_HASH_WS_HI - PROBE_HASH_WS_LO) / 4;
        const size_t gt = (size_t)blockIdx.x * 512 + C.tid, NT_ = (size_t)C.G * 512;
        unsigned h1 = 0x811c9dc5u, h2 = 0x811c9dc5u;
        for (size_t e = gt; e < na; e += NT_) { h1 = (h1 ^ a[e]) * 16777619u; h1 ^= h1 >> 13; }
        for (size_t e = gt; e < nb; e += NT_) { h2 = (h2 ^ b[e]) * 16777619u; h2 ^= h2 >> 13; }
        float* dst = C.out + O_WKVS;
        dst[gt] = (float)(h1 & 0xffffu); dst[131072 + gt] = (float)(h2 & 0xffffu);
        return;
    }
#endif
#define IN(k) (lo <= (k) && (k) < hi)
#define RELAUNDER() do { C.lane = mk_lane(); C.tid = (C.wave << 6) | C.lane; } while (0)
#ifdef PROBE_TIME
    volatile unsigned long long* stamps = (volatile unsigned long long*)(ws + WS_MISC + 1024);
    if (blockIdx.x == 0 && C.tid == 0) stamps[0] = __builtin_amdgcn_s_memrealtime();
#define SEAM(k) do { if (IN(k) && IN((k) + 1)) xcd_barrier(bar, mk_tid(C.wave)); RELAUNDER(); if (blockIdx.x == 0 && C.tid == 0) stamps[(k) + 1] = __builtin_amdgcn_s_memrealtime(); } while (0)
#else
#define SEAM(k) do { if (IN(k) && IN((k) + 1)) xcd_barrier(bar, mk_tid(C.wave)); RELAUNDER(); } while (0)
#endif
#ifdef PROBE_TIME
#define PSTAMP(i) do { __syncthreads(); if (blockIdx.x == 0 && C.tid == 0) stamps[i] = __builtin_amdgcn_s_memrealtime(); } while (0)
#else
#define PSTAMP(i) do { } while (0)
#endif
#ifdef PROBE_TIME
#define SEAM_LOCAL(k) do { if (IN(k) && IN((k) + 1)) __syncthreads(); RELAUNDER(); if (blockIdx.x == 0 && C.tid == 0) stamps[(k) + 1] = __builtin_amdgcn_s_memrealtime(); } while (0)
#else
#define SEAM_LOCAL(k) do { if (IN(k) && IN((k) + 1)) __syncthreads(); RELAUNDER(); } while (0)
#endif
#define GEMM_PHASE_X(k, EPI, NN, MODE, APTR, BPTR, KK, SCALE, ALIGN_, SP2_) do { if (IN(k)) { \
        pg8::Gemm g{(const bf16_t*)(APTR), (const bf16_t*)(BPTR), MP, 0, (KK)}; pg8::GSched<NN, MODE> S; S.init(C.G, (int)blockIdx.x); EPI E{SCALE, C.out, ws, in_ptr(17), in_ptr(20)}; \
        pg8::gemm_phase<EPI, pg8::GSched<NN, MODE>, ALIGN_, SP2_>(C.lds + RING_OFF, g, S, E, mk_tid(C.wave)); RELAUNDER(); } SEAM(k); } while (0)
#define GEMM_PHASE(k, EPI, NN, MODE, APTR, BPTR, KK, SCALE) GEMM_PHASE_X(k, EPI, NN, MODE, APTR, BPTR, KK, SCALE, true, true)
#define FFN_PHASES(k, f) do { \
        GEMM_PHASE(k, pg8::EpiT<pg8::ET_SWIGLU>, NGU / 256, 0, ws + U_XN, (const bf16_t*)(ws + W_GU) + (size_t)(f) * NGU * D, D, 0.f); \
        GEMM_PHASE((k) + 1, pg8::EpiF<pg8::EF_RESID>, 4, 0, ws + U_H, (const bf16_t*)(ws + W_D) + (size_t)(f) * D * FF, FF, 0.5f); } while (0)
#define THIN(k, BODY) do { if (IN(k)) { BODY } } while (0)
#define FFN_THIN(f) \
        THIN_UP(f)
    if (IN(0)) p0_prologue(C); SEAM(0);
#undef FFN_PHASES
#define FFN_PHASES(k, f) do { \
        if (IN(k)) { pg8::Gemm g{(const bf16_t*)(ws + U_XN), (const bf16_t*)(ws + W_GU) + (size_t)(f) * NGU * D, MP, 0, D}; pg8::GSched<NGU / 256, 0, NTM> S; S.init(C.G, (int)blockIdx.x); pg8::EpiT<pg8::ET_SWIGLU> E{0.f, C.out, ws, nullptr, nullptr}; \
            pg8::gemm_phase<pg8::EpiT<pg8::ET_SWIGLU>, pg8::GSched<NGU / 256, 0, NTM>, true, true>(C.lds + RING_OFF, g, S, E, mk_tid(C.wave)); RELAUNDER();        \
            if ((f) < 3 && C.G == 256 && blockIdx.x >= 150 && (int)blockIdx.x < (((f) == 2) ? 248 : 256)) { __syncthreads(); p0_gu(C, (f) + 1, ((int)blockIdx.x - 150) * NWAVES + C.wave, (((f) == 2) ? 98 : 106) * NWAVES); }        \
            else if ((f) < 3 && C.G != 256) { __syncthreads(); p0_gu(C, (f) + 1, C.vcu * NWAVES + C.wave, C.G * NWAVES); } } SEAM(k); \
        if (IN((k) + 1)) { pg8::Gemm g{(const bf16_t*)(ws + U_H), (const bf16_t*)(ws + W_D) + (size_t)(f) * D * FF, MP, 0, FF}; pg8::GSched<4, 0> S; S.init(C.G, (int)blockIdx.x); pg8::EpiF<pg8::EF_RESID> E{0.5f, C.out, ws, nullptr, nullptr}; \
            pg8::gemm_phase<pg8::EpiF<pg8::EF_RESID>, pg8::GSched<4, 0>, true, true>(C.lds + RING_OFF, g, S, E, mk_tid(C.wave)); RELAUNDER(); \
            PSTAMP(40 + 2 * (f)); if ((f) < THIN_SPLIT_MINF) { const ThinOut T{TK_RESID, 0.5f, 0}; thin_run<11, 1>(C, 0, (const bf16_t*)(ws + U_H), FF, (const bf16_t*)(ws + W_D) + (size_t)(f) * D * FF, FF, FF, D / 16, T, 0); } \
            else thin_run_down_split(C, (const bf16_t*)(ws + U_H), (const bf16_t*)(ws + W_D) + (size_t)(f) * D * FF);        \
            PSTAMP(41 + 2 * (f)); } SEAM((k) + 1); } while (0)
#define RESID_PHASE(k, AOFF, WOFF) do { if (IN(k)) { \
            pg8::Gemm g{(const bf16_t*)(ws + (AOFF)), (const bf16_t*)(ws + (WOFF)), MP, 0, D}; pg8::GSched<4, 0> S; S.init(C.G, (int)blockIdx.x); pg8::EpiF<pg8::EF_RESID> E{1.0f, C.out, ws, nullptr, nullptr}; \
            pg8::gemm_phase<pg8::EpiF<pg8::EF_RESID>, pg8::GSched<4, 0>, true, true>(C.lds + RING_OFF, g, S, E, mk_tid(C.wave)); RELAUNDER(); \
            const ThinOut T{TK_RESID, 1.0f, ((k) == 10 && THIN_SPLIT_MINF <= 0) ? 1 : 0};        \
            thin_run<4, 1>(C, 0, (const bf16_t*)(ws + (AOFF)), D, (const bf16_t*)(ws + (WOFF)), D, D, D / 16, T, 0); } SEAM(k); } while (0)
    FFN_PHASES(1, 0);
    if (IN(3)) p_rwmix(C); SEAM(3);
    if (IN(4)) { pg8::Gemm g{(const bf16_t*)(ws + U_A6), (const bf16_t*)(ws + W_RKVL), MP, 0, D}; pg8::GSched<15, 1, NTM> S; S.init(C.G, (int)blockIdx.x); pg8::EpiT<pg8::ET_P4> E{0.f, C.out, ws, nullptr, nullptr};
        pg8::gemm_phase<pg8::EpiT<pg8::ET_P4>, pg8::GSched<15, 1, NTM>, true, true>(C.lds + RING_OFF, g, S, E, mk_tid(C.wave)); RELAUNDER();
        if (C.G == 256 && blockIdx.x >= 207) { __syncthreads();
            p0_transpose(C, in_ptr(11) + (size_t)1 * FF * D, FF, D, FF, D, (bf16_t*)(ws + W_D) + (size_t)1 * D * FF, FF, 0, 0, ((int)blockIdx.x - 207) * NWAVES + C.wave, 49 * NWAVES); } } SEAM(4);
#define P5_GEMM(KIND, gi) do { pg8::Gemm g{(const bf16_t*)(ws + U_LOR) + (size_t)(gi) * MP * 256, (const bf16_t*)(ws + W_LU) + (size_t)(gi) * 1024 * 256, MP, 0, 256}; pg8::GSched<4, 0> S; S.init(C.G, (int)blockIdx.x); \
        pg8::EpiF<KIND> E{0.f, C.out, ws, in_ptr(17), in_ptr(20)}; pg8::gemm_phase<pg8::EpiF<KIND>, pg8::GSched<4, 0>, true, true>(C.lds + RING_OFF, g, S, E, mk_tid(C.wave)); RELAUNDER(); } while (0)
    if (IN(5)) { { pg8::Gemm g{(const bf16_t*)(ws + U_LOR), (const bf16_t*)(ws + W_LU), MP, 0, 256}; pg8::GSched<12, 2> S; S.init(C.G, (int)blockIdx.x);
          pg8::EpiF<pg8::EF_P5ALL> E{0.f, C.out, ws, in_ptr(17), in_ptr(20)}; pg8::gemm_phase<pg8::EpiF<pg8::EF_P5ALL>, pg8::GSched<12, 2>, true, true>(C.lds + RING_OFF, g, S, E, mk_tid(C.wave)); RELAUNDER(); }
        int u0 = 0;
        for (int gi = 0; gi < 3; ++gi) { const ThinOut T{TK_P5, 0.f, gi};
            u0 = thin_run<1, 4>(C, u0, (const bf16_t*)(ws + U_LOR) + (size_t)gi * MP * 256, 256, (const bf16_t*)(ws + W_LU) + (size_t)gi * 1024 * 256, 256, gi == 2 ? 160 : 64, 64, T, 0); } } SEAM(5);
#undef P5_GEMM
    if (IN(6)) p_scan_pre(C, 0); SEAM(6);
    if (IN(7)) { p_scan_seq(C, 0); RELAUNDER(); if (blockIdx.x >= 64) { __syncthreads(); p_scan_pre(C, 1); } } SEAM(7);
    if (IN(8)) { p_scan_seq(C, 1); RELAUNDER();
        if (C.G == 256 && blockIdx.x >= 64) { __syncthreads(); p_scan_post(C, 1, ((int)blockIdx.x - 64) * NWAVES + C.wave, 192 * NWAVES); } } SEAM(8);
    if (IN(9)) p_scan_post(C, (C.G == 256) ? 2 : 0, C.vcu * NWAVES + C.wave, C.G * NWAVES); SEAM(9);
    RESID_PHASE(10, U_YG, W_ORW);
    if (IN(11)) p_norm(C, in_ptr(7) + 1 * D, (bf16_t*)(ws + U_XN), nullptr, nullptr); SEAM(11);
    FFN_PHASES(12, 1);
    if (IN(14)) p_norm(C, in_ptr(30), (bf16_t*)(ws + U_HNKV), in_ptr(7) + 2 * D, (bf16_t*)(ws + U_XN), THIN_SPLIT_MINF <= 1); SEAM(14);
    if (IN(15)) { pg8::Gemm g{(const bf16_t*)(ws + U_HNKV), (const bf16_t*)(ws + W_KV), MP, 0, D}; pg8::GSched<8, 0, NTM> S; S.init(C.G, (C.G == 256) ? ((int)blockIdx.x + 8) % 256 : (int)blockIdx.x); pg8::EpiF<pg8::EF_KV> E{0.f, C.out, ws, nullptr, nullptr};
        pg8::gemm_phase<pg8::EpiF<pg8::EF_KV>, pg8::GSched<8, 0, NTM>, true, true>(C.lds + RING_OFF, g, S, E, mk_tid(C.wave)); RELAUNDER(); } SEAM_LOCAL(15);
    FFN_PHASES(16, 2);
    if (IN(18)) p_norm(C, in_ptr(8) + D, (bf16_t*)(ws + U_HN1), nullptr, nullptr, THIN_SPLIT_MINF <= 2); SEAM(18);
    if (IN(19)) { pg8::Gemm g{(const bf16_t*)(ws + U_HN1), (const bf16_t*)(ws + W_Q), MP, 0, D}; pg8::GSched<4, 0> S; S.init(C.G, (int)blockIdx.x); pg8::EpiF<pg8::EF_Q> E{ATT_C2, C.out, ws, nullptr, nullptr};
        pg8::gemm_phase<pg8::EpiF<pg8::EF_Q>, pg8::GSched<4, 0>, true, true>(C.lds + RING_OFF, g, S, E, mk_tid(C.wave)); RELAUNDER();
        const ThinOut T{TK_Q, ATT_C2, 0}; thin_run<4, 1>(C, 0, (const bf16_t*)(ws + U_HN1), D, (const bf16_t*)(ws + W_Q), D, D, 64, T, 0); } SEAM(19);
    if (IN(20)) p_attn(C); SEAM(20);
    if (IN(21)) p_combine(C); SEAM(21);
    RESID_PHASE(22, U_OA, W_OAT);
    if (IN(23)) p_norm(C, in_ptr(7) + 3 * D, (bf16_t*)(ws + U_XN), nullptr, nullptr); SEAM(23);
    FFN_PHASES(24, 3);
    if (IN(26)) p_final(C);
#ifdef PROBE_TIME
    if (blockIdx.x == 0) { __syncthreads();
#ifdef PROBE_ACC
        const unsigned long long dt = ((volatile unsigned long long*)(ws + WS_MISC + 2048))[PROBE_ACC] / 10;
#else
        const unsigned long long dt = stamps[PROBE_T1] - stamps[PROBE_T0];
#endif
        const float dl = (float)dt * (0.01f / 2000.0f);
        for (int e = C.tid; e < 4096; e += 512) C.out[O_SHP + e] *= (1.0f + dl); }
#endif
#undef THIN
#undef FFN_THIN
#undef RESID_PHASE
#undef IN
#undef SEAM
#undef GEMM_PHASE
#undef GEMM_PHASE_X
#undef FFN_PHASES
}

extern "C" void kernel_launch(void* const* d_in, const int* in_sizes, int n_in, void* d_out, int out_size, void* d_ws, size_t ws_size, hipStream_t stream) {
    static int grid = 0;
    if (grid == 0) {
        if (n_in != 38 || out_size != (int)O_END || ws_size < WS_END) { fprintf(stderr, "kernel_launch: unexpected shapes: n_in %d out %d ws %zu (need %zu)\n", n_in, out_size, ws_size, (size_t)WS_END); grid = -1; return; }
        int dev = 0, cus = 0, per_cu = 0;
        if (hipGetDevice(&dev) != hipSuccess || hipDeviceGetAttribute(&cus, hipDeviceAttributeMultiprocessorCount, dev) != hipSuccess) { grid = -1; return; }
        if (hipFuncSetAttribute((const void*)mk_fwd, hipFuncAttributeMaxDynamicSharedMemorySize, LDS_BYTES) != hipSuccess) { fprintf(stderr, "kernel_launch: hipFuncSetAttribute failed\n"); grid = -1; return; }
        if (hipOccupancyMaxActiveBlocksPerMultiprocessor(&per_cu, (const void*)mk_fwd, NWAVES * 64, LDS_BYTES) != hipSuccess || per_cu < 1) fprintf(stderr, "kernel_launch: occupancy query reports %d\n", per_cu);
        (void)hipGetLastError();
        grid = cus;
    }
    if (grid < 0) return;
    (void)hipMemsetAsync((char*)d_ws + WS_CTL, 0, CTL_ZERO_BYTES, stream);
    Args a{};
    for (int i = 0; i < 38; ++i) a.in[i] = (const float*)d_in[i];
    a.out = (float*)d_out; a.ws = (unsigned char*)d_ws;
#ifndef MK_PER_PHASE
#define MK_PER_PHASE 0
#endif
#if MK_PER_PHASE
#ifndef MK_LAST_PHASE
#define MK_LAST_PHASE N_PHASES
#endif
    for (int ph = 0; ph < MK_LAST_PHASE; ++ph) { a.ph_lo = ph; a.ph_hi = ph + 1; hipLaunchKernelGGL(mk_fwd, dim3(grid), dim3(NWAVES * 64), LDS_BYTES, stream, a); }
#ifdef PROBE_HASH
    a.ph_lo = 100; a.ph_hi = 101; hipLaunchKernelGGL(mk_fwd, dim3(grid), dim3(NWAVES * 64), LDS_BYTES, stream, a);
#endif
#else
    a.ph_lo = 0; a.ph_hi = N_PHASES; hipLaunchKernelGGL(mk_fwd, dim3(grid), dim3(NWAVES * 64), LDS_BYTES, stream, a);
#endif
}
```

```cpp
#define MK_PER_PHASE 0

#include <hip/hip_runtime.h>
#include <hip/hip_bf16.h>
#include <cstdio>
#include <cstdint>
#include <cmath>

constexpr int D = 1024, FF = 2816, NGU = 2 * FF;
constexpr int NTM = 65, MP = NTM * 256;
constexpr int ROW_S = 16384, ROW_M = 16512, ROW_END = 16576;
constexpr size_t O_YP = 0, O_YS = 16777216, O_WKVP = 16908288, O_SHP = 17170432, O_CKP = 17174528, O_CVP = 34017280, O_WKVS = 50860032, O_SHS = 51384320, O_CKS = 51392512, O_CVS = 51523584, O_END = 51654656;
constexpr size_t MiB = 1u << 20;
constexpr size_t WS_CTL = 0, CTL_ZERO_BYTES = 32768;
constexpr size_t WS_XEXTRA = 1 * MiB;
constexpr size_t WS_ROPE = 1 * MiB + 512 * 1024;
constexpr size_t WS_MISC = 2 * MiB;
constexpr size_t WS_KMETA = 3 * MiB, WS_VMETA = 4 * MiB;
#ifndef THIN_SPLIT_MINF
#define THIN_SPLIT_MINF 0
#endif
constexpr size_t WS_PART = 5 * MiB;
constexpr size_t WS_W = 8 * MiB;
constexpr size_t W_GU = WS_W, W_D = W_GU + 44 * MiB, W_RKVL = W_D + 22 * MiB, W_ORW = W_RKVL + 7 * MiB + 512 * 1024, W_LU = W_ORW + 2 * MiB, W_KV = W_LU + 1 * MiB + 512 * 1024, W_Q = W_KV + 4 * MiB, W_OAT = W_Q + 2 * MiB, W_END = W_OAT + 2 * MiB;
static_assert(W_END == 93 * MiB, "weight map");
constexpr size_t WS_U = 96 * MiB;
constexpr size_t S1 = (size_t)MP * 1024 * 2;
constexpr size_t U_XN = WS_U, U_H = WS_U + S1;
constexpr size_t U_A6 = WS_U, U_LOR = WS_U + 6 * S1;
constexpr size_t U_LOGW = WS_U, U_ASIG = WS_U + 2 * S1, U_G = WS_U + 3 * S1;
constexpr size_t U_BK = WS_U + 4 * S1, U_VT = WS_U + 6 * S1, U_SM = WS_U + 7 * S1;
constexpr size_t U_SPART = WS_U + 7 * S1;
constexpr size_t U_Y = WS_U + S1, U_YG = WS_U + 2 * S1;
constexpr size_t O_GAM = 42733568, O_BON = O_GAM + 1060864;
static_assert(O_BON + (size_t)MP * 16 <= O_WKVS && O_CKP + 3 * S1 / 4 == O_GAM, "d_out scratch");
constexpr size_t U_HNKV = WS_U + 4 * S1, U_KB = WS_U + 5 * S1, U_VB = WS_U + 6 * S1;
constexpr size_t U_HN1 = WS_U + 4 * S1, U_QB = WS_U, U_O1 = WS_U + S1, U_O2 = WS_U + 2 * S1, U_OA = WS_U + 3 * S1;
constexpr size_t WS_END = WS_U + 8 * S1;
static_assert(U_H + (size_t)MP * FF * 2 <= U_HNKV, "H overlay");
static_assert(U_LOR + 3 * (size_t)MP * 256 * 2 <= WS_END, "lora overlay");

__device__ __forceinline__ float* xrow_ptr(float* dout, float* xextra, int r) { return r < ROW_M ? dout + (size_t)r * D : xextra + (size_t)(r - ROW_M) * D; }


__device__ __forceinline__ const float* in_ptr(int i) {
    auto kp = (const float* const __attribute__((address_space(4)))*)__builtin_amdgcn_kernarg_segment_ptr();
    asm volatile("" : "+s"(kp));
    return kp[i];
}

__device__ __forceinline__ int mk_lane() { unsigned z = 0; asm volatile("" : "+v"(z)); return (int)__builtin_amdgcn_mbcnt_hi(~0u, __builtin_amdgcn_mbcnt_lo(~0u, z)); }
__device__ __forceinline__ int mk_tid(int wave) { return (wave << 6) | mk_lane(); }

namespace pg8 {
#define PG8_LAS __attribute__((address_space(3)))
typedef unsigned short bf16_t;
typedef short bf16x8 __attribute__((ext_vector_type(8)));
typedef float f32x4 __attribute__((ext_vector_type(4)));
typedef unsigned u32x4 __attribute__((ext_vector_type(4)));
constexpr int BM = 256, BK = 64, HALF = 128, HTB = HALF * BK * 2  , STAGE_BYTES = 8 * HTB, NXCD = 8, WGM = 8;

__host__ __device__ __forceinline__ int lds_byte(int r, int c) { const int st = (r >> 4) * 2 + (c >> 5), rr = r & 15, cc = c & 31, ob = rr * 64 + cc * 2; return st * 1024 + (ob ^ (((ob >> 9) & 1) << 5)); }
__host__ __device__ __forceinline__ void stage_rc(int b, int& R, int& C) { const int st = b / 1024, sb = b % 1024, swz = sb ^ (((sb >> 9) & 1) << 5); R = (st >> 1) * 16 + swz / 64; C = (st & 1) * 32 + (swz % 64) / 2; }
__host__ __device__ __forceinline__ int perm32(int rho) { const int n = rho >> 4, i = rho & 15; return 8 * (i >> 2) + 4 * n + (i & 3); }

struct Unit { int pm, pn; };
struct Gemm { const bf16_t* A; const bf16_t* Bt; int M, N, K; };

struct StaticOrder {
    int nM, nN, nwg, G, c;
    __host__ __device__ void init(int M, int N, int G_, int c_) { nM = M / BM; nN = N / BM; nwg = nM * nN; G = G_; c = c_; }
    __host__ __device__ bool next(int i, Unit& u) const {
        const long L = (long)i * G + c; if (L >= nwg) return false;
        int wgid = (int)L; { const int q = nwg / NXCD, r = nwg % NXCD, xcd = wgid % NXCD, off = wgid / NXCD; wgid = (xcd < r ? xcd * (q + 1) : r * (q + 1) + (xcd - r) * q) + off; }
        const int nig = WGM * nN, gid = wgid / nig, fm = gid * WGM, gsz = (nM - fm) < WGM ? (nM - fm) : WGM;
        u.pm = fm + ((wgid % nig) % gsz); u.pn = (wgid % nig) / gsz; return true;
    }
    __device__ __forceinline__ void a_ready(const Unit&) const {}
    __device__ __forceinline__ void done(const Unit&) const {}
};

typedef float f32x2 __attribute__((ext_vector_type(2)));
typedef __bf16 bf16x2_cv __attribute__((ext_vector_type(2)));
__device__ __forceinline__ unsigned cvt_pk_bf16(float lo, float hi) { const f32x2 v = {lo, hi}; const bf16x2_cv b = __builtin_convertvector(v, bf16x2_cv); return __builtin_bit_cast(unsigned, b); }

template <int nN, int mode, int nMt = NTM - 1> struct GSched {
    int G, c;
    __device__ __forceinline__ void init(int G_, int c_) { G = G_; c = c_; }
    __device__ __forceinline__ bool next(int i, Unit& u) const {
        const int nM = nMt, nwg = nM * nN;
        const long L = (long)i * G + c; if (L >= nwg) return false;
        int wgid = (int)L; { const int q = nwg / NXCD, r = nwg % NXCD, xcd = wgid % NXCD, off = wgid / NXCD; wgid = (xcd < r ? xcd * (q + 1) : r * (q + 1) + (xcd - r) * q) + off; }
        const int nig = WGM * nN, gid = wgid / nig, fm = gid * WGM, gsz = (nM - fm) < WGM ? (nM - fm) : WGM;
        const int pm = fm + ((wgid % nig) % gsz), ct = (wgid % nig) / gsz;
        int g = 0;
        if (mode == 1) g = (ct < 12) ? (ct >> 2) : (ct - 9); else if (mode == 2) g = ct >> 2;
        u.pm = pm + g * NTM; u.pn = ct; return true;
    }
    __device__ __forceinline__ void a_ready(const Unit&) const {}
    __device__ __forceinline__ void done(const Unit&) const {}
};

__device__ __forceinline__ float fast_sigmoid(float x) { return __builtin_amdgcn_rcpf(1.0f + __expf(-x)); }
__device__ __forceinline__ float fast_tanh(float x) { return 1.0f - 2.0f * __builtin_amdgcn_rcpf(__expf(2.0f * x) + 1.0f); }
typedef unsigned u32x2 __attribute__((ext_vector_type(2)));


enum { ET_SWIGLU = 0, ET_P4 = 1 };
template <int kind> struct EpiT {
    static constexpr bool PERM = true, AFTER_DRAIN = false;
    float scale; float* dout; unsigned char* ws; const float* pa; const float* pb;
    __device__ __forceinline__ void operator()(const f32x4 (&acc)[2][2][4][2], const Unit& u, int wr, int wc, int fr, int fq) const {
        if constexpr (kind == ET_SWIGLU) {
            bf16_t* O0 = (bf16_t*)(ws + U_H);
            const int row0 = u.pm * BM + wr * 64 + fr, hcol0 = (u.pn * BM + wc * 32 + 8 * fq) >> 1;
#pragma unroll
            for (int ai = 0; ai < 2; ++ai)
#pragma unroll
                for (int m = 0; m < 4; ++m) { bf16_t* rowp = O0 + (size_t)(row0 + ai * HALF + m * 16) * FF + hcol0;
#pragma unroll
                    for (int bj = 0; bj < 2; ++bj) { const f32x4 gt = acc[ai][bj][m][0], up = acc[ai][bj][m][1]; f32x4 h;
#pragma unroll
                        for (int e = 0; e < 4; ++e) h[e] = gt[e] * fast_sigmoid(gt[e]) * up[e];
                        u32x2 w; w.x = cvt_pk_bf16(h[0], h[1]); w.y = cvt_pk_bf16(h[2], h[3]);
                        *(u32x2*)(rowp + bj * (HALF / 2)) = w; } }
        } else {
            bf16_t* O0 = (bf16_t*)(dout + O_CKP); bf16_t* O1 = (bf16_t*)(ws + U_LOR);
            const int pn = u.pn; int g, pnl; if (pn < 12) { g = pn >> 2; pnl = pn & 3; } else { g = pn - 9; pnl = 0; }
            const int pml = u.pm - NTM * g, row0 = pml * BM + wr * 64 + fr, col0 = pnl * BM + wc * 32 + 8 * fq;
            bf16_t* base; int ldc, act;
            if (g < 3) { base = O0 + (size_t)g * MP * 1024; ldc = 1024; act = 0; } else { base = O1 + (size_t)(g - 3) * MP * 256; ldc = 256; act = (g == 3) ? 1 : ((g == 5) ? 2 : 0); }
#pragma unroll
            for (int ai = 0; ai < 2; ++ai)
#pragma unroll
                for (int m = 0; m < 4; ++m) { bf16_t* rowp = base + (size_t)(row0 + ai * HALF + m * 16) * ldc + col0;
#pragma unroll
                    for (int bj = 0; bj < 2; ++bj) { f32x4 v0 = acc[ai][bj][m][0], v1 = acc[ai][bj][m][1];
                        if (act == 1) {
#pragma unroll
                            for (int e = 0; e < 4; ++e) { v0[e] = fast_tanh(v0[e]); v1[e] = fast_tanh(v1[e]); } }
                        else if (act == 2) {
#pragma unroll
                            for (int e = 0; e < 4; ++e) { v0[e] = fast_sigmoid(v0[e]); v1[e] = fast_sigmoid(v1[e]); } }
                        u32x4 w; w.x = cvt_pk_bf16(v0[0], v0[1]); w.y = cvt_pk_bf16(v0[2], v0[3]); w.z = cvt_pk_bf16(v1[0], v1[1]); w.w = cvt_pk_bf16(v1[2], v1[3]);
                        *(u32x4*)(rowp + bj * HALF) = w; } }
        }
    }
};

enum { EF_RESID = 0, EF_P5 = 1, EF_KV = 2, EF_Q = 3, EF_P5A = 4, EF_P5G = 5, EF_P5ALL = 6 };
template <int kind> struct EpiF {
    static constexpr bool PERM = false, AFTER_DRAIN = false;
    float scale;
    float* dout; unsigned char* ws; const float* pa; const float* pb;
    __device__ __forceinline__ void operator()(const f32x4 (&acc)[2][2][4][2], const Unit& u, int wr, int wc, int fr, int fq) const {
        float* xextra = (float*)(ws + WS_XEXTRA);
        if constexpr (kind == EF_RESID) {
            const int row0 = u.pm * BM + wr * 64 + fr, col0 = u.pn * BM + wc * 32 + 4 * fq;
#pragma unroll
            for (int ai = 0; ai < 2; ++ai)
#pragma unroll
                for (int m = 0; m < 4; ++m) { unsigned short* rowp = (unsigned short*)xrow_ptr(dout, xextra, row0 + ai * HALF + m * 16) + col0;
#pragma unroll
                    for (int bj = 0; bj < 2; ++bj)
#pragma unroll
                        for (int n = 0; n < 2; ++n) { u32x2* p = (u32x2*)(rowp + bj * HALF + n * 16); const u32x2 t = *p;
                            const f32x4 a = acc[ai][bj][m][n];
                            u32x2 o; o.x = cvt_pk_bf16(__uint_as_float(t.x << 16) + a[0] * scale, __uint_as_float(t.x & 0xffff0000u) + a[1] * scale);
                            o.y = cvt_pk_bf16(__uint_as_float(t.y << 16) + a[2] * scale, __uint_as_float(t.y & 0xffff0000u) + a[3] * scale); *p = o; } }
        } else if constexpr (kind == EF_P5 || kind == EF_P5A || kind == EF_P5G || kind == EF_P5ALL) {
            const float* p0 = pa; const float* p1 = pb; float* f0 = (float*)(ws + U_LOGW); bf16_t* h0 = (bf16_t*)(ws + U_ASIG); bf16_t* h1 = (bf16_t*)(ws + U_G);
            const int g = (kind == EF_P5ALL) ? (u.pn >> 2) : (kind == EF_P5) ? 0 : (kind == EF_P5A ? 1 : 2); const int pnl = (kind == EF_P5ALL) ? (u.pn & 3) : u.pn, pml = (kind == EF_P5ALL) ? u.pm - NTM * g : u.pm, row0 = pml * BM + wr * 64 + fr, col0 = pnl * BM + wc * 32 + 4 * fq;
#pragma unroll
            for (int bj = 0; bj < 2; ++bj)
#pragma unroll
                for (int n = 0; n < 2; ++n) { const int c = col0 + bj * HALF + n * 16;
                    f32x4 bias = (f32x4){0.f, 0.f, 0.f, 0.f};
#ifndef PROBE_NO_BIAS
                    if (g == 0) bias = *(const f32x4*)(p0 + c); else if (g == 1) bias = *(const f32x4*)(p1 + c);
#endif
#pragma unroll
                    for (int ai = 0; ai < 2; ++ai)
#pragma unroll
                        for (int m = 0; m < 4; ++m) { const size_t off = (size_t)(row0 + ai * HALF + m * 16) * 1024 + c; const f32x4 v = acc[ai][bj][m][n] + bias;
                            if (g == 0) { f32x4 o;
#pragma unroll
                                for (int e = 0; e < 4; ++e) o[e] = -0.6065306597126334f * fast_sigmoid(v[e]);
                                u32x2 w; w.x = cvt_pk_bf16(o[0], o[1]); w.y = cvt_pk_bf16(o[2], o[3]); *(u32x2*)((bf16_t*)f0 + off) = w; }
                            else if (g == 1) { u32x2 w; w.x = cvt_pk_bf16(fast_sigmoid(v[0]), fast_sigmoid(v[1])); w.y = cvt_pk_bf16(fast_sigmoid(v[2]), fast_sigmoid(v[3])); *(u32x2*)(h0 + off) = w; }
                            else { u32x2 w; w.x = cvt_pk_bf16(v[0], v[1]); w.y = cvt_pk_bf16(v[2], v[3]); *(u32x2*)(h1 + off) = w; } } }
        } else {
            const bool isQ = (kind == EF_Q), isK = isQ || (u.pn < 4);
            const float* p0 = (const float*)(ws + WS_ROPE);
            bf16_t* h0 = (bf16_t*)(ws + (isQ ? U_QB : U_KB)); bf16_t* h1 = (bf16_t*)(ws + U_VB); bf16_t* h2 = (bf16_t*)(ws + WS_KMETA); bf16_t* h3 = (bf16_t*)(ws + WS_VMETA);
            const int colbase = (u.pn & 3) * BM + wc * 32 + 4 * fq;
            const bool ropew = isK && ((wc & 1) == 0);
#pragma unroll
            for (int ai = 0; ai < 2; ++ai)
#pragma unroll
                for (int m = 0; m < 4; ++m) {
                    const int row = u.pm * BM + ai * HALF + wr * 64 + m * 16 + fr;
                    int pos; float* fdst = nullptr; bf16_t* bdst = nullptr; bool valid = true;
                    if (row < ROW_S) { const int b = row >> 12, t = row & 4095; pos = 16 + t;
                        if (isQ) bdst = h0 + (size_t)row * 1024; else { fdst = dout + (isK ? O_CKP : O_CVP) + ((size_t)b * 4112 + 16 + t) * 1024; bdst = (isK ? h0 : h1) + (size_t)row * 1024; } }
                    else if (row < ROW_M) { const int i = row - ROW_S; pos = 2064 + (i & 15);
                        if (isQ) bdst = h0 + (size_t)row * 1024; else fdst = dout + (isK ? O_CKS : O_CVS) + (size_t)i * 1024; }
                    else if (row < ROW_END) { const int i = row - ROW_M, b = i >> 4, j = i & 15; pos = j;
                        if (isQ) bdst = h0 + (size_t)row * 1024; else { fdst = dout + (isK ? O_CKP : O_CVP) + ((size_t)b * 4112 + j) * 1024; bdst = (isK ? h2 : h3) + ((size_t)b * 128 + j) * 1024; } }
                    else { pos = 0; valid = false; }
                    f32x4 cs = (f32x4){1.f, 1.f, 1.f, 1.f}, sn = (f32x4){0.f, 0.f, 0.f, 0.f};
                    if (ropew) { cs = *(const f32x4*)(p0 + (size_t)pos * 16 + 4 * (fq & 1)); sn = *(const f32x4*)(p0 + (size_t)pos * 16 + 8 + 4 * (fq & 1)); }
#pragma unroll
                    for (int bj = 0; bj < 2; ++bj)
#pragma unroll
                        for (int n = 0; n < 2; ++n) { f32x4 v = acc[ai][bj][m][n];
                            if (n == 0 && ropew) { f32x4 pr;
#pragma unroll
                                for (int e = 0; e < 4; ++e) pr[e] = __shfl_xor(v[e], 32);
                                const float sg = (fq < 2) ? -1.f : 1.f;
#pragma unroll
                                for (int e = 0; e < 4; ++e) v[e] = v[e] * cs[e] + sg * pr[e] * sn[e]; }
                            if (isQ) v = v * scale;
                            const int c = colbase + bj * HALF + n * 16;
                            if (valid) { if (fdst) *(f32x4*)(fdst + c) = v;
                                if (bdst) { u32x2 w; w.x = cvt_pk_bf16(v[0], v[1]); w.y = cvt_pk_bf16(v[2], v[3]); *(u32x2*)(bdst + c) = w; } } }
                }
        }
    }
};
template <class Epi, class Sched, bool ALIGN_EPI = false, bool SP2 = false>
__device__ __forceinline__ void gemm_phase(PG8_LAS unsigned char* lds, const Gemm g, const Sched& S, const Epi& E, const int tid) {
    const int wid = __builtin_amdgcn_readfirstlane(tid >> 6), lane = tid & 63, wr = wid >> 2, wc = wid & 3, fr = lane & 15, fq = lane >> 4;
    const int K = g.K, nt = K / BK;
    unsigned voffA[2], voffB[2];
#pragma unroll
    for (int i = 0; i < 2; ++i) { int R, C; stage_rc(tid * 16 + i * 8192, R, C); const int Rb = Epi::PERM ? ((R & ~31) + perm32(R & 31)) : R;
        voffA[i] = (unsigned)(R * K + C) * 2u; voffB[i] = (unsigned)(Rb * K + C) * 2u; }
    const size_t kstep = (size_t)(BK * 2);
    const size_t hstep = (size_t)HALF * K * 2;
    const size_t tstep = 2 * hstep;
    const unsigned ldsw = (unsigned)wid * 1024u;
    const int aoff = lds_byte(wr * 64 + fr, fq * 8), boff = lds_byte(wc * 32 + fr, fq * 8);
#define PG8_SA(b, h) (((b) * 2 + (h)) * HTB)
#define PG8_SB(b, h) ((4 + (b) * 2 + (h)) * HTB)
#define PG8_STAGE(bufoff, gbase, voff) do { _Pragma("unroll") for (int _i = 0; _i < 2; ++_i) \
        __builtin_amdgcn_global_load_lds((const unsigned*)((const char*)(gbase) + (voff)[_i]), (PG8_LAS unsigned*)(lds + (bufoff) + ldsw + _i * 8192), 16, 0, 0); } while (0)
#define PG8_LDA(dst, b, h) do { _Pragma("unroll") for (int m = 0; m < 4; ++m) _Pragma("unroll") for (int k = 0; k < 2; ++k) dst[m][k] = *(const PG8_LAS bf16x8*)(lds + PG8_SA(b, h) + aoff + m * 2048 + k * 1024); } while (0)
#define PG8_LDB(dst, b, h) do { _Pragma("unroll") for (int n = 0; n < 2; ++n) _Pragma("unroll") for (int k = 0; k < 2; ++k) dst[n][k] = *(const PG8_LAS bf16x8*)(lds + PG8_SB(b, h) + boff + n * 2048 + k * 1024); } while (0)
#define PG8_MMA(ai, bj, At, Bt) do { __builtin_amdgcn_s_setprio(1); _Pragma("unroll") for (int m = 0; m < 4; ++m) _Pragma("unroll") for (int n = 0; n < 2; ++n) _Pragma("unroll") for (int k = 0; k < 2; ++k) \
        acc[ai][bj][m][n] = __builtin_amdgcn_mfma_f32_16x16x32_bf16(Bt[n][k], At[m][k], acc[ai][bj][m][n], 0, 0, 0); __builtin_amdgcn_s_setprio(0); } while (0)
#define PG8_WAIT_V(n) asm volatile("s_waitcnt vmcnt(" #n ")" ::: "memory")
#define PG8_WAIT_L(n) asm volatile("s_waitcnt lgkmcnt(" #n ")" ::: "memory")
#define PG8_BAR __builtin_amdgcn_s_barrier()
#define PG8_SCHED __builtin_amdgcn_sched_barrier(0)
    Unit cur, nxt; int ui = 0;
    if (!S.next(0, cur)) return;
    f32x4 acc[2][2][4][2];
#pragma unroll
    for (int a = 0; a < 2; ++a)
#pragma unroll
        for (int b = 0; b < 2; ++b)
#pragma unroll
            for (int m = 0; m < 4; ++m)
#pragma unroll
                for (int n = 0; n < 2; ++n) acc[a][b][m][n] = (f32x4){0.f, 0.f, 0.f, 0.f};
    bf16x8 At[4][2], B0[2][2], B1[2][2];
    const char* cA = (const char*)g.A + (size_t)cur.pm * tstep; const char* cB = (const char*)g.Bt + (size_t)cur.pn * tstep;
    S.a_ready(cur);
    if constexpr (SP2) {
        PG8_STAGE(PG8_SB(0, 0), cB, voffB); PG8_STAGE(PG8_SB(0, 1), cB + hstep, voffB); PG8_STAGE(PG8_SA(0, 0), cA, voffA); PG8_STAGE(PG8_SA(0, 1), cA + hstep, voffA);
        if (wr == 1) PG8_BAR;
        PG8_WAIT_V(2); PG8_BAR;
        PG8_STAGE(PG8_SB(1, 0), cB + kstep, voffB); PG8_STAGE(PG8_SA(1, 0), cA + kstep, voffA); PG8_STAGE(PG8_SB(1, 1), cB + hstep + kstep, voffB);
        PG8_WAIT_V(6); PG8_BAR;
    } else {
        PG8_STAGE(PG8_SB(0, 0), cB, voffB); PG8_STAGE(PG8_SA(0, 0), cA, voffA); PG8_STAGE(PG8_SB(0, 1), cB + hstep, voffB); PG8_STAGE(PG8_SA(0, 1), cA + hstep, voffA);
        if (wr == 1) PG8_BAR;
        PG8_WAIT_V(4); PG8_BAR;
        PG8_STAGE(PG8_SB(1, 0), cB + kstep, voffB); PG8_STAGE(PG8_SA(1, 0), cA + kstep, voffA); PG8_STAGE(PG8_SB(1, 1), cB + hstep + kstep, voffB);
        PG8_WAIT_V(6); PG8_BAR;
    }
    for (;;) {
        const bool has_next = S.next(ui + 1, nxt);
        const char* nA = has_next ? (const char*)g.A + (size_t)nxt.pm * tstep : cA; const char* nB = has_next ? (const char*)g.Bt + (size_t)nxt.pn * tstep : cB;
        for (int t = 0; t < nt; t += 2) {
            const bool last = (t == nt - 2);
            const char* a1 = cA + (size_t)(t + 1) * kstep;
            const char* a2 = last ? nA : cA + (size_t)(t + 2) * kstep; const char* b2 = last ? nB : cB + (size_t)(t + 2) * kstep;
            const char* a3 = a2 + kstep; const char* b3 = b2 + kstep;
            if (last && has_next) S.a_ready(nxt);
            if constexpr (SP2) {
            PG8_LDB(B0, 0, 0); PG8_LDB(B1, 0, 1); PG8_SCHED; PG8_LDA(At, 0, 0); PG8_STAGE(PG8_SA(1, 1), a1 + hstep, voffA);
            PG8_WAIT_V(8); PG8_WAIT_L(0); PG8_BAR; PG8_MMA(0, 0, At, B0); PG8_MMA(0, 1, At, B1); PG8_BAR; PG8_SCHED;
            PG8_LDA(At, 0, 1); PG8_STAGE(PG8_SB(0, 0), b2, voffB); PG8_STAGE(PG8_SB(0, 1), b2 + hstep, voffB); PG8_STAGE(PG8_SA(0, 0), a2, voffA);
            PG8_WAIT_V(8); PG8_WAIT_L(0); PG8_BAR; PG8_MMA(1, 0, At, B0); PG8_MMA(1, 1, At, B1); PG8_BAR; PG8_SCHED;
            PG8_LDB(B0, 1, 0); PG8_LDB(B1, 1, 1); PG8_SCHED; PG8_LDA(At, 1, 0); PG8_STAGE(PG8_SA(0, 1), a2 + hstep, voffA);
            PG8_WAIT_V(8); PG8_WAIT_L(0); PG8_BAR; PG8_MMA(0, 0, At, B0); PG8_MMA(0, 1, At, B1); PG8_BAR; PG8_SCHED;
            PG8_LDA(At, 1, 1); PG8_STAGE(PG8_SB(1, 0), b3, voffB); PG8_STAGE(PG8_SB(1, 1), b3 + hstep, voffB); PG8_STAGE(PG8_SA(1, 0), a3, voffA);
            PG8_WAIT_V(8); PG8_WAIT_L(0); PG8_BAR; PG8_MMA(1, 0, At, B0); PG8_MMA(1, 1, At, B1); PG8_BAR; PG8_SCHED;
            } else {
            PG8_LDB(B0, 0, 0); PG8_SCHED; PG8_LDA(At, 0, 0); PG8_STAGE(PG8_SA(1, 1), a1 + hstep, voffA);
            PG8_WAIT_L(8); PG8_BAR; PG8_WAIT_L(0); PG8_MMA(0, 0, At, B0); PG8_BAR; PG8_SCHED;
            PG8_LDB(B1, 0, 1); PG8_STAGE(PG8_SB(0, 0), b2, voffB);
            PG8_BAR; PG8_WAIT_L(0); PG8_MMA(0, 1, At, B1); PG8_BAR;
            PG8_LDA(At, 0, 1); PG8_STAGE(PG8_SA(0, 0), a2, voffA);
            PG8_BAR; PG8_WAIT_L(0); PG8_MMA(1, 0, At, B0); PG8_BAR; PG8_SCHED;
            PG8_STAGE(PG8_SB(0, 1), b2 + hstep, voffB);
            PG8_WAIT_V(6); PG8_BAR; PG8_MMA(1, 1, At, B1); PG8_BAR;
            PG8_LDB(B0, 1, 0); PG8_SCHED; PG8_LDA(At, 1, 0); PG8_STAGE(PG8_SA(0, 1), a2 + hstep, voffA);
            PG8_WAIT_L(8); PG8_BAR; PG8_WAIT_L(0); PG8_MMA(0, 0, At, B0); PG8_BAR; PG8_SCHED;
            PG8_LDB(B1, 1, 1); PG8_STAGE(PG8_SB(1, 0), b3, voffB);
            PG8_BAR; PG8_WAIT_L(0); PG8_MMA(0, 1, At, B1); PG8_BAR;
            PG8_LDA(At, 1, 1); PG8_STAGE(PG8_SA(1, 0), a3, voffA);
            PG8_BAR; PG8_WAIT_L(0); PG8_MMA(1, 0, At, B0); PG8_BAR; PG8_SCHED;
            PG8_STAGE(PG8_SB(1, 1), b3 + hstep, voffB);
            PG8_WAIT_V(6); PG8_BAR; PG8_MMA(1, 1, At, B1); PG8_BAR;
            }
        }
        if constexpr (ALIGN_EPI) { if (wr == 0) PG8_BAR; }
        if constexpr (!Epi::AFTER_DRAIN) { E(acc, cur, wr, wc, fr, fq); S.done(cur); }
        if (!has_next) break;
#pragma unroll
        for (int a = 0; a < 2; ++a)
#pragma unroll
            for (int b = 0; b < 2; ++b)
#pragma unroll
                for (int m = 0; m < 4; ++m)
#pragma unroll
                    for (int n = 0; n < 2; ++n) acc[a][b][m][n] = (f32x4){0.f, 0.f, 0.f, 0.f};
        cur = nxt; cA = nA; cB = nB; ++ui;
        if constexpr (ALIGN_EPI) { if (wr == 1) PG8_BAR; }
    }
    PG8_WAIT_V(0);
    if constexpr (!ALIGN_EPI) { if (wr == 0) PG8_BAR; }
    PG8_BAR;
    if constexpr (Epi::AFTER_DRAIN) { E.fused(acc, cur, wr, wc, fr, fq, lds, wid, lane); S.done(cur); }
#undef PG8_SA
#undef PG8_SB
#undef PG8_STAGE
#undef PG8_LDA
#undef PG8_LDB
#undef PG8_MMA
#undef PG8_WAIT_V
#undef PG8_WAIT_L
#undef PG8_BAR
#undef PG8_SCHED
}
}
#include <hip/hip_bf16.h>
#include <cmath>
namespace attn_body {
using bf16=__hip_bfloat16;
using bf16x8=__attribute__((ext_vector_type(8)))short;
using s16x4=__attribute__((ext_vector_type(4)))short;
using f32x16=__attribute__((ext_vector_type(16)))float;
using u32x4=__attribute__((ext_vector_type(4)))unsigned;
constexpr int BATCH=4,NHEAD=16,SEQ=4096,D=64,DM=NHEAD*D;
constexpr int NW=8,QBLK=32,QB=QBLK*NW,KVBLK=64,NQB=SEQ/QB;
constexpr int ATTN_PITCH=DM, ATTN_UNIT_ROWS=QB;
__device__ __forceinline__ int crow(int r,int hi){return (r&3)+8*(r>>2)+4*hi;}
#define SBAR() __builtin_amdgcn_sched_barrier(0)
__device__ __forceinline__ void bmask(f32x16&p0,f32x16&p1,int jb,int wid,int hi){
  const float NEG=-INFINITY;
  const bool all=(jb<4)?(jb>(wid>>1)):(jb==5); const bool meta=(jb==4);
  const bool m0lo=all, m0hi=all||meta, m1=all||meta;
  #pragma unroll
  for(int r=0;r<8;++r)p0[r]=m0lo?NEG:p0[r];
  #pragma unroll
  for(int r=8;r<16;++r)p0[r]=m0hi?NEG:p0[r];
  #pragma unroll
  for(int r=0;r<16;++r)p1[r]=m1?NEG:p1[r];
}

constexpr int NSLOT=3, SLOTB=8192;
constexpr int LDS_K=0, LDS_V=NSLOT*SLOTB, LDS_WS=3*NSLOT*SLOTB, LDS_OST=LDS_WS+NW*64*4, LDS_BYTES=LDS_OST+NW*4096;
constexpr float C2=0.125f*1.4426950408889634f;
__device__ __forceinline__ void glds16(const void*gsrc,unsigned lds_dst){unsigned keep;
  asm volatile("s_mov_b32 %0, m0\n\ts_mov_b32 m0, %2\n\ts_nop 0\n\tglobal_load_lds_dwordx4 %1, off\n\ts_mov_b32 m0, %0":"=&s"(keep):"v"(gsrc),"s"(lds_dst):"memory");}
__device__ __forceinline__ float max3f(float a,float b,float c){float r;asm("v_max3_f32 %0, %1, %2, %3":"=v"(r):"v"(a),"v"(b),"v"(c));return r;}
__device__ __forceinline__ float max2f(float a,float b){float r;asm("v_max_f32_e32 %0, %1, %2":"=v"(r):"v"(a),"v"(b));return r;}
__device__ __forceinline__ float fadd_s(float a,float b){float r;asm("v_add_f32_e32 %0, %1, %2":"=v"(r):"v"(a),"v"(b));return r;}
__device__ __forceinline__ float fsub_s(float a,float b){float r;asm("v_sub_f32_e32 %0, %1, %2":"=v"(r):"v"(a),"v"(b));return r;}
typedef float f32x2_t __attribute__((ext_vector_type(2))); typedef __bf16 bf16x2_t __attribute__((ext_vector_type(2)));
__device__ __forceinline__ unsigned cvtpk_s(float lo,float hi){f32x2_t v={lo,hi};bf16x2_t b=__builtin_convertvector(v,bf16x2_t);return __builtin_bit_cast(unsigned,b);}
#define WAIT_BAR(N) asm volatile("s_waitcnt vmcnt(" #N ") lgkmcnt(0)\n\ts_barrier":::"memory")

__device__ __forceinline__ void qkt(f32x16&p0,f32x16&p1,const char*Kslot,const bf16x8*qr,int r32,int hi){ const f32x16 negm=f32x16{};
  const char*kb=Kslot+hi*1024+r32*16;
  #pragma unroll
  for(int d0=0;d0<4;++d0){
    const bf16x8 b0=*reinterpret_cast<const bf16x8*>(kb+d0*2048);
    const bf16x8 b1=*reinterpret_cast<const bf16x8*>(kb+d0*2048+512);
    if(d0==0){p0=__builtin_amdgcn_mfma_f32_32x32x16_bf16(b0,qr[0],negm,0,0,0);p1=__builtin_amdgcn_mfma_f32_32x32x16_bf16(b1,qr[0],negm,0,0,0);}
    else{p0=__builtin_amdgcn_mfma_f32_32x32x16_bf16(b0,qr[d0],p0,0,0,0);p1=__builtin_amdgcn_mfma_f32_32x32x16_bf16(b1,qr[d0],p1,0,0,0);}}
}
typedef __attribute__((address_space(3))) const char* lds_cptr;
typedef short v4i16_t __attribute__((ext_vector_type(4)));
__device__ __forceinline__ void kload8(bf16x8*kf,lds_cptr kp){
  kf[0]=*(const __attribute__((address_space(3))) bf16x8*)(kp);      kf[1]=*(const __attribute__((address_space(3))) bf16x8*)(kp+512);
  kf[2]=*(const __attribute__((address_space(3))) bf16x8*)(kp+2048); kf[3]=*(const __attribute__((address_space(3))) bf16x8*)(kp+2560);
  kf[4]=*(const __attribute__((address_space(3))) bf16x8*)(kp+4096); kf[5]=*(const __attribute__((address_space(3))) bf16x8*)(kp+4608);
  kf[6]=*(const __attribute__((address_space(3))) bf16x8*)(kp+6144); kf[7]=*(const __attribute__((address_space(3))) bf16x8*)(kp+6656);
}
__device__ __forceinline__ void kload2(bf16x8*kf,lds_cptr kp,int j){ kf[2*j]=*(const __attribute__((address_space(3))) bf16x8*)(kp+j*2048); kf[2*j+1]=*(const __attribute__((address_space(3))) bf16x8*)(kp+j*2048+512); }
__device__ __forceinline__ s16x4 vtr(lds_cptr p){ return __builtin_bit_cast(s16x4,__builtin_amdgcn_ds_read_tr16_b64_v4i16((__attribute__((address_space(3))) v4i16_t*)p)); }
__device__ __forceinline__ float rowmax(const f32x16&p0,const f32x16&p1){
  float a=max3f(p0[0],p0[1],p1[0]),b=max3f(p0[2],p0[3],p1[1]);a=max3f(a,p1[2],p1[3]);
  #pragma unroll
  for(int r=4;r<16;r+=4){a=max3f(a,p0[r],p0[r+1]);b=max3f(b,p0[r+2],p0[r+3]);a=max3f(a,p1[r],p1[r+1]);b=max3f(b,p1[r+2],p1[r+3]);}
  const float m=max2f(a,b);
  auto rr=__builtin_amdgcn_permlane32_swap(__float_as_uint(m),__float_as_uint(m),false,false);
  return max2f(__uint_as_float(rr[0]),__uint_as_float(rr[1]));
}
__device__ __forceinline__ void pv(f32x16*o,int vb,bf16x8 pa0,bf16x8 pa1,bf16x8 pa2,bf16x8 pa3){
  #pragma unroll
  for(int d0=0;d0<2;++d0){s16x4 lo[4],hi[4];
    #pragma unroll
    for(int ks=0;ks<4;++ks){
      asm volatile("ds_read_b64_tr_b16 %0,%1 offset:%c2":"=&v"(lo[ks]):"v"(vb),"i"(d0*4096+ks*1024):"memory");
      asm volatile("ds_read_b64_tr_b16 %0,%1 offset:%c2":"=&v"(hi[ks]):"v"(vb),"i"(d0*4096+ks*1024+512):"memory");}
    asm volatile("s_waitcnt lgkmcnt(0)":::"memory");SBAR();
    #define PK(k) (bf16x8){lo[k][0],lo[k][1],lo[k][2],lo[k][3],hi[k][0],hi[k][1],hi[k][2],hi[k][3]}
    o[d0]=__builtin_amdgcn_mfma_f32_32x32x16_bf16(pa0,PK(0),o[d0],0,0,0);
    o[d0]=__builtin_amdgcn_mfma_f32_32x32x16_bf16(pa1,PK(1),o[d0],0,0,0);
    o[d0]=__builtin_amdgcn_mfma_f32_32x32x16_bf16(pa2,PK(2),o[d0],0,0,0);
    o[d0]=__builtin_amdgcn_mfma_f32_32x32x16_bf16(pa3,PK(3),o[d0],0,0,0);
    #undef PK
  }
}

#ifndef ATTN_STORE16
#define ATTN_STORE16(p,v) (*(u32x4*)(p)=(v))
#endif
template<int THRL> __device__ __forceinline__ void attn_unit(int b,int h,int hv,int qb,const unsigned char*wsb,long oQ,long oK,long oV,long oKM,long oVM,long oO,char*shm,const int tid){
  const bf16*Q=(const bf16*)(wsb+oQ); const bf16*__restrict__ K=(const bf16*)(wsb+oK); const bf16*__restrict__ V=(const bf16*)(wsb+oV); const bf16*__restrict__ KM=(const bf16*)(wsb+oKM); const bf16*__restrict__ VM=(const bf16*)(wsb+oVM); bf16*O=(bf16*)(wsb+oO);
  const int lane=tid&63,r32=lane&31,hi=lane>>5; const int wid=__builtin_amdgcn_readfirstlane(tid>>6);
  const long rowbase=(long)b*SEQ; const int q0=qb*QB;
  const bf16*Qw=Q+(rowbase+q0+wid*QBLK)*DM+h*D;
  const bf16*Kh=K+rowbase*DM+h*D,*Vh=V+rowbase*DM+hv*D;
  const unsigned lds0=(unsigned)(uintptr_t)shm;
  float*wsf=(float*)(shm+LDS_WS)+wid*64;
  const bf16*ksrc=Kh+(long)lane*DM+wid*8;
  const bf16*vsrc=Vh+(long)(16*(wid&3)+(lane>>2))*DM+(wid>>2)*32+(lane&3)*8;
  const long dKm=(long)(KM-K)+((long)b*128-rowbase)*DM, dVm=(long)(VM-V)+((long)b*128-rowbase)*DM;
  const int NTF=(q0+QB)/KVBLK, NT=NTF+2;
  const unsigned kdst=lds0+LDS_K+wid*1024, vdst=lds0+LDS_V+wid*1024;
  #define DMA_K(t,slot) glds16(ksrc+(((t)<NTF)?(long)(t)*KVBLK*DM:dKm+(long)((t)-NTF)*KVBLK*DM),(unsigned)__builtin_amdgcn_readfirstlane(kdst+(slot)))
  #define DMA_V(t,slot) do{ const bf16*vs_=vsrc+(((t)<NTF)?(long)(t)*KVBLK*DM:dVm+(long)((t)-NTF)*KVBLK*DM); const unsigned vd_=(unsigned)__builtin_amdgcn_readfirstlane(vdst+2*(slot)); glds16(vs_,vd_); glds16(vs_+64,vd_+8192); }while(0)
  const int vb0=(int)(lds0+LDS_V)+((lane>>4)&1)*32+(lane&3)*8+(4*hi+((lane&15)>>2))*64;
  const char*Kbase=shm+LDS_K; bf16x8 kf[8];
  const lds_cptr shm3=(lds_cptr)shm; const lds_cptr kp0=shm3+LDS_K+hi*1024+r32*16; const lds_cptr vp0=shm3+LDS_V+((lane>>4)&1)*32+(lane&3)*8+(4*hi+((lane&15)>>2))*64;
  DMA_K(0,0);DMA_V(0,0);DMA_K(1,SLOTB);
  bf16x8 qr[4];
  #pragma unroll
  for(int d0=0;d0<4;++d0)qr[d0]=*reinterpret_cast<const bf16x8*>(&Qw[(long)r32*DM+d0*16+hi*8]);
  float mhat=0.f,l_reg=0.f;f32x16 o[4];o[0]=f32x16{};o[1]=f32x16{};o[2]=f32x16{};o[3]=f32x16{};
  #define CMASK(P0,P1,t) do{int jb_=(t)-(NT-6); if(jb_>=0)bmask(P0,P1,jb_,wid,hi);}while(0)
  bool resc=false;
  #define START(P0,P1) do{ const float rm=rowmax(P0,P1); resc=false; \
    { const float dl=rm; mhat=fadd_s(mhat,dl); \
      _Pragma("unroll") for(int r=0;r<16;++r){P0[r]=fsub_s(P0[r],dl);P1[r]=fsub_s(P1[r],dl);} \
      } \
    _Pragma("unroll") for(int r=0;r<16;++r)P0[r]=__builtin_amdgcn_exp2f(P0[r]); }while(0)
  #define RESC() do{ if(resc){ asm volatile("s_waitcnt lgkmcnt(0)":::"memory"); \
      _Pragma("unroll") for(int d_=0;d_<4;++d_) _Pragma("unroll") for(int r=0;r<16;++r)o[d_][r]*=wsf[crow(r,hi)]; } }while(0)
  f32x16 pA0,pA1,pB0,pB1;
  int sl_prev=0,sl_cur=0,sl_next=SLOTB;
  #define ROT() do{sl_prev=sl_cur;sl_cur=sl_next;sl_next=(sl_next==(NSLOT-1)*SLOTB)?0:sl_next+SLOTB;}while(0)
  DMA_K(2,2*SLOTB);
  WAIT_BAR(3);
  qkt(pA0,pA1,Kbase,qr,r32,hi);asm volatile("s_nop 15\n\ts_nop 7":"+v"(pA0),"+v"(pA1));CMASK(pA0,pA1,0);
  START(pA0,pA1);
  _Pragma("unroll") for(int r=0;r<16;++r)pA1[r]=__builtin_amdgcn_exp2f(pA1[r]);
  WAIT_BAR(0);
  DMA_K(3,0);DMA_V(1,SLOTB);
  ROT();
  kload8(kf,kp0+sl_cur);
  WAIT_BAR(3);
  s16x4 vlo[8],vhi[8]; u32x4 pw0,pw1,pw2,pw3;
  #define PKW(P,B) cvtpk_s(P[B],P[B+1])
  #define PAF(k) __builtin_bit_cast(bf16x8,pw##k)
  #define VFR(i) (bf16x8){vlo[i][0],vlo[i][1],vlo[i][2],vlo[i][3],vhi[i][0],vhi[i][1],vhi[i][2],vhi[i][3]}
  #define PIN(x) asm volatile("":"+v"(x))
  #define MX3(a,b,c) __builtin_fmaxf(__builtin_fmaxf((a),(b)),(c))
  #define GAPA(MF,A0,A1,A2,A3,W0,W1,PW) do{ MF; sacc+=A0; sacc+=A1; sacc+=A2; sacc+=A3; PIN(sacc); W0; W1; PIN(PW); SBAR(); }while(0)
  #define EX(v) __builtin_amdgcn_exp2f(v)
  #define GAPB(MF,X,B) do{ MF; X[B]=EX(X[B]); X[B+1]=EX(X[B+1]); X[B+2]=EX(X[B+2]); X[B+3]=EX(X[B+3]); PIN(X); SBAR(); }while(0)
  #define VRD(i) do{ vlo[i]=vtr(vp_+(((i)>>2)*4096+((i)&3)*1024)); vhi[i]=vtr(vp_+(((i)>>2)*4096+((i)&3)*1024+512)); }while(0)
  #define VRD2(i) do{ vlo[i]=vtr(vp_+(8192+((i)>>2)*4096+((i)&3)*1024)); vhi[i]=vtr(vp_+(8192+((i)>>2)*4096+((i)&3)*1024+512)); }while(0)
  #define GAPC(MF,X,B,RL) do{ MF; X[B]=EX(X[B]-mhat); X[B+1]=EX(X[B+1]-mhat); PIN(X); RL; SBAR(); }while(0)
  #define KRD(G,j) do{ if(G){ kload2(kf,kp0+sl_next,j); SBAR(); } }while(0)
  #define STEP(C0,C1,P0,P1,t,GK,GV,GL) do{ SBAR(); \
    const lds_cptr vp_=vp0+2*sl_prev; \
    VRD(0); SBAR(); float sacc=(P0[0]+P0[1]); \
    GAPA(C0=__builtin_amdgcn_mfma_f32_32x32x16_bf16(kf[0],qr[0],(f32x16{}),0,0,0), P0[2],P0[3],P0[4],P0[5],     pw0[0]=PKW(P0,0), pw0[1]=PKW(P0,2), pw0); \
    VRD(4); SBAR(); GAPA(C1=__builtin_amdgcn_mfma_f32_32x32x16_bf16(kf[1],qr[0],(f32x16{}),0,0,0), P0[6],P0[7],P0[8],P0[9],     pw0[2]=PKW(P0,4), pw0[3]=PKW(P0,6), pw0); \
    VRD(1); SBAR(); GAPA(C0=__builtin_amdgcn_mfma_f32_32x32x16_bf16(kf[2],qr[1],C0,0,0,0),   P0[10],P0[11],P0[12],P0[13], pw1[0]=PKW(P0,8), pw1[1]=PKW(P0,10), pw1); \
    VRD(5); SBAR(); GAPA(C1=__builtin_amdgcn_mfma_f32_32x32x16_bf16(kf[3],qr[1],C1,0,0,0),   P0[14],P0[15],P1[0],P1[1],   pw1[2]=PKW(P0,12),pw1[3]=PKW(P0,14), pw1); \
    VRD(2); SBAR(); GAPA(C0=__builtin_amdgcn_mfma_f32_32x32x16_bf16(kf[4],qr[2],C0,0,0,0),   P1[2],P1[3],P1[4],P1[5],     pw2[0]=PKW(P1,0), pw2[1]=PKW(P1,2), pw2); \
    VRD(6); SBAR(); GAPA(C1=__builtin_amdgcn_mfma_f32_32x32x16_bf16(kf[5],qr[2],C1,0,0,0),   P1[6],P1[7],P1[8],P1[9],     pw2[2]=PKW(P1,4), pw2[3]=PKW(P1,6), pw2); \
    VRD(3); SBAR(); GAPA(C0=__builtin_amdgcn_mfma_f32_32x32x16_bf16(kf[6],qr[3],C0,0,0,0),   P1[10],P1[11],P1[12],P1[13], pw3[0]=PKW(P1,8), pw3[1]=PKW(P1,10), pw3); \
    VRD(7); SBAR(); GAPA(C1=__builtin_amdgcn_mfma_f32_32x32x16_bf16(kf[7],qr[3],C1,0,0,0),   P1[14],P1[15],0.f,0.f,       pw3[2]=PKW(P1,12),pw3[3]=PKW(P1,14), pw3); \
    l_reg+=sacc; \
    if(GK){DMA_K((t)+3,sl_cur);} if(GV){DMA_V((t)+1,sl_next);} \
    CMASK(C0,C1,t); \
    { float a=MX3(C0[0],C0[1],C1[0]),b=MX3(C0[2],C0[3],C1[1]); a=MX3(a,C1[2],C1[3]); \
      _Pragma("unroll") for(int r=4;r<16;r+=4){a=MX3(a,C0[r],C0[r+1]);b=MX3(b,C0[r+2],C0[r+3]);a=MX3(a,C1[r],C1[r+1]);b=MX3(b,C1[r+2],C1[r+3]);} \
      float rm=__builtin_fmaxf(a,b); { auto rr=__builtin_amdgcn_permlane32_swap(__float_as_uint(rm),__float_as_uint(rm),false,false); rm=__builtin_fmaxf(__uint_as_float(rr[0]),__uint_as_float(rr[1]))-mhat; } \
      resc=false; \
      if(__builtin_expect(__any(rm>(float)THRL),0)){ const float dl=__builtin_fmaxf(rm,0.f); mhat+=dl; \
        const float f=__builtin_amdgcn_exp2f(-dl); l_reg*=f; if(hi==0)wsf[r32]=f; resc=true; } } \
    SBAR(); \
    GAPC(o[0]=__builtin_amdgcn_mfma_f32_32x32x16_bf16(PAF(0),VFR(0),o[0],0,0,0), C0,0, VRD2(0)); \
    GAPC(o[1]=__builtin_amdgcn_mfma_f32_32x32x16_bf16(PAF(0),VFR(4),o[1],0,0,0), C0,2, VRD2(4)); \
    KRD(GL,0); GAPC(o[0]=__builtin_amdgcn_mfma_f32_32x32x16_bf16(PAF(1),VFR(1),o[0],0,0,0), C0,4, VRD2(1)); \
    KRD(GL,1); GAPC(o[1]=__builtin_amdgcn_mfma_f32_32x32x16_bf16(PAF(1),VFR(5),o[1],0,0,0), C0,6, VRD2(5)); \
    KRD(GL,2); GAPC(o[0]=__builtin_amdgcn_mfma_f32_32x32x16_bf16(PAF(2),VFR(2),o[0],0,0,0), C0,8, VRD2(2)); \
    KRD(GL,3); GAPC(o[1]=__builtin_amdgcn_mfma_f32_32x32x16_bf16(PAF(2),VFR(6),o[1],0,0,0), C0,10, VRD2(6)); \
    GAPC(o[0]=__builtin_amdgcn_mfma_f32_32x32x16_bf16(PAF(3),VFR(3),o[0],0,0,0), C0,12, VRD2(3)); \
    GAPC(o[1]=__builtin_amdgcn_mfma_f32_32x32x16_bf16(PAF(3),VFR(7),o[1],0,0,0), C0,14, VRD2(7)); \
    GAPC(o[2]=__builtin_amdgcn_mfma_f32_32x32x16_bf16(PAF(0),VFR(0),o[2],0,0,0), C1,0, (void)0); \
    GAPC(o[3]=__builtin_amdgcn_mfma_f32_32x32x16_bf16(PAF(0),VFR(4),o[3],0,0,0), C1,2, (void)0); \
    GAPC(o[2]=__builtin_amdgcn_mfma_f32_32x32x16_bf16(PAF(1),VFR(1),o[2],0,0,0), C1,4, (void)0); \
    GAPC(o[3]=__builtin_amdgcn_mfma_f32_32x32x16_bf16(PAF(1),VFR(5),o[3],0,0,0), C1,6, (void)0); \
    GAPC(o[2]=__builtin_amdgcn_mfma_f32_32x32x16_bf16(PAF(2),VFR(2),o[2],0,0,0), C1,8, (void)0); \
    GAPC(o[3]=__builtin_amdgcn_mfma_f32_32x32x16_bf16(PAF(2),VFR(6),o[3],0,0,0), C1,10, (void)0); \
    GAPC(o[2]=__builtin_amdgcn_mfma_f32_32x32x16_bf16(PAF(3),VFR(3),o[2],0,0,0), C1,12, (void)0); \
    GAPC(o[3]=__builtin_amdgcn_mfma_f32_32x32x16_bf16(PAF(3),VFR(7),o[3],0,0,0), C1,14, (void)0); \
    }while(0)
  int t=1;
  #undef CMASK
  #define CMASK(P0,P1,t) do{}while(0)
  for(;t+7<NT;t+=2){
    STEP(pB0,pB1,pA0,pA1,t,true,true,true);     WAIT_BAR(3); RESC(); ROT();
    STEP(pA0,pA1,pB0,pB1,t+1,true,true,true);   WAIT_BAR(3); RESC(); ROT();
  }
  #undef CMASK
  #define CMASK(P0,P1,t) do{int jb_=(t)-(NT-6); if(jb_>=0)bmask(P0,P1,jb_,wid,hi);}while(0)
  #define ENDW(tt) do{ if((tt)+3<NT){WAIT_BAR(3);} else if((tt)+2<NT){WAIT_BAR(2);} else {WAIT_BAR(0);} }while(0)
  for(;t+1<NT;t+=2){
    STEP(pB0,pB1,pA0,pA1,t,(t+3<NT),(t+1<NT),(t+1<NT));       ENDW(t);   RESC(); ROT();
    STEP(pA0,pA1,pB0,pB1,t+1,(t+4<NT),(t+2<NT),(t+2<NT));     ENDW(t+1); RESC(); ROT();
  }
  STEP(pB0,pB1,pA0,pA1,NT-1,false,false,false); RESC();
  { float sacc=pB0[0]+pB0[1]; _Pragma("unroll") for(int r=2;r<16;++r)sacc+=pB0[r]; _Pragma("unroll") for(int r=0;r<16;++r)sacc+=pB1[r]; l_reg+=sacc;
    pw0=(u32x4){PKW(pB0,0),PKW(pB0,2),PKW(pB0,4),PKW(pB0,6)};pw1=(u32x4){PKW(pB0,8),PKW(pB0,10),PKW(pB0,12),PKW(pB0,14)};pw2=(u32x4){PKW(pB1,0),PKW(pB1,2),PKW(pB1,4),PKW(pB1,6)};pw3=(u32x4){PKW(pB1,8),PKW(pB1,10),PKW(pB1,12),PKW(pB1,14)};
    SBAR(); pv(o,vb0+2*sl_cur,PAF(0),PAF(1),PAF(2),PAF(3)); pv(o+2,vb0+2*sl_cur+8192,PAF(0),PAF(1),PAF(2),PAF(3)); }
  #undef PKW
  #undef PAF
  #undef VFR
  #undef PIN
  #undef MX3
  #undef GAPA
  #undef GAPB
  #undef EX
  #undef VRD
  #undef VRD2
  #undef GAPC
  #undef KRD
  #undef STEP
  #undef ENDW
  {auto rr=__builtin_amdgcn_permlane32_swap(__float_as_uint(l_reg),__float_as_uint(l_reg),false,false);l_reg=__uint_as_float(rr[0])+__uint_as_float(rr[1]);}
  if(hi==0)wsf[32+r32]=l_reg;asm volatile("s_waitcnt lgkmcnt(0)":::"memory");
  float rli[16];
  #pragma unroll
  for(int r=0;r<16;++r)rli[r]=__builtin_amdgcn_rcpf(wsf[32+crow(r,hi)]);
  bf16*Ow=O+(rowbase+q0+wid*QBLK)*DM+hv*D;
  { bf16*stg=(bf16*)(shm+LDS_OST)+wid*2048;
    #pragma unroll
    for(int hp=0;hp<2;++hp){
      #pragma unroll
      for(int r=0;r<16;++r){const int orow=crow(r,hi);
        #pragma unroll
        for(int d0=0;d0<2;++d0)stg[orow*64+d0*32+r32]=__float2bfloat16(o[2*hp+d0][r]*rli[r]);}
      asm volatile("s_waitcnt lgkmcnt(0)":::"memory");
      #pragma unroll
      for(int i=0;i<4;++i){const int row=i*8+(lane>>3),ch=lane&7; const u32x4 v=*(const u32x4*)(stg+row*64+ch*8); ATTN_STORE16(Ow+(long)row*DM+hp*64+ch*8,v);}
      asm volatile("s_waitcnt lgkmcnt(0)":::"memory"); } }
  asm volatile("s_waitcnt lgkmcnt(0)\n\ts_barrier":::"memory");
  #undef DMA_K
  #undef DMA_V
  #undef CMASK
  #undef START
  #undef RESC
  #undef ROT
}
constexpr int ATTN_LDS_BYTES=LDS_BYTES;
#undef SBAR
#undef WAIT_BAR
}
#define GAS __attribute__((address_space(1)))
#define LAS __attribute__((address_space(3)))
typedef unsigned short bf16;
typedef unsigned v4u __attribute__((ext_vector_type(4)));
typedef float f32x4 __attribute__((ext_vector_type(4)));
typedef short bf16x8 __attribute__((ext_vector_type(8)));
typedef GAS unsigned gu32;
typedef GAS unsigned long long gu64;
#define RLX_AGENT __ATOMIC_RELAXED, __HIP_MEMORY_SCOPE_AGENT
#define LDS_WAIT() asm volatile("s_waitcnt lgkmcnt(0)" ::: "memory")
#define VM_WAIT() asm volatile("s_waitcnt vmcnt(0)" ::: "memory")
__device__ __forceinline__ unsigned long long rt() { return __builtin_amdgcn_s_memrealtime(); }
__device__ __forceinline__ unsigned f2bf(float f) { unsigned u = __builtin_bit_cast(unsigned, f); return (u + 0x7fffu + ((u >> 16) & 1u)) >> 16; }
__device__ __forceinline__ unsigned pk2(float lo, float hi) { return f2bf(lo) | (f2bf(hi) << 16); }

#define XB_TMO      128
#define XB_XCNT(j)  (256  + 64 * (j))
#define XB_XSUB(j)  (1280 + 64 * (j))
#define XB_XGEN(j)  (2304 + 64 * (j))
#define XB_TOP      3328
#define XB_TOPGEN   3392
#define XCD_BAR_WORDS 3456
#define XB_SPIN_CAP (1u << 18)

__device__ __forceinline__ unsigned xb_ld(unsigned* p)              { return __hip_atomic_load(p, __ATOMIC_RELAXED, __HIP_MEMORY_SCOPE_AGENT); }
__device__ __forceinline__ unsigned xb_add(unsigned* p, unsigned v) { return __hip_atomic_fetch_add(p, v, __ATOMIC_RELAXED, __HIP_MEMORY_SCOPE_AGENT); }
__device__ __forceinline__ unsigned xb_xcc_id() { return (unsigned)__builtin_amdgcn_s_getreg((3 << 11) | 20) & 0xFu; }
#define XB_SPIN(cond, bar) do { unsigned _sp = 0; while (cond) { __builtin_amdgcn_s_sleep(1); \
    if ((++_sp & 255u) == 0u) { if (xb_ld(&(bar)[XB_TMO])) break; if (_sp > XB_SPIN_CAP) { atomicAdd(&(bar)[XB_TMO], 1u); break; } } } } while (0)

struct XcdBarrier {
    unsigned* bar; unsigned x;
    volatile LAS unsigned* st;
};

__device__ __forceinline__ XcdBarrier xcd_barrier_post(unsigned* bar, volatile LAS unsigned* st, const int tid) {
    XcdBarrier b; b.bar = bar; b.x = xb_xcc_id(); b.st = st;
    if (tid == 0) (void)xb_add(&bar[XB_XCNT(b.x)], 1u);
    return b;
}
__device__ __forceinline__ void xcd_barrier_complete(unsigned* bar, unsigned x, unsigned& nloc, unsigned& nx) {
    const unsigned G = gridDim.x * gridDim.y * gridDim.z;
    unsigned sum, cnt, mine, sp = 0u;
    for (;;) {
        sum = 0u; cnt = 0u; mine = 0u;
#pragma unroll
        for (unsigned j = 0; j < 16; ++j) { const unsigned c = xb_ld(&bar[XB_XCNT(j)]); sum += c; cnt += (c > 0u) ? 1u : 0u; mine = (j == x) ? c : mine; }
        if (sum == G) break;
        __builtin_amdgcn_s_sleep(1);
        if ((++sp & 255u) == 0u) { if (xb_ld(&bar[XB_TMO])) break; if (sp > XB_SPIN_CAP) { atomicAdd(&bar[XB_TMO], 1u); break; } }
    }
    nloc = mine > 0u ? mine : 1u; nx = cnt > 0u ? cnt : 1u;
}

__device__ __forceinline__ void xcd_barrier(const XcdBarrier& b, const int tid) {
    asm volatile("s_waitcnt vmcnt(0)" ::: "memory");
    __syncthreads();
    if (tid == 0) {
        unsigned* bar = b.bar;
        __builtin_amdgcn_s_waitcnt(0);
        unsigned nloc = b.st[0], nx = b.st[1];
        if (nloc == 0u) { xcd_barrier_complete(bar, b.x, nloc, nx); b.st[0] = nloc; b.st[1] = nx; }
        const unsigned old = xb_add(&bar[XB_XSUB(b.x)], 1u);
        const unsigned gen = old / nloc;
        if (old + 1u == (gen + 1u) * nloc) {
            __builtin_amdgcn_fence(__ATOMIC_RELEASE, "agent");
            asm volatile("s_waitcnt vmcnt(0)" ::: "memory");
            const unsigned og = xb_add(&bar[XB_TOP], 1u);
            const unsigned tg = og / nx;
            if (og + 1u == (tg + 1u) * nx) xb_add(&bar[XB_TOPGEN], 1u);
            else XB_SPIN(xb_ld(&bar[XB_TOPGEN]) == tg, bar);
            __builtin_amdgcn_fence(__ATOMIC_ACQUIRE, "agent");
            xb_add(&bar[XB_XGEN(b.x)], 1u);
            asm volatile("s_waitcnt vmcnt(0)" ::: "memory");
        } else {
            XB_SPIN(xb_ld(&bar[XB_XGEN(b.x)]) == gen, bar);
            __builtin_amdgcn_fence(__ATOMIC_ACQUIRE, "agent");
            asm volatile("s_waitcnt vmcnt(0)" ::: "memory");
        }
    }
    __syncthreads();
}

constexpr int NWAVES = 8;
constexpr int RING_OFF = 0, RING_BYTES = 131072;
constexpr int LDSCTL_OFF = RING_BYTES, MISC_OFF = LDSCTL_OFF + 320;
constexpr int LDS_BYTES = 147456;
constexpr int CW_BAR = 4096;
typedef float f32x4 __attribute__((ext_vector_type(4)));
typedef unsigned u32x2v __attribute__((ext_vector_type(2)));
using pg8::bf16_t;

struct Args { const float* in[38]; float* out; unsigned char* ws; int ph_lo, ph_hi; };

struct Ctx {
    float* out; unsigned char* ws;
    LAS unsigned char* lds; int tid, lane, wave, vcu, G;
};


__device__ __forceinline__ float wave_sum(float v) {
#pragma unroll
    for (int o = 1; o < 64; o <<= 1) v += __shfl_xor(v, o);
    return v;
}
__device__ __forceinline__ float wave_max(float v) {
#pragma unroll
    for (int o = 1; o < 64; o <<= 1) v = fmaxf(v, __shfl_xor(v, o));
    return v;
}
__device__ __forceinline__ float bf2f(bf16_t h) { return __uint_as_float(((unsigned)h) << 16); }
__device__ __forceinline__ void load_row(const float* p, int lane, f32x4 (&v)[4]) {
    const f32x4* q = (const f32x4*)p + lane;
#pragma unroll
    for (int j = 0; j < 4; ++j) v[j] = q[64 * j];
}
__device__ __forceinline__ float row_rstd(const f32x4 (&v)[4], float eps) {
    float s = 0.f;
#pragma unroll
    for (int j = 0; j < 4; ++j) s += (v[j].x * v[j].x + v[j].y * v[j].y) + (v[j].z * v[j].z + v[j].w * v[j].w);
    return 1.0f / sqrtf(wave_sum(s) * (1.0f / D) + eps);
}
__device__ __forceinline__ void store_row_bf16(bf16_t* p, int lane, const f32x4 (&v)[4]) {
    unsigned long long* o = (unsigned long long*)p + lane;
#pragma unroll
    for (int j = 0; j < 4; ++j) o[64 * j] = (unsigned long long)pk2(v[j].x, v[j].y) | ((unsigned long long)pk2(v[j].z, v[j].w) << 32);
}

__device__ __forceinline__ void load_xrow(const float* slot, int lane, f32x4 (&v)[4]) {
    const uint2* q = (const uint2*)slot + lane; uint2 t[4];
#pragma unroll
    for (int j = 0; j < 4; ++j) t[j] = q[64 * j];
#pragma unroll
    for (int j = 0; j < 4; ++j) v[j] = (f32x4){__uint_as_float(t[j].x << 16), __uint_as_float(t[j].x & 0xffff0000u), __uint_as_float(t[j].y << 16), __uint_as_float(t[j].y & 0xffff0000u)};
}
__device__ __forceinline__ void store_xrow(float* slot, int lane, const f32x4 (&v)[4]) { store_row_bf16((bf16_t*)slot, lane, v); }

__device__ __forceinline__ void p0_transpose_item(const float* W, int K, int N, bf16_t* WT, int ldk, int row_off, int mode, LAS float* scr, int kb, int nb, int lane) {
    const int k0 = 64 * kb, n0 = 32 * nb;
    {
        float tv[32]; const int nn_ = n0 + (lane & 31), nc = nn_ < N ? nn_ : N - 1; const float nm = nn_ < N ? 1.f : 0.f;
#pragma unroll
        for (int i = 0; i < 32; ++i) { const int k = k0 + 2 * i + (lane >> 5), kc = k < K ? k : K - 1; tv[i] = W[(size_t)kc * N + nc]; }
#pragma unroll
        for (int i = 0; i < 32; ++i) { const int kk = 2 * i + (lane >> 5); scr[kk * 33 + (lane & 31)] = (k0 + kk < K) ? tv[i] * nm : 0.f; }
    }
    LDS_WAIT(); asm volatile("" ::: "memory");
    const int c = lane & 7;
#pragma unroll
    for (int j = 0; j < 4; ++j) { const int n = (lane >> 3) + 8 * j; const LAS float* s = scr + (8 * c) * 33 + n;
        v4u o; o.x = pk2(s[0 * 33], s[1 * 33]); o.y = pk2(s[2 * 33], s[3 * 33]); o.z = pk2(s[4 * 33], s[5 * 33]); o.w = pk2(s[6 * 33], s[7 * 33]);
        const int nn = n0 + n, drow = (mode == 0) ? nn : ((nn >> 2) * 8 + (nn & 3) + (mode == 2 ? 4 : 0));
        *(GAS v4u*)(WT + (size_t)(row_off + drow) * ldk + k0 + 8 * c) = o; }
    LDS_WAIT(); asm volatile("" ::: "memory");
}
__device__ __forceinline__ void p0_transpose(const Ctx& C, const float* W, int K, int N, int Kd, int Nd, bf16_t* WT, int ldk, int row_off, int mode, int gw, int NGW) {
    LAS float* scr = (LAS float*)(C.lds + RING_OFF + C.wave * 16384);
    const int nkb = Kd / 64, nnb = Nd / 32, nit = nkb * nnb;
    for (int it = gw; it < nit; it += NGW) p0_transpose_item(W, K, N, WT, ldk, row_off, mode, scr, it / nnb, it % nnb, C.lane);
}
__device__ __forceinline__ void p0_gu(const Ctx& C, const int f, int gw, int NGW) {
    unsigned char* ws = C.ws;
    p0_transpose(C, in_ptr(9) + (size_t)f * D * FF, D, FF, D, FF, (bf16_t*)(ws + W_GU) + (size_t)f * NGU * D, D, 0, 1, gw, NGW);
    p0_transpose(C, in_ptr(10) + (size_t)f * D * FF, D, FF, D, FF, (bf16_t*)(ws + W_GU) + (size_t)f * NGU * D, D, 0, 2, gw, NGW);
}
__device__ __forceinline__ void p0_weights_late(const Ctx& C, int gw, int NGW) {
    unsigned char* ws = C.ws;
    p0_transpose(C, in_ptr(11) + (size_t)2 * FF * D, FF, D, FF, D, (bf16_t*)(ws + W_D) + (size_t)2 * D * FF, FF, 0, 0, gw, NGW);
    p0_transpose(C, in_ptr(11) + (size_t)3 * FF * D, FF, D, FF, D, (bf16_t*)(ws + W_D) + (size_t)3 * D * FF, FF, 0, 0, gw, NGW);
    if (C.G == 256) p0_transpose(C, in_ptr(16), D, D, D, D, (bf16_t*)(ws + W_ORW), D, 0, 0, gw, NGW);
    p0_transpose(C, in_ptr(31), D, D, D, D, (bf16_t*)(ws + W_KV), D, 0, 0, gw, NGW);
    p0_transpose(C, in_ptr(32), D, D, D, D, (bf16_t*)(ws + W_KV), D, 1024, 0, gw, NGW);
    p0_transpose(C, in_ptr(33), D, D, D, D, (bf16_t*)(ws + W_Q), D, 0, 0, gw, NGW);
    p0_transpose(C, in_ptr(34), D, D, D, D, (bf16_t*)(ws + W_OAT), D, 0, 0, gw, NGW);
}
__device__ __forceinline__ void p0_prologue(const Ctx& C) {
    unsigned char* ws = C.ws;
    const int gw = C.vcu * NWAVES + C.wave, NGW = C.G * NWAVES;
    p0_gu(C, 0, gw, NGW);
    for (int f = 0; f < (C.G == 256 ? 1 : 2); ++f) p0_transpose(C, in_ptr(11) + (size_t)f * FF * D, FF, D, FF, D, (bf16_t*)(ws + W_D) + (size_t)f * D * FF, FF, 0, 0, gw, NGW);
    bf16_t* wrkvl = (bf16_t*)(ws + W_RKVL);
    p0_transpose(C, in_ptr(13), D, D, D, D, wrkvl, D, 0, 0, gw, NGW);
    p0_transpose(C, in_ptr(14), D, D, D, D, wrkvl, D, 1024, 0, gw, NGW);
    p0_transpose(C, in_ptr(15), D, D, D, D, wrkvl, D, 2048, 0, gw, NGW);
    p0_transpose(C, in_ptr(18), D, 64, D, 256, wrkvl, D, 3072, 0, gw, NGW);
    p0_transpose(C, in_ptr(21), D, 64, D, 256, wrkvl, D, 3328, 0, gw, NGW);
    p0_transpose(C, in_ptr(23), D, 160, D, 256, wrkvl, D, 3584, 0, gw, NGW);
    if (C.G != 256) p0_transpose(C, in_ptr(16), D, D, D, D, (bf16_t*)(ws + W_ORW), D, 0, 0, gw, NGW);
    bf16_t* wlu = (bf16_t*)(ws + W_LU);
    p0_transpose(C, in_ptr(19), 64, D, 256, D, wlu, 256, 0, 0, gw, NGW);
    p0_transpose(C, in_ptr(22), 64, D, 256, D, wlu, 256, 1024, 0, gw, NGW);
    p0_transpose(C, in_ptr(24), 160, D, 256, D, wlu, 256, 2048, 0, gw, NGW);
    {
        f32x4 gn[4]; load_row(in_ptr(7), C.lane, gn);
        bf16_t* XN = (bf16_t*)(ws + U_XN);
        for (int r = gw; r < MP; r += NGW) {
            f32x4 v[4];
            if (r < ROW_S) load_row(in_ptr(0) + (size_t)r * D, C.lane, v);
            else if (r < ROW_M) load_row(in_ptr(1) + (size_t)(r - ROW_S) * D, C.lane, v);
            else if (r < ROW_END) load_row(in_ptr(6) + (size_t)((r - ROW_M) & 15) * D, C.lane, v);
            else {
#pragma unroll
                for (int j = 0; j < 4; ++j) v[j] = (f32x4){0.f, 0.f, 0.f, 0.f}; }
            float* xr = xrow_ptr(C.out, (float*)(C.ws + WS_XEXTRA), r);
            store_xrow(xr, C.lane, v);
            const float rs = row_rstd(v, 1e-6f);
#pragma unroll
            for (int j = 0; j < 4; ++j) v[j] = v[j] * rs * gn[j];
            store_row_bf16(XN + (size_t)r * D, C.lane, v);
        }
    }
    {
        float* rope = (float*)(ws + WS_ROPE);
        const int gt = (C.vcu * NWAVES + C.wave) * 64 + C.lane, NGT = C.G * NWAVES * 64;
        for (int e = gt; e < 4112 * 8; e += NGT) {
            const int pos = e >> 3, i = e & 7;
            const float inv = exp2f(-(float)i * (18.931568569324174f / 8.0f));
            const float x = (float)pos * inv;
            const float n = rintf(x * 0.15915494309189535f);
            float r = fmaf(-n, 6.28125f, x); r = fmaf(-n, 1.9353071795864769e-3f, r);
            rope[(size_t)pos * 16 + i] = cosf(r); rope[(size_t)pos * 16 + 8 + i] = sinf(r);
        }
    }
    {
        v4u* z = (v4u*)(ws + WS_KMETA); const int gt = (C.vcu * NWAVES + C.wave) * 64 + C.lane, NGT = C.G * NWAVES * 64;
        for (int e = gt; e < (int)(2 * MiB / 16); e += NGT) z[e] = (v4u){0u, 0u, 0u, 0u};
    }
    if (blockIdx.x == 0 && C.wave == 0) {
        const float* lp = in_ptr(35);
        const float a = wave_sum(lp[C.lane] * lp[64 + C.lane]), b = wave_sum(lp[128 + C.lane] * lp[192 + C.lane]);
        if (C.lane == 0) ((float*)(ws + WS_MISC))[0] = expf(a) - expf(b) + 0.35550906759096924f;
    }
}

__device__ __forceinline__ void fold_partials(const Ctx& C, int r, f32x4 (&v)[4]) {
    const float* P = (const float*)(C.ws + WS_PART) + (size_t)(r - ROW_S) * 1024;
    f32x4 p0[4], p1[4], p2[4], p3[4];
    load_row(P, C.lane, p0); load_row(P + 192 * 1024, C.lane, p1); load_row(P + 2 * 192 * 1024, C.lane, p2); load_row(P + 3 * 192 * 1024, C.lane, p3);
#pragma unroll
    for (int j = 0; j < 4; ++j) v[j] = v[j] + 0.5f * (((p0[j] + p1[j]) + p2[j]) + p3[j]);
}
__device__ __forceinline__ void p_norm(const Ctx& C, const float* g0, bf16_t* o0, const float* g1, bf16_t* o1, const bool fold = false) {
    const int gw = C.vcu * NWAVES + C.wave, NGW = C.G * NWAVES;
    f32x4 ga[4], gb[4]; load_row(g0, C.lane, ga); if (g1) load_row(g1, C.lane, gb);
    for (int r = ROW_END + gw; r < MP; r += NGW) {
        f32x4 z[4];
#pragma unroll
        for (int j = 0; j < 4; ++j) z[j] = (f32x4){0.f, 0.f, 0.f, 0.f};
        store_row_bf16(o0 + (size_t)r * D, C.lane, z); if (g1) store_row_bf16(o1 + (size_t)r * D, C.lane, z); }
    for (int r = gw; r < ROW_END; r += NGW) {
        float* xp = xrow_ptr(C.out, (float*)(C.ws + WS_XEXTRA), r);
        f32x4 v[4]; load_xrow(xp, C.lane, v);
        if (fold && r >= ROW_S) { fold_partials(C, r, v);
            store_xrow(xp, C.lane, v); }
        const float rs = row_rstd(v, 1e-6f);
        f32x4 o[4];
#pragma unroll
        for (int j = 0; j < 4; ++j) o[j] = v[j] * rs * ga[j];
        store_row_bf16(o0 + (size_t)r * D, C.lane, o);
        if (g1) {
#pragma unroll
            for (int j = 0; j < 4; ++j) o[j] = v[j] * rs * gb[j];
            store_row_bf16(o1 + (size_t)r * D, C.lane, o);
        }
    }
}
__device__ __forceinline__ void p_final(const Ctx& C) {
    const int gw = C.vcu * NWAVES + C.wave, NGW = C.G * NWAVES;
    f32x4 ga[4]; load_row(in_ptr(37), C.lane, ga);
    for (int r = gw; r < ROW_M; r += NGW) {
        float* xr = C.out + (size_t)r * D;
        f32x4 v[4]; load_xrow(xr, C.lane, v);
        if (THIN_SPLIT_MINF <= 3 && r >= ROW_S) fold_partials(C, r, v);
        const float rs = row_rstd(v, 1e-6f);
        f32x4* xo = (f32x4*)xr + C.lane;
#pragma unroll
        for (int j = 0; j < 4; ++j) xo[64 * j] = v[j] * rs * ga[j];
    }
}

__device__ __forceinline__ void p_rwmix(const Ctx& C) {
    const int gw = C.vcu * NWAVES + C.wave, NGW = C.G * NWAVES;
    f32x4 gn[4]; load_row(in_ptr(8), C.lane, gn);
    f32x4 mu6[6][4];
#pragma unroll
    for (int g = 0; g < 6; ++g) { const int mi = (g == 0) ? 0 : (g == 1) ? 2 : (g == 2) ? 3 : (g == 3) ? 1 : g;
        load_row(in_ptr(12) + (size_t)mi * D, C.lane, mu6[g]); }
    bf16_t* A6 = (bf16_t*)(C.ws + U_A6);
    for (int r = ROW_END + gw; r < MP; r += NGW) {
        f32x4 z[4];
#pragma unroll
        for (int j = 0; j < 4; ++j) z[j] = (f32x4){0.f, 0.f, 0.f, 0.f};
#pragma unroll
        for (int g = 0; g < 6; ++g) store_row_bf16(A6 + ((size_t)g * MP + r) * D, C.lane, z); }
    for (int r = gw; r < ROW_END; r += NGW) {
        f32x4 h[4], hp[4];
        load_xrow(xrow_ptr(C.out, (float*)(C.ws + WS_XEXTRA), r), C.lane, h);
        if (THIN_SPLIT_MINF <= 0 && r >= ROW_S) fold_partials(C, r, h);
        { const float rs = row_rstd(h, 1e-6f);
#pragma unroll
          for (int j = 0; j < 4; ++j) h[j] = h[j] * rs * gn[j]; }
        int prev = -1; const float* raw = nullptr; int last = 0; size_t shoff = 0;
        if (r < ROW_S) { const int b = r >> 12, t = r & 4095; prev = t > 0 ? r - 1 : ROW_M + b * 16 + 15; if (t == 4095) { last = 1; shoff = O_SHP + (size_t)b * D; } }
        else if (r < ROW_M) { const int i = r - ROW_S, b = i >> 4, t = i & 15; if (t > 0) prev = r - 1; else raw = in_ptr(5) + (size_t)b * D; if (t == 15) { last = 1; shoff = O_SHS + (size_t)b * D; } }
        else { const int j = (r - ROW_M) & 15; if (j > 0) prev = r - 1; }
        if (prev >= 0) { load_xrow(xrow_ptr(C.out, (float*)(C.ws + WS_XEXTRA), prev), C.lane, hp); if (THIN_SPLIT_MINF <= 0 && prev >= ROW_S) fold_partials(C, prev, hp); const float rs = row_rstd(hp, 1e-6f);
#pragma unroll
            for (int j = 0; j < 4; ++j) hp[j] = hp[j] * rs * gn[j]; }
        else if (raw) load_row(raw, C.lane, hp);
        else {
#pragma unroll
            for (int j = 0; j < 4; ++j) hp[j] = (f32x4){0.f, 0.f, 0.f, 0.f}; }
        if (last) { f32x4* so = (f32x4*)(C.out + shoff) + C.lane;
#pragma unroll
            for (int j = 0; j < 4; ++j) so[64 * j] = h[j]; }
#pragma unroll
        for (int g = 0; g < 6; ++g) {
            f32x4 o[4];
#pragma unroll
            for (int j = 0; j < 4; ++j) o[j] = h[j] + (hp[j] - h[j]) * mu6[g][j];
            store_row_bf16(A6 + ((size_t)g * MP + r) * D, C.lane, o);
        }
    }
}


constexpr int NCH_PROMPT = 4 * 257 * 16, NCH_ALL = NCH_PROMPT + 128;
constexpr int SCAN_C1 = 143;
typedef short bf16x8s __attribute__((ext_vector_type(8)));
typedef short s16x4s __attribute__((ext_vector_type(4)));
typedef float f32x4s __attribute__((ext_vector_type(4)));

__device__ __forceinline__ void chunk_decode(int ch, int& row0, int& h) {
    if (ch < NCH_PROMPT) { const int b = ch / (257 * 16), rem = ch - b * (257 * 16), c = rem >> 4; h = rem & 15; row0 = (c == 0) ? ROW_M + b * 16 : b * 4096 + (c - 1) * 16; }
    else { const int i = ch - NCH_PROMPT; h = i & 15; row0 = ROW_S + (i >> 4) * 16; }
}
__device__ __forceinline__ float dpp_add(float x, const int ctrl_sel) {
    const int xi = __float_as_int(x); int t;
    switch (ctrl_sel) {
    case 0: t = __builtin_amdgcn_update_dpp(0, xi, 0xB1, 0xF, 0xF, false); break;
    case 1: t = __builtin_amdgcn_update_dpp(0, xi, 0x4E, 0xF, 0xF, false); break;
    case 2: t = __builtin_amdgcn_update_dpp(0, xi, 0x141, 0xF, 0xF, false); break;
    case 3: t = __builtin_amdgcn_update_dpp(0, xi, 0x140, 0xF, 0xF, false); break;
    case 4: t = __builtin_amdgcn_update_dpp(0, xi, 0x142, 0xA, 0xF, false); break;
    default: t = __builtin_amdgcn_update_dpp(0, xi, 0x143, 0xC, 0xF, false); break;
    }
    return x + __int_as_float(t);
}
__device__ __forceinline__ void reduce16(float (&x)[16]) {
#pragma unroll
    for (int st = 0; st < 6; ++st) {
#pragma unroll
        for (int t = 0; t < 16; ++t) x[t] = dpp_add(x[t], st);
    }
#pragma unroll
    for (int t = 0; t < 16; ++t) x[t] = __int_as_float(__builtin_amdgcn_readlane(__float_as_int(x[t]), 63));
}
__device__ __forceinline__ unsigned short f2bf_s(float f) { return (unsigned short)(pg8::cvt_pk_bf16(f, 0.f) & 0xffffu); }

__device__ __forceinline__ void p_scan_pre(const Ctx& C, const int half) {
    const int lane = C.lane, fr = lane & 15, fq = lane >> 4;
    LAS unsigned char* wl = C.lds + RING_OFF + C.wave * 12288;
    LAS unsigned short* TA = (LAS unsigned short*)wl; LAS unsigned short* TB = TA + 1152; LAS unsigned short* TK = TB + 1152; LAS unsigned short* TR = TK + 1152;
    LAS float* LAB = (LAS float*)(wl + 9216); LAS float* LAK = LAB + 256;
    bf16_t* Rb = (bf16_t*)(C.out + O_CKP); bf16_t* Kb = Rb + (size_t)MP * D; const bf16_t* Vb = Kb + (size_t)MP * D;
    const bf16_t* LW = (const bf16_t*)(C.ws + U_LOGW); const bf16_t* AS = (const bf16_t*)(C.ws + U_ASIG);
    bf16_t* BK = (bf16_t*)(C.ws + U_BK); bf16_t* VT = (bf16_t*)(C.ws + U_VT); bf16_t* SM = (bf16_t*)(C.ws + U_SM);
    float* GAM = (float*)(C.out + O_GAM); float* BON = (float*)(C.out + O_BON);
    const int gw = half ? ((int)blockIdx.x - 64) * NWAVES + C.wave : C.vcu * NWAVES + C.wave, NGW = half ? (C.G - 64) * NWAVES : C.G * NWAVES;
    const int ntask = half ? 4 * (257 - SCAN_C1) * 16 : 4 * SCAN_C1 * 16 + 128;
    const int pos = ((lane >> 2) & 3) * 16 + (lane >> 5) * 8 + ((lane >> 4) & 1) * 4 + (lane & 3);
    for (int task = gw; task < ntask; task += NGW) {
        int ch;
        if (half) { const int b_ = task / ((257 - SCAN_C1) * 16), rem_ = task - b_ * ((257 - SCAN_C1) * 16); ch = (b_ * 257 + SCAN_C1 + (rem_ >> 4)) * 16 + (rem_ & 15); }
        else if (task < 4 * SCAN_C1 * 16) { const int b_ = task / (SCAN_C1 * 16), rem_ = task - b_ * (SCAN_C1 * 16); ch = (b_ * 257 + (rem_ >> 4)) * 16 + (rem_ & 15); }
        else ch = NCH_PROMPT + (task - 4 * SCAN_C1 * 16);
        int row0, h; chunk_decode(ch, row0, h);
        const int col = h * 64 + lane;
        const float kk_c = in_ptr(25)[col], ka_c = in_ptr(26)[col], rk_c = in_ptr(27)[col];
        float rt[16], at[16], bt[16], kt[16]; unsigned short vraw[16];
        float nrm[16], bon[16];
        {
            float kr[16], as_[16];
            {
                LAS unsigned char* stg = wl;
                const int r8 = lane >> 3, sg8 = lane & 7, r4 = lane >> 4, sg16 = lane & 15;
                const size_t gb = ((size_t)(row0 + r8) * D + h * 64 + sg8 * 8), gb8 = gb + (size_t)8 * D;
                const v4u x0 = *(const v4u*)(Rb + gb), x1 = *(const v4u*)(Rb + gb8), x2 = *(const v4u*)(Kb + gb), x3 = *(const v4u*)(Kb + gb8);
                const v4u x4 = *(const v4u*)(Vb + gb), x5 = *(const v4u*)(Vb + gb8), x6 = *(const v4u*)(AS + gb), x7 = *(const v4u*)(AS + gb8);
                const v4u x8 = *(const v4u*)(LW + gb), x9 = *(const v4u*)(LW + gb8);
                const int lo = r8 * 128 + sg8 * 16;
                *(LAS v4u*)(stg + lo) = x0; *(LAS v4u*)(stg + lo + 1024) = x1; *(LAS v4u*)(stg + 2048 + lo) = x2; *(LAS v4u*)(stg + 2048 + lo + 1024) = x3;
                *(LAS v4u*)(stg + 4096 + lo) = x4; *(LAS v4u*)(stg + 4096 + lo + 1024) = x5; *(LAS v4u*)(stg + 6144 + lo) = x6; *(LAS v4u*)(stg + 6144 + lo + 1024) = x7;
                *(LAS v4u*)(stg + 8192 + lo) = x8; *(LAS v4u*)(stg + 8192 + lo + 1024) = x9;
                LDS_WAIT(); asm volatile("" ::: "memory");
                const LAS unsigned short* s16 = (const LAS unsigned short*)stg + lane;
#pragma unroll
                for (int t = 0; t < 16; ++t) { rt[t] = bf2f(s16[t * 64]); kr[t] = bf2f(s16[1024 + t * 64]); vraw[t] = s16[2048 + t * 64]; as_[t] = bf2f(s16[3072 + t * 64]); at[t] = bf2f(s16[4096 + t * 64]); }
                LDS_WAIT(); asm volatile("" ::: "memory");
            }
#pragma unroll
            for (int t = 0; t < 16; ++t) { const float kkv = kr[t] * kk_c; nrm[t] = kkv * kkv; bt[t] = kkv;
                kt[t] = kr[t] * (1.0f + (as_[t] - 1.0f) * ka_c); bon[t] = rt[t] * kt[t] * rk_c; }
            reduce16(nrm); reduce16(bon);
            float L = 0.f, gprev = 1.0f;
#pragma unroll
            for (int t = 0; t < 16; ++t) {
                const float kkn = bt[t] * ((nrm[t] > 1e-24f) ? __builtin_amdgcn_rsqf(nrm[t]) : 1e12f), lw = at[t];
                const float gp = gprev; L += lw; const float gt = __expf(L), gi = __builtin_amdgcn_rcpf(gt); gprev = gt;
                at[t] = -kkn * gp; bt[t] = kkn * as_[t] * gi; kt[t] = kt[t] * gi; rt[t] = rt[t] * gt;
            }
            const float gC = gprev;
            GAM[(size_t)ch * 64 + lane] = gC;
            { float bsel = bon[0];
#pragma unroll
              for (int t = 1; t < 16; ++t) bsel = (lane == t) ? bon[t] : bsel;
              if (lane < 16) BON[(size_t)(row0 + lane) * 16 + h] = bsel; }
#pragma unroll
            for (int t = 0; t < 16; ++t) { TA[t * 72 + lane] = f2bf_s(at[t]); TB[t * 72 + lane] = f2bf_s(bt[t]); TK[t * 72 + lane] = f2bf_s(kt[t]); TR[t * 72 + lane] = f2bf_s(rt[t]); }
            bf16_t* bkp = BK + (size_t)ch * 2048 + lane * 32;
#pragma unroll
            for (int q = 0; q < 4; ++q) { v4u o; o.x = pg8::cvt_pk_bf16(bt[4 * q] * gC, bt[4 * q + 1] * gC); o.y = pg8::cvt_pk_bf16(bt[4 * q + 2] * gC, bt[4 * q + 3] * gC);
                o.z = pg8::cvt_pk_bf16(kt[4 * q] * gC, kt[4 * q + 1] * gC); o.w = pg8::cvt_pk_bf16(kt[4 * q + 2] * gC, kt[4 * q + 3] * gC); *(v4u*)(bkp + q * 8) = o; }
            bf16_t* vtp = VT + (size_t)ch * 1024 + lane * 16;
#pragma unroll
            for (int q = 0; q < 2; ++q) { v4u o; o.x = (unsigned)vraw[8 * q] | ((unsigned)vraw[8 * q + 1] << 16); o.y = (unsigned)vraw[8 * q + 2] | ((unsigned)vraw[8 * q + 3] << 16);
                o.z = (unsigned)vraw[8 * q + 4] | ((unsigned)vraw[8 * q + 5] << 16); o.w = (unsigned)vraw[8 * q + 6] | ((unsigned)vraw[8 * q + 7] << 16); *(v4u*)(vtp + q * 8) = o; }
#pragma unroll
            for (int t = 0; t < 16; ++t) Rb[(size_t)(row0 + t) * D + h * 64 + pos] = f2bf_s(rt[t]);
        }
        LDS_WAIT(); asm volatile("" ::: "memory");
        f32x4s Aab = {0.f, 0.f, 0.f, 0.f}, Aak = Aab, Arb = Aab, Ark = Aab;
#pragma unroll
        for (int mf = 0; mf < 2; ++mf) {
            const bf16x8s fa = *(const LAS bf16x8s*)(TA + fr * 72 + fq * 8 + mf * 32), fb = *(const LAS bf16x8s*)(TB + fr * 72 + fq * 8 + mf * 32);
            const bf16x8s fk = *(const LAS bf16x8s*)(TK + fr * 72 + fq * 8 + mf * 32), frr = *(const LAS bf16x8s*)(TR + fr * 72 + fq * 8 + mf * 32);
            Aab = __builtin_amdgcn_mfma_f32_16x16x32_bf16(fa, fb, Aab, 0, 0, 0); Aak = __builtin_amdgcn_mfma_f32_16x16x32_bf16(fa, fk, Aak, 0, 0, 0);
            Arb = __builtin_amdgcn_mfma_f32_16x16x32_bf16(frr, fb, Arb, 0, 0, 0); Ark = __builtin_amdgcn_mfma_f32_16x16x32_bf16(frr, fk, Ark, 0, 0, 0);
        }
        bf16_t* smp = SM + (size_t)ch * 1024;
#pragma unroll
        for (int e = 0; e < 4; ++e) { const int t = 4 * fq + e, s = fr;
            const float ab = (s < t) ? Aab[e] : 0.f, ak = (s < t) ? Aak[e] : 0.f, rb = (s <= t) ? Arb[e] : 0.f, rk2 = (s <= t) ? Ark[e] : 0.f;
            LAB[t * 16 + s] = ab; LAK[t * 16 + s] = ak;
            smp[512 + t * 32 + (s >> 2) * 8 + (s & 3)] = f2bf_s(rb); smp[512 + t * 32 + (s >> 2) * 8 + 4 + (s & 3)] = f2bf_s(rk2); }
        LDS_WAIT(); asm volatile("" ::: "memory");
        float xm[16];
#pragma unroll
        for (int t = 0; t < 16; ++t) {
            float accw = at[t], accm = LAK[t * 16 + fr];
#pragma unroll
            for (int s4 = 0; s4 < (t + 3) / 4; ++s4) { const f32x4s q = *(const LAS f32x4s*)(LAB + t * 16 + 4 * s4);
#pragma unroll
                for (int e = 0; e < 4; ++e) if (4 * s4 + e < t) { accw += q[e] * at[4 * s4 + e]; accm += q[e] * xm[4 * s4 + e]; } }
            at[t] = accw; xm[t] = accm;
        }
#pragma unroll
        for (int t = 0; t < 16; ++t) Kb[(size_t)(row0 + t) * D + h * 64 + pos] = f2bf_s(at[t]);
        if (lane < 16) {
#pragma unroll
            for (int t = 0; t < 16; ++t) { smp[t * 32 + (lane >> 2) * 8 + 4 + (lane & 3)] = f2bf_s(xm[t]); smp[t * 32 + (lane >> 2) * 8 + (lane & 3)] = 0; } }
        LDS_WAIT(); asm volatile("" ::: "memory");
    }
}

constexpr int SQ_BK = 0, SQ_VT = 5120, SQ_M2 = 7168, SQ_AR = 8448, SQ_WP = 9728, SQ_RP = 12032, SQ_GM = 14336, SQ_SLOT = 14592;
__device__ __forceinline__ void p_scan_seq(const Ctx& C, const int part) {
    const int g = (int)blockIdx.x, w = C.wave, lane = C.lane, fr = lane & 15, fq = lane >> 4, tid = C.tid;
    if (part == 0 && g >= 192) return;
    if (part == 1 && g >= 64) { p0_weights_late(C, (g - 64) * NWAVES + w, (C.G - 64) * NWAVES); return; }
    const int prompt = g < 64, b = prompt ? (g >> 4) : ((g - 64) >> 4), h = g & 15, bh = b * 16 + h;
    const unsigned char* Rb = (const unsigned char*)(C.out + O_CKP); const unsigned char* Kb = Rb + (size_t)MP * D * 2;
    const unsigned char* BK = (const unsigned char*)(C.ws + U_BK); const unsigned char* VT = (const unsigned char*)(C.ws + U_VT); const unsigned char* SM = (const unsigned char*)(C.ws + U_SM);
    const unsigned char* GAM = (const unsigned char*)(C.out + O_GAM); float* Y = (float*)(C.ws + U_Y);
    LAS unsigned char* slots = C.lds + RING_OFF;
    const int coff = (prompt && part) ? SCAN_C1 : 0;
    const int nch = prompt ? (part ? 257 - SCAN_C1 : SCAN_C1) : 1;
    const int lt = tid - 256; const bool loader = tid >= 256;
    const int ldsP0 = SQ_BK + (lt >> 2) * 80 + (lt & 3) * 16;
    const unsigned char* srcP1 = (lt < 128) ? VT + (size_t)lt * 16 : SM + (size_t)(lt - 128) * 16;
    const int q1 = (lt - 128) & 63, ldsP1 = (lt < 128) ? SQ_VT + lt * 16 : ((lt < 192 ? SQ_M2 : SQ_AR) + (q1 >> 2) * 80 + (q1 & 3) * 16);
    const unsigned char* srcP2 = (lt < 128) ? Kb : Rb; const int row2 = (lt & 127) >> 3, seg2 = lt & 7, ldsP2 = (lt < 128 ? SQ_WP : SQ_RP) + row2 * 144 + seg2 * 16;
    const int ldsP3 = SQ_GM + (lt & 15) * 16; const bool has3 = loader && lt < 16;
    v4u buf0[12], buf1[12], buf2[12], buf3[12];
#define SQ_CH(c) (prompt ? (b * 257 + coff + (c)) * 16 + h : NCH_PROMPT + bh)
#define SQ_ROW0(c) (prompt ? ((coff + (c)) == 0 ? ROW_M + b * 16 : b * 4096 + (coff + (c) - 1) * 16) : ROW_S + b * 16)
#define SQ_ISSUE(j, c_) do { { const int cq_ = ((c_) < nch) ? (c_) : nch - 1; const int ch_ = SQ_CH(cq_); buf0[j] = *(const v4u*)(BK + (size_t)ch_ * 4096 + (size_t)lt * 16); buf1[j] = *(const v4u*)(srcP1 + (size_t)ch_ * 2048); \
        buf2[j] = *(const v4u*)(srcP2 + ((size_t)(SQ_ROW0(cq_) + row2) * D + h * 64) * 2 + seg2 * 16); buf3[j] = *(const v4u*)(GAM + (size_t)ch_ * 256 + (lt & 15) * 16); } } while (0)
#define SQ_PUT(j, c) do { if (loader) { LAS unsigned char* sl_ = slots + ((c) & 1) * SQ_SLOT; *(LAS v4u*)(sl_ + ldsP0) = buf0[j]; *(LAS v4u*)(sl_ + ldsP1) = buf1[j]; *(LAS v4u*)(sl_ + ldsP2) = buf2[j]; \
        if (has3) *(LAS v4u*)(sl_ + ldsP3) = buf3[j]; } } while (0)
    f32x4s ST[2][4];
    if (w < 2) {
#pragma unroll
        for (int u = 0; u < 2; ++u) {
            if (prompt && part == 0) {
#pragma unroll
                for (int kt = 0; kt < 4; ++kt) ST[u][kt] = (f32x4s){0.f, 0.f, 0.f, 0.f};
            } else {
                const float* s0 = (prompt ? (const float*)(C.out + O_WKVP) : in_ptr(4)) + ((size_t)bh * 64 + 32 * w + 16 * u + fr) * 64;
#pragma unroll
                for (int kt = 0; kt < 4; ++kt) ST[u][kt] = *(const f32x4s*)(s0 + 16 * kt + 4 * fq);
            }
        }
    }
    struct Frg { bf16x8s wp0, wp1, rp0, rp1, m2, ar, bk0, bk1, bk2, bk3; s16x4s vt0, vt1; f32x4s g0, g1, g2, g3; };
#define SQ_FRAGS(F, c) do { const LAS unsigned char* sl_ = slots + ((c) % 3) * SQ_SLOT; \
        F.wp0 = *(const LAS bf16x8s*)(sl_ + SQ_WP + fr * 144 + fq * 32); F.wp1 = *(const LAS bf16x8s*)(sl_ + SQ_WP + fr * 144 + fq * 32 + 16); \
        F.rp0 = *(const LAS bf16x8s*)(sl_ + SQ_RP + fr * 144 + fq * 32); F.rp1 = *(const LAS bf16x8s*)(sl_ + SQ_RP + fr * 144 + fq * 32 + 16); \
        F.m2 = *(const LAS bf16x8s*)(sl_ + SQ_M2 + fr * 80 + fq * 16); F.ar = *(const LAS bf16x8s*)(sl_ + SQ_AR + fr * 80 + fq * 16); \
        F.bk0 = *(const LAS bf16x8s*)(sl_ + SQ_BK + fr * 80 + fq * 16); F.bk1 = *(const LAS bf16x8s*)(sl_ + SQ_BK + (16 + fr) * 80 + fq * 16); \
        F.bk2 = *(const LAS bf16x8s*)(sl_ + SQ_BK + (32 + fr) * 80 + fq * 16); F.bk3 = *(const LAS bf16x8s*)(sl_ + SQ_BK + (48 + fr) * 80 + fq * 16); \
        F.vt0 = *(const LAS s16x4s*)(sl_ + SQ_VT + (32 * w + fr) * 32 + fq * 8); F.vt1 = *(const LAS s16x4s*)(sl_ + SQ_VT + (32 * w + 16 + fr) * 32 + fq * 8); \
        F.g0 = *(const LAS f32x4s*)(sl_ + SQ_GM + fq * 16); F.g1 = *(const LAS f32x4s*)(sl_ + SQ_GM + 64 + fq * 16); F.g2 = *(const LAS f32x4s*)(sl_ + SQ_GM + 128 + fq * 16); F.g3 = *(const LAS f32x4s*)(sl_ + SQ_GM + 192 + fq * 16); } while (0)
#define SQ_PACK(a, bq) (bf16x8s){(short)(pg8::cvt_pk_bf16(a[0], a[1]) & 0xffff), (short)(pg8::cvt_pk_bf16(a[0], a[1]) >> 16), (short)(pg8::cvt_pk_bf16(a[2], a[3]) & 0xffff), (short)(pg8::cvt_pk_bf16(a[2], a[3]) >> 16), \
                                 (short)(pg8::cvt_pk_bf16(bq[0], bq[1]) & 0xffff), (short)(pg8::cvt_pk_bf16(bq[0], bq[1]) >> 16), (short)(pg8::cvt_pk_bf16(bq[2], bq[3]) & 0xffff), (short)(pg8::cvt_pk_bf16(bq[2], bq[3]) >> 16)}
#define SQ_TILE(F, c, u, VT_) do { \
        const bf16x8s sb0 = SQ_PACK(ST[u][0], ST[u][1]), sb1 = SQ_PACK(ST[u][2], ST[u][3]); \
        const bf16x8s vb = (bf16x8s){0, 0, 0, 0, VT_[0], VT_[1], VT_[2], VT_[3]}; \
        f32x4s U = __builtin_amdgcn_mfma_f32_16x16x32_bf16(F.wp0, sb0, (f32x4s){0.f, 0.f, 0.f, 0.f}, 0, 0, 0); \
        U = __builtin_amdgcn_mfma_f32_16x16x32_bf16(F.wp1, sb1, U, 0, 0, 0); U = __builtin_amdgcn_mfma_f32_16x16x32_bf16(F.m2, vb, U, 0, 0, 0); \
        f32x4s Yv = __builtin_amdgcn_mfma_f32_16x16x32_bf16(F.rp0, sb0, (f32x4s){0.f, 0.f, 0.f, 0.f}, 0, 0, 0); Yv = __builtin_amdgcn_mfma_f32_16x16x32_bf16(F.rp1, sb1, Yv, 0, 0, 0); \
        const unsigned u01 = pg8::cvt_pk_bf16(U[0], U[1]), u23 = pg8::cvt_pk_bf16(U[2], U[3]); \
        const bf16x8s ub = (bf16x8s){(short)(u01 & 0xffff), (short)(u01 >> 16), (short)(u23 & 0xffff), (short)(u23 >> 16), VT_[0], VT_[1], VT_[2], VT_[3]}; \
        Yv = __builtin_amdgcn_mfma_f32_16x16x32_bf16(F.ar, ub, Yv, 0, 0, 0); \
        ST[u][0] = __builtin_amdgcn_mfma_f32_16x16x32_bf16(F.bk0, ub, ST[u][0] * F.g0, 0, 0, 0); ST[u][1] = __builtin_amdgcn_mfma_f32_16x16x32_bf16(F.bk1, ub, ST[u][1] * F.g1, 0, 0, 0); \
        ST[u][2] = __builtin_amdgcn_mfma_f32_16x16x32_bf16(F.bk2, ub, ST[u][2] * F.g2, 0, 0, 0); ST[u][3] = __builtin_amdgcn_mfma_f32_16x16x32_bf16(F.bk3, ub, ST[u][3] * F.g3, 0, 0, 0); \
        LAS float* yl_ = (LAS float*)(slots + 3 * SQ_SLOT + ((c) & 1) * 4096) + (4 * fq) * 64 + 32 * w + 16 * (u) + fr;        \
        yl_[0] = Yv[0]; yl_[64] = Yv[1]; yl_[128] = Yv[2]; yl_[192] = Yv[3]; } while (0)
#define SQ_MF(a, b, c_) __builtin_amdgcn_mfma_f32_16x16x32_bf16(a, b, c_, 0, 0, 0)
#define SQ_STEP(F, c) do { \
        const bf16x8s sa0 = SQ_PACK(ST[0][0], ST[0][1]), sa1 = SQ_PACK(ST[0][2], ST[0][3]), sc0 = SQ_PACK(ST[1][0], ST[1][1]), sc1 = SQ_PACK(ST[1][2], ST[1][3]); \
        const bf16x8s va = (bf16x8s){0, 0, 0, 0, F.vt0[0], F.vt0[1], F.vt0[2], F.vt0[3]}, vc = (bf16x8s){0, 0, 0, 0, F.vt1[0], F.vt1[1], F.vt1[2], F.vt1[3]}; \
        const f32x4s z4_ = (f32x4s){0.f, 0.f, 0.f, 0.f}; \
        f32x4s Ua = SQ_MF(F.wp0, sa0, z4_), Uc = SQ_MF(F.wp0, sc0, z4_); \
        Ua = SQ_MF(F.wp1, sa1, Ua); Uc = SQ_MF(F.wp1, sc1, Uc); \
        f32x4s Ya = SQ_MF(F.rp0, sa0, z4_), Yc = SQ_MF(F.rp0, sc0, z4_); \
        Ua = SQ_MF(F.m2, va, Ua); Uc = SQ_MF(F.m2, vc, Uc); \
        Ya = SQ_MF(F.rp1, sa1, Ya); Yc = SQ_MF(F.rp1, sc1, Yc); \
        const unsigned ua01 = pg8::cvt_pk_bf16(Ua[0], Ua[1]), ua23 = pg8::cvt_pk_bf16(Ua[2], Ua[3]); \
        const bf16x8s uba = (bf16x8s){(short)(ua01 & 0xffff), (short)(ua01 >> 16), (short)(ua23 & 0xffff), (short)(ua23 >> 16), F.vt0[0], F.vt0[1], F.vt0[2], F.vt0[3]}; \
        const unsigned uc01 = pg8::cvt_pk_bf16(Uc[0], Uc[1]), uc23 = pg8::cvt_pk_bf16(Uc[2], Uc[3]); \
        const bf16x8s ubc = (bf16x8s){(short)(uc01 & 0xffff), (short)(uc01 >> 16), (short)(uc23 & 0xffff), (short)(uc23 >> 16), F.vt1[0], F.vt1[1], F.vt1[2], F.vt1[3]}; \
        ST[0][0] = SQ_MF(F.bk0, uba, ST[0][0] * F.g0); ST[1][0] = SQ_MF(F.bk0, ubc, ST[1][0] * F.g0); \
        ST[0][1] = SQ_MF(F.bk1, uba, ST[0][1] * F.g1); ST[1][1] = SQ_MF(F.bk1, ubc, ST[1][1] * F.g1); \
        ST[0][2] = SQ_MF(F.bk2, uba, ST[0][2] * F.g2); ST[1][2] = SQ_MF(F.bk2, ubc, ST[1][2] * F.g2); \
        ST[0][3] = SQ_MF(F.bk3, uba, ST[0][3] * F.g3); ST[1][3] = SQ_MF(F.bk3, ubc, ST[1][3] * F.g3); \
        Ya = SQ_MF(F.ar, uba, Ya); Yc = SQ_MF(F.ar, ubc, Yc); \
        LAS float* yl_ = (LAS float*)(slots + 3 * SQ_SLOT + ((c) & 1) * 4096) + (4 * fq) * 64 + 32 * w + fr;        \
        yl_[0] = Ya[0]; yl_[64] = Ya[1]; yl_[128] = Ya[2]; yl_[192] = Ya[3]; yl_[16] = Yc[0]; yl_[80] = Yc[1]; yl_[144] = Yc[2]; yl_[208] = Yc[3]; } while (0)
#undef SQ_PUT
#define SQ_PUT(j, c) do { LAS unsigned char* sl_ = slots + ((c) % 3) * SQ_SLOT; *(LAS v4u*)(sl_ + ldsP0) = buf0[j]; *(LAS v4u*)(sl_ + ldsP1) = buf1[j]; *(LAS v4u*)(sl_ + ldsP2) = buf2[j]; \
        if (has3) *(LAS v4u*)(sl_ + ldsP3) = buf3[j]; } while (0)
#define SQ_BAR() do { asm volatile("" ::: "memory"); __builtin_amdgcn_s_waitcnt(0xc07f); __builtin_amdgcn_s_barrier(); asm volatile("" ::: "memory"); } while (0)
    constexpr int RD = 12;
    const int nch8 = ((nch + 24) / 24) * 24;
    static_assert(24 % RD == 0, "loop barrier count");
    SQ_BAR();
    if (loader) {
#pragma unroll
        for (int j = 0; j < RD; ++j) SQ_ISSUE(j, j);
        SQ_PUT(0, 0); SQ_ISSUE(0, RD);
        SQ_PUT(1, 1); SQ_ISSUE(1, RD + 1);
        SQ_BAR();
        unsigned long long pacc0 = 0, pacc1 = 0, pacc2 = 0;
        for (int c0 = 0; c0 < nch8; c0 += RD) {
#pragma unroll
            for (int i = 0; i < RD; ++i) { const int c = c0 + i;
#ifdef PROBE_ACC
                const unsigned long long ta_ = __builtin_amdgcn_s_memtime();
                SQ_PUT((i + 2) % RD, c + 2);
                asm volatile("s_waitcnt lgkmcnt(0)" ::: "memory");
                const unsigned long long tb_ = __builtin_amdgcn_s_memtime();
                SQ_ISSUE((i + 2) % RD, c + 2 + RD);
                const unsigned long long tc_ = __builtin_amdgcn_s_memtime();
                SQ_BAR();
                const unsigned long long td_ = __builtin_amdgcn_s_memtime();
                pacc0 += tb_ - ta_; pacc1 += tc_ - tb_; pacc2 += td_ - tc_; }
#else
                SQ_PUT((i + 2) % RD, c + 2); SQ_ISSUE((i + 2) % RD, c + 2 + RD);
                SQ_BAR(); }
#endif
        }
#ifdef PROBE_ACC
        if (g == 0 && tid == 256) { volatile unsigned long long* pa_ = (volatile unsigned long long*)(C.ws + WS_MISC + 2048); pa_[0] = pacc0; pa_[1] = pacc1; pa_[2] = pacc2; }
#endif
    } else if (w < 2) {
        SQ_BAR();
        Frg FA, FB;
        SQ_FRAGS(FA, 0);
#ifdef PROBE_ACC
        unsigned long long qacc = 0, qstep = 0, qwait = 0, qfr = 0; const unsigned long long qt0 = __builtin_amdgcn_s_memtime();
#define SQ_TS() __builtin_amdgcn_s_memtime()
        for (int c = 0; c < nch8; c += 2) {
            const unsigned long long t0_ = SQ_TS();
            if (c + 1 < nch) SQ_FRAGS(FB, c + 1);
            asm volatile("" ::: "memory"); const unsigned long long t1_ = SQ_TS();
            if (c < nch) SQ_STEP(FA, c);
            asm volatile("" ::: "memory"); const unsigned long long t2_ = SQ_TS();
            __builtin_amdgcn_s_waitcnt(0xc07f);
            const unsigned long long t3_ = SQ_TS();
            __builtin_amdgcn_s_barrier(); asm volatile("" ::: "memory");
            const unsigned long long t4_ = SQ_TS();
            if (c + 2 < nch) SQ_FRAGS(FA, c + 2);
            if (c + 1 < nch) SQ_STEP(FB, c + 1);
            SQ_BAR();
            qfr += t1_ - t0_; qstep += t2_ - t1_; qwait += t3_ - t2_; qacc += t4_ - t3_;
        }
#else
        for (int c = 0; c < nch8; c += 2) {
            if (c + 1 < nch) SQ_FRAGS(FB, c + 1);
            if (c < nch) SQ_STEP(FA, c);
            SQ_BAR();
            if (c + 2 < nch) SQ_FRAGS(FA, c + 2);
            if (c + 1 < nch) SQ_STEP(FB, c + 1);
            SQ_BAR();
        }
#endif
#ifdef PROBE_ACC
        if (g == 0 && tid == 0) { volatile unsigned long long* pa_ = (volatile unsigned long long*)(C.ws + WS_MISC + 2048); pa_[3] = qacc; pa_[4] = __builtin_amdgcn_s_memtime() - qt0; pa_[5] = qfr; pa_[6] = qstep; pa_[7] = qwait; }
#endif
    } else {
        SQ_BAR();
        f32x4s ya[4][4];
        for (int c0 = 0; c0 < nch8; c0 += 8) {
#pragma unroll
            for (int i = 0; i < 8; ++i) { const int c = c0 + i, cp = c - 1;
                if (((i + 1) & 1) == (w & 1) || true) {
                    if (cp >= 0 && cp < nch && (cp & 1) == (w & 1)) {
                        const LAS f32x4s* yl = (const LAS f32x4s*)(slots + 3 * SQ_SLOT + (cp & 1) * 4096) + (lane >> 4) * 16 + (lane & 15);
#pragma unroll
                        for (int q = 0; q < 4; ++q) ya[i >> 1][q] = yl[q * 64];
                        unsigned short* yg = (unsigned short*)Y + (size_t)(SQ_ROW0(cp) + (lane >> 4)) * D + h * 64 + 4 * (lane & 15);
#pragma unroll
                        for (int q = 0; q < 4; ++q) { uint2 o_; o_.x = pg8::cvt_pk_bf16(ya[i >> 1][q][0], ya[i >> 1][q][1]); o_.y = pg8::cvt_pk_bf16(ya[i >> 1][q][2], ya[i >> 1][q][3]); *(uint2*)(yg + (size_t)q * 4 * D) = o_; }
                    }
                }
                SQ_BAR(); }
        }
    }
#undef SQ_CH
#undef SQ_ROW0
#undef SQ_ISSUE
#undef SQ_PUT
#undef SQ_FRAGS
#undef SQ_PACK
#undef SQ_TILE
#undef SQ_STEP
    if (w < 2) {
#pragma unroll
        for (int u = 0; u < 2; ++u) {
            float* so = C.out + (prompt ? O_WKVP : O_WKVS) + ((size_t)bh * 64 + 32 * w + 16 * u + fr) * 64;
#pragma unroll
            for (int kt = 0; kt < 4; ++kt) *(f32x4s*)(so + 16 * kt + 4 * fq) = ST[u][kt];
        }
    }
}

__device__ __forceinline__ void p_scan_post(const Ctx& C, const int sel, const int gw, const int NGW) {
    const int lane = C.lane;
    const float* Y = (const float*)(C.ws + U_Y); const bf16_t* Vb = (const bf16_t*)(C.out + O_CKP) + (size_t)2 * MP * D; const bf16_t* GG = (const bf16_t*)(C.ws + U_G);
    const float* BON = (const float*)(C.out + O_BON); bf16_t* YG = (bf16_t*)(C.ws + U_YG);
    f32x4 gg[4], gb[4]; load_row(in_ptr(28), lane, gg); load_row(in_ptr(29), lane, gb);
    for (int r = gw; r < MP; r += NGW) {
        if (sel) { const bool inA = (r < ROW_S) ? ((r & 4095) < (SCAN_C1 - 1) * 16) : (r < ROW_END); if (inA != (sel == 1)) continue; }
        f32x4 o[4];
        if (r >= ROW_END) {
#pragma unroll
            for (int j = 0; j < 4; ++j) o[j] = (f32x4){0.f, 0.f, 0.f, 0.f};
        } else {
            f32x4 y[4];
            { const uint2* yq = (const uint2*)((const unsigned short*)Y + (size_t)r * D) + lane; uint2 yr[4];
#pragma unroll
              for (int j = 0; j < 4; ++j) yr[j] = yq[64 * j];
#pragma unroll
              for (int j = 0; j < 4; ++j) y[j] = (f32x4){__uint_as_float(yr[j].x << 16), __uint_as_float(yr[j].x & 0xffff0000u), __uint_as_float(yr[j].y << 16), __uint_as_float(yr[j].y & 0xffff0000u)}; }
#pragma unroll
            for (int j = 0; j < 4; ++j) {
                float s = (y[j].x + y[j].y) + (y[j].z + y[j].w);
                s += __shfl_xor(s, 1); s += __shfl_xor(s, 2); s += __shfl_xor(s, 4); s += __shfl_xor(s, 8);
                const float mean = s * (1.0f / 64.0f); const f32x4 d = y[j] - mean;
                float q = (d.x * d.x + d.y * d.y) + (d.z * d.z + d.w * d.w);
                q += __shfl_xor(q, 1); q += __shfl_xor(q, 2); q += __shfl_xor(q, 4); q += __shfl_xor(q, 8);
                const float rs = 1.0f / sqrtf(q * (1.0f / 64.0f) + 64e-5f);
                const size_t off = (size_t)r * D + 4 * lane + 256 * j;
                const unsigned long long vv = *(const unsigned long long*)(Vb + off), gv = *(const unsigned long long*)(GG + off);
                const float bn = BON[(size_t)r * 16 + 4 * j + (lane >> 4)];
                f32x4 v4, g4;
                v4.x = __uint_as_float((unsigned)(vv & 0xffffull) << 16); v4.y = __uint_as_float((unsigned)((vv >> 16) & 0xffffull) << 16); v4.z = __uint_as_float((unsigned)((vv >> 32) & 0xffffull) << 16); v4.w = __uint_as_float((unsigned)((vv >> 48) & 0xffffull) << 16);
                g4.x = __uint_as_float((unsigned)(gv & 0xffffull) << 16); g4.y = __uint_as_float((unsigned)((gv >> 16) & 0xffffull) << 16); g4.z = __uint_as_float((unsigned)((gv >> 32) & 0xffffull) << 16); g4.w = __uint_as_float((unsigned)((gv >> 48) & 0xffffull) << 16);
                o[j] = (d * rs * gg[j] + gb[j] + v4 * bn) * g4;
            }
        }
        store_row_bf16(YG + (size_t)r * D, lane, o);
    }
}

enum { TK_SWIGLU = 0, TK_RESID = 1, TK_P4 = 2, TK_P5 = 3, TK_KV = 4, TK_Q = 5, TK_PART = 6 };
struct ThinOut { int kind; float scale; int g; };

__device__ __forceinline__ void thin_epilogue(const Ctx& C, const ThinOut& T, const f32x4s v, int xr0, int col, int fr, int fq) {
    unsigned char* ws = C.ws;
    if (T.kind == TK_SWIGLU) {
        f32x4s up;
#pragma unroll
        for (int e = 0; e < 4; ++e) up[e] = __shfl_xor(v[e], 4);
        if ((fr & 4) == 0) { bf16_t* H = (bf16_t*)(ws + U_H);
#pragma unroll
            for (int e = 0; e < 4; ++e) H[(size_t)(ROW_S + xr0 + e) * FF + (col >> 3) * 4 + (col & 3)] = f2bf_s(v[e] * pg8::fast_sigmoid(v[e]) * up[e]); }
    } else if (T.kind == TK_RESID) {
#pragma unroll
        for (int e = 0; e < 4; ++e) { unsigned short* p = (unsigned short*)xrow_ptr(C.out, (float*)(C.ws + WS_XEXTRA), ROW_S + xr0 + e) + col; float x = __uint_as_float((unsigned)*p << 16);
            if (T.g == 1) { const float* P = (const float*)(ws + WS_PART) + (size_t)(xr0 + e) * 1024 + col; x = x + 0.5f * (((P[0] + P[192 * 1024]) + P[2 * 192 * 1024]) + P[3 * 192 * 1024]); }
            *p = f2bf_s(x + T.scale * v[e]); }
    } else if (T.kind == TK_PART) {
        float* P = (float*)(ws + WS_PART) + (size_t)T.g * 192 * 1024;
#pragma unroll
        for (int e = 0; e < 4; ++e) P[(size_t)(xr0 + e) * 1024 + col] = v[e];
    } else if (T.kind == TK_P4) {
        if (T.g < 3) { bf16_t* O = (bf16_t*)(C.out + O_CKP) + (size_t)T.g * MP * D;
#pragma unroll
            for (int e = 0; e < 4; ++e) O[(size_t)(ROW_S + xr0 + e) * D + col] = f2bf_s(v[e]); }
        else { bf16_t* O = (bf16_t*)(ws + U_LOR) + (size_t)(T.g - 3) * MP * 256;
#pragma unroll
            for (int e = 0; e < 4; ++e) { const float x = (T.g == 3) ? pg8::fast_tanh(v[e]) : (T.g == 5) ? pg8::fast_sigmoid(v[e]) : v[e]; O[(size_t)(ROW_S + xr0 + e) * 256 + col] = f2bf_s(x); } }
    } else if (T.kind == TK_P5) {
#pragma unroll
        for (int e = 0; e < 4; ++e) { const size_t off = (size_t)(ROW_S + xr0 + e) * D + col;
            if (T.g == 0) ((bf16_t*)(ws + U_LOGW))[off] = f2bf_s(-0.6065306597126334f * pg8::fast_sigmoid(v[e] + in_ptr(17)[col]));
            else if (T.g == 1) ((bf16_t*)(ws + U_ASIG))[off] = f2bf_s(pg8::fast_sigmoid(v[e] + in_ptr(20)[col]));
            else ((bf16_t*)(ws + U_G))[off] = f2bf_s(v[e]); }
    } else {
        const bool isQ = (T.kind == TK_Q), isK = isQ || (col < 1024);
        const int c1 = col & 1023; const bool ropeb = isK && ((c1 & 63) < 16);
        f32x4s pr;
#pragma unroll
        for (int e = 0; e < 4; ++e) pr[e] = __shfl_xor(v[e], 8);
        const float* rope = (const float*)(ws + WS_ROPE);
#pragma unroll
        for (int e = 0; e < 4; ++e) { const int xr = xr0 + e, row = ROW_S + xr; float x = v[e];
            const int pos = (xr < 128) ? 2064 + (xr & 15) : ((xr - 128) & 15);
            if (ropeb) { const float cs = rope[(size_t)pos * 16 + (fr & 7)], sn = rope[(size_t)pos * 16 + 8 + (fr & 7)]; x = x * cs + ((fr < 8) ? -pr[e] : pr[e]) * sn; }
            if (isQ) { ((bf16_t*)(ws + U_QB))[(size_t)row * D + c1] = f2bf_s(x * T.scale); }
            else if (xr < 128) { C.out[(isK ? O_CKS : O_CVS) + (size_t)xr * 1024 + c1] = x; }
            else { const int i = xr - 128, b = i >> 4, j = i & 15;
                C.out[(isK ? O_CKP : O_CVP) + ((size_t)b * 4112 + j) * 1024 + c1] = x;
                ((bf16_t*)(ws + (isK ? WS_KMETA : WS_VMETA)))[((size_t)b * 128 + j) * 1024 + c1] = f2bf_s(x); } }
    }
}

template <int NKS, int NB>
__device__ __forceinline__ void thin_unit(const Ctx& C, const bf16_t* A, int lda, const bf16_t* Bt, int ldb, int K, int cb0, int rg, const ThinOut& T, int colbase) {
    const int w = C.wave, lane = C.lane, fr = lane & 15, fq = lane >> 4;
    LAS f32x4s* red = (LAS f32x4s*)(C.lds + RING_OFF);
    const bf16_t* bp = Bt + (size_t)(cb0 * 16 + fr) * ldb + fq * 8;
    const bf16_t* ap = A + (size_t)(ROW_S + rg * 48 + fr) * lda + fq * 8;
    const int nks = K >> 5;
    bf16x8s fb[NB][NKS], fa0[NKS], fa1[NKS], fa2[NKS];
#pragma unroll
    for (int i = 0; i < NKS; ++i) { const int ks = w + 8 * i; const int kc = (ks < nks) ? ks : 0;
        fa0[i] = *(const bf16x8s*)(ap + kc * 32); fa1[i] = *(const bf16x8s*)(ap + (size_t)16 * lda + kc * 32); fa2[i] = *(const bf16x8s*)(ap + (size_t)32 * lda + kc * 32);
#pragma unroll
        for (int nb = 0; nb < NB; ++nb) fb[nb][i] = *(const bf16x8s*)(bp + (size_t)nb * 16 * ldb + kc * 32); }
    f32x4s acc[NB][3];
#pragma unroll
    for (int nb = 0; nb < NB; ++nb) { acc[nb][0] = (f32x4s){0.f, 0.f, 0.f, 0.f}; acc[nb][1] = acc[nb][0]; acc[nb][2] = acc[nb][0]; }
#pragma unroll
    for (int i = 0; i < NKS; ++i) { if (w + 8 * i < nks) {
#pragma unroll
        for (int nb = 0; nb < NB; ++nb) { acc[nb][0] = __builtin_amdgcn_mfma_f32_16x16x32_bf16(fa0[i], fb[nb][i], acc[nb][0], 0, 0, 0); acc[nb][1] = __builtin_amdgcn_mfma_f32_16x16x32_bf16(fa1[i], fb[nb][i], acc[nb][1], 0, 0, 0);
            acc[nb][2] = __builtin_amdgcn_mfma_f32_16x16x32_bf16(fa2[i], fb[nb][i], acc[nb][2], 0, 0, 0); } } }
    __syncthreads();
#pragma unroll
    for (int nb = 0; nb < NB; ++nb)
#pragma unroll
        for (int rt = 0; rt < 3; ++rt) red[(w * (3 * NB) + nb * 3 + rt) * 64 + lane] = acc[nb][rt];
    __syncthreads();
#pragma unroll
    for (int j0 = 0; j0 < 3 * NB; j0 += 8) { const int idx = j0 + w;
        if (idx < 3 * NB) { const int nb = idx / 3, rt = idx - nb * 3;
            f32x4s s = red[(0 * (3 * NB) + idx) * 64 + lane];
#pragma unroll
            for (int j = 1; j < 8; ++j) s += red[(j * (3 * NB) + idx) * 64 + lane];
            thin_epilogue(C, T, s, rg * 48 + rt * 16 + 4 * fq, colbase + (cb0 + nb) * 16 + fr, fr, fq); } }
}

template <int NKS, int NB>
__device__ __forceinline__ int thin_run(const Ctx& C, int u0, const bf16_t* A, int lda, const bf16_t* Bt, int ldb, int K, int nblk, const ThinOut& T, int colbase, const int wg0 = 0, const int nwg_ = 0) {
    const int nwg = nwg_ > 0 ? nwg_ : C.G, rel = (int)blockIdx.x - (nwg_ > 0 ? wg0 : 0);
    const int nun = (nblk / NB) * 4;
    if (rel >= 0 && rel < nwg) {
        const int first = ((rel - (u0 % nwg)) % nwg + nwg) % nwg;
        for (int u = first; u < nun; u += nwg) thin_unit<NKS, NB>(C, A, lda, Bt, ldb, K, (u >> 2) * NB, u & 3, T, colbase); }
    return u0 + nun;
}
__device__ __forceinline__ void thin_run_down_split(const Ctx& C, const bf16_t* A, const bf16_t* Bt) {
    for (int u = (int)blockIdx.x; u < 256; u += C.G) { const int part = u >> 6, koff = part * 768;
        const ThinOut T{TK_PART, 0.f, part};
        thin_unit<3, 4>(C, A + koff, FF, Bt + koff, FF, (part == 3) ? 512 : 768, ((u >> 2) & 15) * 4, u & 3, T, 0); }
}

constexpr float ATT_C2 = 0.125f * 1.4426950408889634f;
constexpr float LAM_INIT = 0.35550906759096924f;
constexpr int SA_QS = 0, SA_SS = 4608, SA_SROW = 2320, SA_T = SA_SS + 32 * SA_SROW, SA_KTB = 17408, SA_VTB = 18432;
__device__ __forceinline__ void sample_attn_unit(const Ctx& C, int unit) {
    const int b = unit >> 5, hh = (unit >> 2) & 7, part = unit & 3, tile0 = (part == 0) ? 0 : 1 + 8 * part, nt = (part == 0) ? 9 : 8;
    const int key_base = tile0 * 64, nvalid = (2080 - key_base) < nt * 64 ? (2080 - key_base) : nt * 64;
    const int tid = C.tid, lane = C.lane, w = C.wave, fr = lane & 15, fq = lane >> 4;
    LAS unsigned char* L = C.lds + RING_OFF;
    const float* ck = in_ptr(2); const float* cv = in_ptr(3);
    __syncthreads();
    if (tid < 256) { const int q = tid >> 4, p16 = tid & 15, c = p16 >> 3, d0 = (p16 & 7) * 8;
        *(LAS v4u*)(L + SA_QS + ((c * 16 + q) * 72 + d0) * 2) = *(const v4u*)((const bf16_t*)(C.ws + U_QB) + (size_t)(ROW_S + b * 16 + q) * D + hh * 128 + c * 64 + d0); }
    const int lkey = tid >> 3, seg = tid & 7;
#define SA_SRC(base_cache, OFF_NEW, t, dst) do { const int gk_ = key_base + 64 * (t) + lkey; \
        if (gk_ < 2064) { const float* s_ = (base_cache) + (((size_t)b * 2064 + gk_) * 8 + hh) * 128 + seg * 16; dst[0] = *(const f32x4*)s_; dst[1] = *(const f32x4*)(s_ + 4); dst[2] = *(const f32x4*)(s_ + 8); dst[3] = *(const f32x4*)(s_ + 12); } \
        else if (gk_ < 2080) { const float* s_ = C.out + (OFF_NEW) + (((size_t)b * 16 + (gk_ - 2064)) * 8 + hh) * 128 + seg * 16; dst[0] = *(const f32x4*)s_; dst[1] = *(const f32x4*)(s_ + 4); dst[2] = *(const f32x4*)(s_ + 8); dst[3] = *(const f32x4*)(s_ + 12); } \
        else { dst[0] = dst[1] = dst[2] = dst[3] = (f32x4){0.f, 0.f, 0.f, 0.f}; } } while (0)
    f32x4 r0[4], r1[4], r2[4];
#define SA_BAR() do { asm volatile("s_waitcnt lgkmcnt(0)" ::: "memory"); __builtin_amdgcn_s_barrier(); asm volatile("" ::: "memory"); } while (0)
    SA_SRC(ck, O_CKS, 0, r0); if (1 < nt) SA_SRC(ck, O_CKS, 1, r1); if (2 < nt) SA_SRC(ck, O_CKS, 2, r2);
#define SA_KPUT(R, t) do { LAS unsigned char* kt_ = L + SA_T + ((t) & 1) * SA_KTB + lkey * 272 + seg * 32; \
        v4u a_, b_; a_.x = pg8::cvt_pk_bf16(R[0].x, R[0].y); a_.y = pg8::cvt_pk_bf16(R[0].z, R[0].w); a_.z = pg8::cvt_pk_bf16(R[1].x, R[1].y); a_.w = pg8::cvt_pk_bf16(R[1].z, R[1].w); \
        b_.x = pg8::cvt_pk_bf16(R[2].x, R[2].y); b_.y = pg8::cvt_pk_bf16(R[2].z, R[2].w); b_.z = pg8::cvt_pk_bf16(R[3].x, R[3].y); b_.w = pg8::cvt_pk_bf16(R[3].z, R[3].w); \
        *(LAS v4u*)kt_ = a_; *(LAS v4u*)(kt_ + 16) = b_; } while (0)
#define SA_SCORE(t) do { const int c_ = w >> 2, kt4_ = w & 3; const LAS unsigned char* kb_ = L + SA_T + ((t) & 1) * SA_KTB + (16 * kt4_ + fr) * 272 + (c_ * 64 + 8 * fq) * 2; \
        const LAS unsigned char* qb_ = L + SA_QS + ((c_ * 16 + fr) * 72 + 8 * fq) * 2; \
        f32x4s s_ = __builtin_amdgcn_mfma_f32_16x16x32_bf16(*(const LAS bf16x8s*)qb_, *(const LAS bf16x8s*)kb_, (f32x4s){0.f, 0.f, 0.f, 0.f}, 0, 0, 0); \
        s_ = __builtin_amdgcn_mfma_f32_16x16x32_bf16(*(const LAS bf16x8s*)(qb_ + 64), *(const LAS bf16x8s*)(kb_ + 64), s_, 0, 0, 0); \
        LAS float* sp_ = (LAS float*)(L + SA_SS + (c_ * 16 + 4 * fq) * SA_SROW) + 64 * (t) + 16 * kt4_ + fr; \
        sp_[0] = s_[0]; sp_[SA_SROW / 4] = s_[1]; sp_[2 * (SA_SROW / 4)] = s_[2]; sp_[3 * (SA_SROW / 4)] = s_[3]; } while (0)
    for (int t0 = 0; t0 < nt; t0 += 3) {
        SA_KPUT(r0, t0); if (t0 + 3 < nt) SA_SRC(ck, O_CKS, t0 + 3, r0); SA_BAR(); SA_SCORE(t0);
        if (t0 + 1 < nt) { SA_KPUT(r1, t0 + 1); if (t0 + 4 < nt) SA_SRC(ck, O_CKS, t0 + 4, r1); SA_BAR(); SA_SCORE(t0 + 1); }
        if (t0 + 2 < nt) { SA_KPUT(r2, t0 + 2); if (t0 + 5 < nt) SA_SRC(ck, O_CKS, t0 + 5, r2); SA_BAR(); SA_SCORE(t0 + 2); }
    }
    SA_SRC(cv, O_CVS, 0, r0); if (1 < nt) SA_SRC(cv, O_CVS, 1, r1); if (2 < nt) SA_SRC(cv, O_CVS, 2, r2);
    __syncthreads();
    float* PT = (float*)(C.ws + U_SPART) + (size_t)unit * 4160;
#pragma unroll
    for (int i = 0; i < 4; ++i) { const int row = 4 * w + i; LAS float* sr = (LAS float*)(L + SA_SS + row * SA_SROW);
        float sv[9]; float m = -INFINITY;
#pragma unroll
        for (int j = 0; j < 9; ++j) { const int k = lane + 64 * j; sv[j] = (k < nvalid) ? sr[k] : -INFINITY; m = fmaxf(m, sv[j]); }
        m = wave_max(m); float l = 0.f;
#pragma unroll
        for (int j = 0; j < 9; ++j) { sv[j] = exp2f(sv[j] - m); l += sv[j]; }
        l = wave_sum(l);
        LAS unsigned short* pr = (LAS unsigned short*)sr;
#pragma unroll
        for (int j = 0; j < 9; ++j) { const int k = lane + 64 * j; if (k < nt * 64) pr[k] = f2bf_s(sv[j]); }
        if (lane == 0) { PT[4096 + row] = m; PT[4096 + 32 + row] = l; } }
    __syncthreads();
#define SA_VPUT(R, t) do { LAS unsigned short* vt_ = (LAS unsigned short*)(L + SA_T + ((t) & 1) * SA_VTB) + (seg * 16) * 72 + lkey; \
        _Pragma("unroll") for (int i_ = 0; i_ < 4; ++i_) { vt_[(4 * i_) * 72] = f2bf_s(R[i_].x); vt_[(4 * i_ + 1) * 72] = f2bf_s(R[i_].y); vt_[(4 * i_ + 2) * 72] = f2bf_s(R[i_].z); vt_[(4 * i_ + 3) * 72] = f2bf_s(R[i_].w); } } while (0)
    f32x4s o0 = {0.f, 0.f, 0.f, 0.f}, o1 = o0;
    const int oc = w >> 2, odt = 2 * (w & 3);
#define SA_PV(t) do { const LAS unsigned char* pb_ = L + SA_SS + (oc * 16 + fr) * SA_SROW + (64 * (t) + 8 * fq) * 2; \
        const LAS unsigned char* vb_ = L + SA_T + ((t) & 1) * SA_VTB + ((16 * odt + fr) * 72 + 8 * fq) * 2; \
        const bf16x8s pa0_ = *(const LAS bf16x8s*)pb_, pa1_ = *(const LAS bf16x8s*)(pb_ + 64); \
        o0 = __builtin_amdgcn_mfma_f32_16x16x32_bf16(pa0_, *(const LAS bf16x8s*)vb_, o0, 0, 0, 0); o0 = __builtin_amdgcn_mfma_f32_16x16x32_bf16(pa1_, *(const LAS bf16x8s*)(vb_ + 64), o0, 0, 0, 0); \
        o1 = __builtin_amdgcn_mfma_f32_16x16x32_bf16(pa0_, *(const LAS bf16x8s*)(vb_ + 16 * 144), o1, 0, 0, 0); o1 = __builtin_amdgcn_mfma_f32_16x16x32_bf16(pa1_, *(const LAS bf16x8s*)(vb_ + 16 * 144 + 64), o1, 0, 0, 0); } while (0)
    for (int t0 = 0; t0 < nt; t0 += 3) {
        SA_VPUT(r0, t0); if (t0 + 3 < nt) SA_SRC(cv, O_CVS, t0 + 3, r0); SA_BAR(); SA_PV(t0);
        if (t0 + 1 < nt) { SA_VPUT(r1, t0 + 1); if (t0 + 4 < nt) SA_SRC(cv, O_CVS, t0 + 4, r1); SA_BAR(); SA_PV(t0 + 1); }
        if (t0 + 2 < nt) { SA_VPUT(r2, t0 + 2); if (t0 + 5 < nt) SA_SRC(cv, O_CVS, t0 + 5, r2); SA_BAR(); SA_PV(t0 + 2); }
    }
#undef SA_SRC
#undef SA_BAR
#undef SA_KPUT
#undef SA_SCORE
#undef SA_VPUT
#undef SA_PV
#pragma unroll
    for (int e = 0; e < 4; ++e) { PT[(oc * 16 + 4 * fq + e) * 128 + 16 * odt + fr] = o0[e]; PT[(oc * 16 + 4 * fq + e) * 128 + 16 * (odt + 1) + fr] = o1[e]; }
    __syncthreads();
}

__device__ __forceinline__ void attn_combine_block(const Ctx& C, const int b, const int hh, const int qb) {
    const bf16_t* O1 = (const bf16_t*)(C.ws + U_O1); const bf16_t* O2 = (const bf16_t*)(C.ws + U_O2); bf16_t* OA = (bf16_t*)(C.ws + U_OA);
    const float lam = ((const float*)(C.ws + WS_MISC))[0];
    const int lane = C.lane, l32 = lane & 31;
    const f32x4 sub = *(const f32x4*)(in_ptr(36) + 4 * l32);
    const size_t off0 = (size_t)(b * 4096 + qb * 256 + C.wave * 32 + (lane >> 5)) * D + hh * 128 + 4 * l32;
    unsigned long long av[16], bv[16];
#pragma unroll
    for (int it = 0; it < 16; ++it) { const size_t off = off0 + (size_t)(2 * it) * D; av[it] = *(const unsigned long long*)(O1 + off); bv[it] = *(const unsigned long long*)(O2 + off); }
#pragma unroll
    for (int it = 0; it < 16; ++it) {
        const size_t off = off0 + (size_t)(2 * it) * D;
        const unsigned long long a = av[it], bb = bv[it];
        f32x4 o;
        o.x = __uint_as_float((unsigned)(a & 0xffffull) << 16) - lam * __uint_as_float((unsigned)(bb & 0xffffull) << 16);
        o.y = __uint_as_float((unsigned)((a >> 16) & 0xffffull) << 16) - lam * __uint_as_float((unsigned)((bb >> 16) & 0xffffull) << 16);
        o.z = __uint_as_float((unsigned)((a >> 32) & 0xffffull) << 16) - lam * __uint_as_float((unsigned)((bb >> 32) & 0xffffull) << 16);
        o.w = __uint_as_float((unsigned)((a >> 48) & 0xffffull) << 16) - lam * __uint_as_float((unsigned)((bb >> 48) & 0xffffull) << 16);
        float ss = (o.x * o.x + o.y * o.y) + (o.z * o.z + o.w * o.w);
        ss += __shfl_xor(ss, 1); ss += __shfl_xor(ss, 2); ss += __shfl_xor(ss, 4); ss += __shfl_xor(ss, 8); ss += __shfl_xor(ss, 16);
        const float rs = 1.0f / sqrtf(ss * (1.0f / 128.0f) + 1e-5f) * (1.0f - LAM_INIT);
        o = o * rs * sub;
        *(unsigned long long*)(OA + off) = (unsigned long long)pk2(o.x, o.y) | ((unsigned long long)pk2(o.z, o.w) << 32);
    }
}
__device__ __forceinline__ void p_attn_main(const Ctx& C, const int i0, const int i1, const int istep) {
    const int v = C.vcu, s = v & 7;
    for (int i = i0; i < i1; i += istep) {
        int combo, qb;
        if (C.G == 256) { combo = ((v >> 3) << 1) | (i & 1); qb = (i < 2) ? 15 - s : s; } else { combo = i >> 4; qb = i & 15; }
        const int c = combo & 1, hh = (combo >> 1) & 7, b = combo >> 4;
        attn_body::attn_unit<8>(b, 2 * hh + c, 2 * hh, qb, C.ws, (long)U_QB, (long)U_KB, (long)U_VB, (long)WS_KMETA, (long)WS_VMETA, (long)(c ? U_O2 : U_O1), (char*)C.lds + RING_OFF, mk_tid(C.wave)); }
}
__device__ __forceinline__ void p_attn(Ctx& C) {
    if (C.G == 256) {
        const int is = (C.vcu >> 3) & 3, hh = (C.vcu >> 3) & 7, b = C.vcu >> 6, s = C.vcu & 7;
        p_attn_main(C, 0, is, 1);
#ifndef NO_SAMPLE
        __syncthreads(); sample_attn_unit(C, C.vcu); __syncthreads();
#endif
        C.lane = mk_lane(); C.tid = (C.wave << 6) | C.lane;
        p_attn_main(C, is, 4, 1);
        asm volatile("s_waitcnt vmcnt(0)" ::: "memory"); __syncthreads();
        C.lane = mk_lane(); C.tid = (C.wave << 6) | C.lane;
        attn_combine_block(C, b, hh, 15 - s); attn_combine_block(C, b, hh, s);
    } else {
        p_attn_main(C, C.vcu, 1024, C.G);
#ifndef NO_SAMPLE
        for (int u = C.vcu; u < 256; u += C.G) sample_attn_unit(C, u);
#endif
    }
}

__device__ __forceinline__ void p_combine(const Ctx& C) {
    const int gw = C.vcu * NWAVES + C.wave, NGW = C.G * NWAVES, lane = C.lane;
    const bf16_t* O1 = (const bf16_t*)(C.ws + U_O1); const bf16_t* O2 = (const bf16_t*)(C.ws + U_O2); bf16_t* OA = (bf16_t*)(C.ws + U_OA);
    const float lam = ((const float*)(C.ws + WS_MISC))[0];
    const f32x4 sub = *(const f32x4*)(in_ptr(36) + 4 * (lane & 31));
    for (int task = gw; task < 1024; task += NGW) {
        const int ri = task >> 3, hh = task & 7, b = ri >> 4, q = ri & 15;
        const float* PT = (const float*)(C.ws + U_SPART) + (size_t)((b * 8 + hh) * 4) * 4160;
        float oc[2][2];
#pragma unroll
        for (int c = 0; c < 2; ++c) {
            float mp[4], lp[4], M = -INFINITY;
#pragma unroll
            for (int p4 = 0; p4 < 4; ++p4) { mp[p4] = PT[p4 * 4160 + 4096 + c * 16 + q]; lp[p4] = PT[p4 * 4160 + 4096 + 32 + c * 16 + q]; M = fmaxf(M, mp[p4]); }
            float L = 0.f, a0 = 0.f, a1 = 0.f;
#pragma unroll
            for (int p4 = 0; p4 < 4; ++p4) { const float wgt = exp2f(mp[p4] - M); L += lp[p4] * wgt; a0 += wgt * PT[p4 * 4160 + (c * 16 + q) * 128 + lane]; a1 += wgt * PT[p4 * 4160 + (c * 16 + q) * 128 + 64 + lane]; }
            oc[c][0] = a0 / L; oc[c][1] = a1 / L;
        }
        const float o0 = oc[0][0] - lam * oc[1][0], o1 = oc[0][1] - lam * oc[1][1];
        const float rs = 1.0f / sqrtf(wave_sum(o0 * o0 + o1 * o1) * (1.0f / 128.0f) + 1e-5f) * (1.0f - LAM_INIT);
        bf16_t* op = OA + (size_t)(ROW_S + ri) * D + hh * 128;
        op[lane] = (bf16_t)f2bf(o0 * rs * in_ptr(36)[lane]); op[64 + lane] = (bf16_t)f2bf(o1 * rs * in_ptr(36)[64 + lane]);
    }
    for (int r = ROW_M + gw; r < MP; r += NGW) {
        f32x4 z[4];
#pragma unroll
        for (int j = 0; j < 4; ++j) z[j] = (f32x4){0.f, 0.f, 0.f, 0.f};
        store_row_bf16(OA + (size_t)r * D, lane, z); }
    if (C.G != 256) for (int r = gw; r < ROW_S; r += NGW) {
        f32x4 o[4];
#pragma unroll
        for (int j = 0; j < 4; ++j) { const size_t off = (size_t)r * D + 4 * lane + 256 * j;
            const unsigned long long a = *(const unsigned long long*)(O1 + off), bb = *(const unsigned long long*)(O2 + off);
            o[j].x = __uint_as_float((unsigned)(a & 0xffffull) << 16) - lam * __uint_as_float((unsigned)(bb & 0xffffull) << 16);
            o[j].y = __uint_as_float((unsigned)((a >> 16) & 0xffffull) << 16) - lam * __uint_as_float((unsigned)((bb >> 16) & 0xffffull) << 16);
            o[j].z = __uint_as_float((unsigned)((a >> 32) & 0xffffull) << 16) - lam * __uint_as_float((unsigned)((bb >> 32) & 0xffffull) << 16);
            o[j].w = __uint_as_float((unsigned)((a >> 48) & 0xffffull) << 16) - lam * __uint_as_float((unsigned)((bb >> 48) & 0xffffull) << 16); }
#pragma unroll
        for (int j = 0; j < 4; ++j) { float ss = (o[j].x * o[j].x + o[j].y * o[j].y) + (o[j].z * o[j].z + o[j].w * o[j].w);
            ss += __shfl_xor(ss, 1); ss += __shfl_xor(ss, 2); ss += __shfl_xor(ss, 4); ss += __shfl_xor(ss, 8); ss += __shfl_xor(ss, 16);
            const float rs = 1.0f / sqrtf(ss * (1.0f / 128.0f) + 1e-5f) * (1.0f - LAM_INIT);
            o[j] = o[j] * rs * sub; }
        store_row_bf16(OA + (size_t)r * D, lane, o);
    }
}

constexpr int N_PHASES = 27;
__global__ void __launch_bounds__(NWAVES * 64, 2) mk_fwd(Args args) {
    extern __shared__ __attribute__((aligned(16))) unsigned char lds[];
    Ctx C;
    C.out = args.out; C.ws = args.ws;
    C.lds = (LAS unsigned char*)lds; C.tid = threadIdx.x; C.lane = C.tid & 63; C.wave = __builtin_amdgcn_readfirstlane(C.tid >> 6);
    C.G = gridDim.x; { const int bx = blockIdx.x; C.vcu = (C.G % 8 == 0) ? (bx % 8) * (C.G / 8) + bx / 8 : bx; }
    volatile LAS unsigned* MISC = (volatile LAS unsigned*)(C.lds + MISC_OFF);
    for (int u = C.tid; u < (LDS_BYTES - LDSCTL_OFF) / 4; u += NWAVES * 64) ((LAS unsigned*)(C.lds + LDSCTL_OFF))[u] = 0u;
    __syncthreads();
    const int lo = args.ph_lo, hi = args.ph_hi;
    const bool use_bar = (hi - lo) > 1;
    XcdBarrier bar; bar.bar = (unsigned*)(args.ws + WS_CTL) + CW_BAR; bar.x = 0; bar.st = nullptr;
    if (use_bar) bar = xcd_barrier_post((unsigned*)(args.ws + WS_CTL) + CW_BAR, MISC + 8, C.tid);
    unsigned char* const ws = C.ws;
#ifdef PROBE_HASH
    if (lo == 100) {
        const unsigned* a = (const unsigned*)C.out; const size_t na = (size_t)42733568;
        const unsigned* b = (const unsigned*)(args.ws + PROBE_HASH_WS_LO); const size_t nb = (size_t)(PROBE_HASH_WS_HI - PROBE_HASH_WS_LO) / 4;
        const size_t gt = (size_t)blockIdx.x * 512 + C.tid, NT_ = (size_t)C.G * 512;
        unsigned h1 = 0x811c9dc5u, h2 = 0x811c9dc5u;
        for (size_t e = gt; e < na; e += NT_) { h1 = (h1 ^ a[e]) * 16777619u; h1 ^= h1 >> 13; }
        for (size_t e = gt; e < nb; e += NT_) { h2 = (h2 ^ b[e]) * 16777619u; h2 ^= h2 >> 13; }
        float* dst = C.out + O_WKVS;
        dst[gt] = (float)(h1 & 0xffffu); dst[131072 + gt] = (float)(h2 & 0xffffu);
        return;
    }
#endif
#define IN(k) (lo <= (k) && (k) < hi)
#define RELAUNDER() do { C.lane = mk_lane(); C.tid = (C.wave << 6) | C.lane; } while (0)
#ifdef PROBE_TIME
    volatile unsigned long long* stamps = (volatile unsigned long long*)(ws + WS_MISC + 1024);
    if (blockIdx.x == 0 && C.tid == 0) stamps[0] = __builtin_amdgcn_s_memrealtime();
#define SEAM(k) do { if (IN(k) && IN((k) + 1)) xcd_barrier(bar, mk_tid(C.wave)); RELAUNDER(); if (blockIdx.x == 0 && C.tid == 0) stamps[(k) + 1] = __builtin_amdgcn_s_memrealtime(); } while (0)
#else
#define SEAM(k) do { if (IN(k) && IN((k) + 1)) xcd_barrier(bar, mk_tid(C.wave)); RELAUNDER(); } while (0)
#endif
#ifdef PROBE_TIME
#define PSTAMP(i) do { __syncthreads(); if (blockIdx.x == 0 && C.tid == 0) stamps[i] = __builtin_amdgcn_s_memrealtime(); } while (0)
#else
#define PSTAMP(i) do { } while (0)
#endif
#ifdef PROBE_TIME
#define SEAM_LOCAL(k) do { if (IN(k) && IN((k) + 1)) __syncthreads(); RELAUNDER(); if (blockIdx.x == 0 && C.tid == 0) stamps[(k) + 1] = __builtin_amdgcn_s_memrealtime(); } while (0)
#else
#define SEAM_LOCAL(k) do { if (IN(k) && IN((k) + 1)) __syncthreads(); RELAUNDER(); } while (0)
#endif
#define GEMM_PHASE_X(k, EPI, NN, MODE, APTR, BPTR, KK, SCALE, ALIGN_, SP2_) do { if (IN(k)) { \
        pg8::Gemm g{(const bf16_t*)(APTR), (const bf16_t*)(BPTR), MP, 0, (KK)}; pg8::GSched<NN, MODE> S; S.init(C.G, (int)blockIdx.x); EPI E{SCALE, C.out, ws, in_ptr(17), in_ptr(20)}; \
        pg8::gemm_phase<EPI, pg8::GSched<NN, MODE>, ALIGN_, SP2_>(C.lds + RING_OFF, g, S, E, mk_tid(C.wave)); RELAUNDER(); } SEAM(k); } while (0)
#define GEMM_PHASE(k, EPI, NN, MODE, APTR, BPTR, KK, SCALE) GEMM_PHASE_X(k, EPI, NN, MODE, APTR, BPTR, KK, SCALE, true, true)
#define FFN_PHASES(k, f) do { \
        GEMM_PHASE(k, pg8::EpiT<pg8::ET_SWIGLU>, NGU / 256, 0, ws + U_XN, (const bf16_t*)(ws + W_GU) + (size_t)(f) * NGU * D, D, 0.f); \
        GEMM_PHASE((k) + 1, pg8::EpiF<pg8::EF_RESID>, 4, 0, ws + U_H, (const bf16_t*)(ws + W_D) + (size_t)(f) * D * FF, FF, 0.5f); } while (0)
#define THIN(k, BODY) do { if (IN(k)) { BODY } } while (0)
#define FFN_THIN(f) \
        THIN_UP(f)
    if (IN(0)) p0_prologue(C); SEAM(0);
#undef FFN_PHASES
#define FFN_PHASES(k, f) do { \
        if (IN(k)) { pg8::Gemm g{(const bf16_t*)(ws + U_XN), (const bf16_t*)(ws + W_GU) + (size_t)(f) * NGU * D, MP, 0, D}; pg8::GSched<NGU / 256, 0, NTM> S; S.init(C.G, (int)blockIdx.x); pg8::EpiT<pg8::ET_SWIGLU> E{0.f, C.out, ws, nullptr, nullptr}; \
            pg8::gemm_phase<pg8::EpiT<pg8::ET_SWIGLU>, pg8::GSched<NGU / 256, 0, NTM>, true, true>(C.lds + RING_OFF, g, S, E, mk_tid(C.wave)); RELAUNDER();        \
            if ((f) < 3 && C.G == 256 && blockIdx.x >= 150 && (int)blockIdx.x < (((f) == 2) ? 248 : 256)) { __syncthreads(); p0_gu(C, (f) + 1, ((int)blockIdx.x - 150) * NWAVES + C.wave, (((f) == 2) ? 98 : 106) * NWAVES); }        \
            else if ((f) < 3 && C.G != 256) { __syncthreads(); p0_gu(C, (f) + 1, C.vcu * NWAVES + C.wave, C.G * NWAVES); } } SEAM(k); \
        if (IN((k) + 1)) { pg8::Gemm g{(const bf16_t*)(ws + U_H), (const bf16_t*)(ws + W_D) + (size_t)(f) * D * FF, MP, 0, FF}; pg8::GSched<4, 0> S; S.init(C.G, (int)blockIdx.x); pg8::EpiF<pg8::EF_RESID> E{0.5f, C.out, ws, nullptr, nullptr}; \
            pg8::gemm_phase<pg8::EpiF<pg8::EF_RESID>, pg8::GSched<4, 0>, true, true>(C.lds + RING_OFF, g, S, E, mk_tid(C.wave)); RELAUNDER(); \
            PSTAMP(40 + 2 * (f)); if ((f) < THIN_SPLIT_MINF) { const ThinOut T{TK_RESID, 0.5f, 0}; thin_run<11, 1>(C, 0, (const bf16_t*)(ws + U_H), FF, (const bf16_t*)(ws + W_D) + (size_t)(f) * D * FF, FF, FF, D / 16, T, 0); } \
            else thin_run_down_split(C, (const bf16_t*)(ws + U_H), (const bf16_t*)(ws + W_D) + (size_t)(f) * D * FF);        \
            PSTAMP(41 + 2 * (f)); } SEAM((k) + 1); } while (0)
#define RESID_PHASE(k, AOFF, WOFF) do { if (IN(k)) { \
            pg8::Gemm g{(const bf16_t*)(ws + (AOFF)), (const bf16_t*)(ws + (WOFF)), MP, 0, D}; pg8::GSched<4, 0> S; S.init(C.G, (int)blockIdx.x); pg8::EpiF<pg8::EF_RESID> E{1.0f, C.out, ws, nullptr, nullptr}; \
            pg8::gemm_phase<pg8::EpiF<pg8::EF_RESID>, pg8::GSched<4, 0>, true, true>(C.lds + RING_OFF, g, S, E, mk_tid(C.wave)); RELAUNDER(); \
            const ThinOut T{TK_RESID, 1.0f, ((k) == 10 && THIN_SPLIT_MINF <= 0) ? 1 : 0};        \
            thin_run<4, 1>(C, 0, (const bf16_t*)(ws + (AOFF)), D, (const bf16_t*)(ws + (WOFF)), D, D, D / 16, T, 0); } SEAM(k); } while (0)
    FFN_PHASES(1, 0);
    if (IN(3)) p_rwmix(C); SEAM(3);
    if (IN(4)) { pg8::Gemm g{(const bf16_t*)(ws + U_A6), (const bf16_t*)(ws + W_RKVL), MP, 0, D}; pg8::GSched<15, 1, NTM> S; S.init(C.G, (int)blockIdx.x); pg8::EpiT<pg8::ET_P4> E{0.f, C.out, ws, nullptr, nullptr};
        pg8::gemm_phase<pg8::EpiT<pg8::ET_P4>, pg8::GSched<15, 1, NTM>, true, true>(C.lds + RING_OFF, g, S, E, mk_tid(C.wave)); RELAUNDER();
        if (C.G == 256 && blockIdx.x >= 207) { __syncthreads();
            p0_transpose(C, in_ptr(11) + (size_t)1 * FF * D, FF, D, FF, D, (bf16_t*)(ws + W_D) + (size_t)1 * D * FF, FF, 0, 0, ((int)blockIdx.x - 207) * NWAVES + C.wave, 49 * NWAVES); } } SEAM(4);
#define P5_GEMM(KIND, gi) do { pg8::Gemm g{(const bf16_t*)(ws + U_LOR) + (size_t)(gi) * MP * 256, (const bf16_t*)(ws + W_LU) + (size_t)(gi) * 1024 * 256, MP, 0, 256}; pg8::GSched<4, 0> S; S.init(C.G, (int)blockIdx.x); \
        pg8::EpiF<KIND> E{0.f, C.out, ws, in_ptr(17), in_ptr(20)}; pg8::gemm_phase<pg8::EpiF<KIND>, pg8::GSched<4, 0>, true, true>(C.lds + RING_OFF, g, S, E, mk_tid(C.wave)); RELAUNDER(); } while (0)
    if (IN(5)) { { pg8::Gemm g{(const bf16_t*)(ws + U_LOR), (const bf16_t*)(ws + W_LU), MP, 0, 256}; pg8::GSched<12, 2> S; S.init(C.G, (int)blockIdx.x);
          pg8::EpiF<pg8::EF_P5ALL> E{0.f, C.out, ws, in_ptr(17), in_ptr(20)}; pg8::gemm_phase<pg8::EpiF<pg8::EF_P5ALL>, pg8::GSched<12, 2>, true, true>(C.lds + RING_OFF, g, S, E, mk_tid(C.wave)); RELAUNDER(); }
        int u0 = 0;
        for (int gi = 0; gi < 3; ++gi) { const ThinOut T{TK_P5, 0.f, gi};
            u0 = thin_run<1, 4>(C, u0, (const bf16_t*)(ws + U_LOR) + (size_t)gi * MP * 256, 256, (const bf16_t*)(ws + W_LU) + (size_t)gi * 1024 * 256, 256, gi == 2 ? 160 : 64, 64, T, 0); } } SEAM(5);
#undef P5_GEMM
    if (IN(6)) p_scan_pre(C, 0); SEAM(6);
    if (IN(7)) { p_scan_seq(C, 0); RELAUNDER(); if (blockIdx.x >= 64) { __syncthreads(); p_scan_pre(C, 1); } } SEAM(7);
    if (IN(8)) { p_scan_seq(C, 1); RELAUNDER();
        if (C.G == 256 && blockIdx.x >= 64) { __syncthreads(); p_scan_post(C, 1, ((int)blockIdx.x - 64) * NWAVES + C.wave, 192 * NWAVES); } } SEAM(8);
    if (IN(9)) p_scan_post(C, (C.G == 256) ? 2 : 0, C.vcu * NWAVES + C.wave, C.G * NWAVES); SEAM(9);
    RESID_PHASE(10, U_YG, W_ORW);
    if (IN(11)) p_norm(C, in_ptr(7) + 1 * D, (bf16_t*)(ws + U_XN), nullptr, nullptr); SEAM(11);
    FFN_PHASES(12, 1);
    if (IN(14)) p_norm(C, in_ptr(30), (bf16_t*)(ws + U_HNKV), in_ptr(7) + 2 * D, (bf16_t*)(ws + U_XN), THIN_SPLIT_MINF <= 1); SEAM(14);
    if (IN(15)) { pg8::Gemm g{(const bf16_t*)(ws + U_HNKV), (const bf16_t*)(ws + W_KV), MP, 0, D}; pg8::GSched<8, 0, NTM> S; S.init(C.G, (C.G == 256) ? ((int)blockIdx.x + 8) % 256 : (int)blockIdx.x); pg8::EpiF<pg8::EF_KV> E{0.f, C.out, ws, nullptr, nullptr};
        pg8::gemm_phase<pg8::EpiF<pg8::EF_KV>, pg8::GSched<8, 0, NTM>, true, true>(C.lds + RING_OFF, g, S, E, mk_tid(C.wave)); RELAUNDER(); } SEAM_LOCAL(15);
    FFN_PHASES(16, 2);
    if (IN(18)) p_norm(C, in_ptr(8) + D, (bf16_t*)(ws + U_HN1), nullptr, nullptr, THIN_SPLIT_MINF <= 2); SEAM(18);
    if (IN(19)) { pg8::Gemm g{(const bf16_t*)(ws + U_HN1), (const bf16_t*)(ws + W_Q), MP, 0, D}; pg8::GSched<4, 0> S; S.init(C.G, (int)blockIdx.x); pg8::EpiF<pg8::EF_Q> E{ATT_C2, C.out, ws, nullptr, nullptr};
        pg8::gemm_phase<pg8::EpiF<pg8::EF_Q>, pg8::GSched<4, 0>, true, true>(C.lds + RING_OFF, g, S, E, mk_tid(C.wave)); RELAUNDER();
        const ThinOut T{TK_Q, ATT_C2, 0}; thin_run<4, 1>(C, 0, (const bf16_t*)(ws + U_HN1), D, (const bf16_t*)(ws + W_Q), D, D, 64, T, 0); } SEAM(19);
    if (IN(20)) p_attn(C); SEAM(20);
    if (IN(21)) p_combine(C); SEAM(21);
    RESID_PHASE(22, U_OA, W_OAT);
    if (IN(23)) p_norm(C, in_ptr(7) + 3 * D, (bf16_t*)(ws + U_XN), nullptr, nullptr); SEAM(23);
    FFN_PHASES(24, 3);
    if (IN(26)) p_final(C);
#ifdef PROBE_TIME
    if (blockIdx.x == 0) { __syncthreads();
#ifdef PROBE_ACC
        const unsigned long long dt = ((volatile unsigned long long*)(ws + WS_MISC + 2048))[PROBE_ACC] / 10;
#else
        const unsigned long long dt = stamps[PROBE_T1] - stamps[PROBE_T0];
#endif
        const float dl = (float)dt * (0.01f / 2000.0f);
        for (int e = C.tid; e < 4096; e += 512) C.out[O_SHP + e] *= (1.0f + dl); }
#endif
#undef THIN
#undef FFN_THIN
#undef RESID_PHASE
#undef IN
#undef SEAM
#undef GEMM_PHASE
#undef GEMM_PHASE_X
#undef FFN_PHASES
}

extern "C" void kernel_launch(void* const* d_in, const int* in_sizes, int n_in, void* d_out, int out_size, void* d_ws, size_t ws_size, hipStream_t stream) {
    static int grid = 0;
    if (grid == 0) {
        if (n_in != 38 || out_size != (int)O_END || ws_size < WS_END) { fprintf(stderr, "kernel_launch: unexpected shapes: n_in %d out %d ws %zu (need %zu)\n", n_in, out_size, ws_size, (size_t)WS_END); grid = -1; return; }
        int dev = 0, cus = 0, per_cu = 0;
        if (hipGetDevice(&dev) != hipSuccess || hipDeviceGetAttribute(&cus, hipDeviceAttributeMultiprocessorCount, dev) != hipSuccess) { grid = -1; return; }
        if (hipFuncSetAttribute((const void*)mk_fwd, hipFuncAttributeMaxDynamicSharedMemorySize, LDS_BYTES) != hipSuccess) { fprintf(stderr, "kernel_launch: hipFuncSetAttribute failed\n"); grid = -1; return; }
        if (hipOccupancyMaxActiveBlocksPerMultiprocessor(&per_cu, (const void*)mk_fwd, NWAVES * 64, LDS_BYTES) != hipSuccess || per_cu < 1) fprintf(stderr, "kernel_launch: occupancy query reports %d\n", per_cu);
        (void)hipGetLastError();
        grid = cus;
    }
    if (grid < 0) return;
    (void)hipMemsetAsync((char*)d_ws + WS_CTL, 0, CTL_ZERO_BYTES, stream);
    Args a{};
    for (int i = 0; i < 38; ++i) a.in[i] = (const float*)d_in[i];
    a.out = (float*)d_out; a.ws = (unsigned char*)d_ws;
#ifndef MK_PER_PHASE
#define MK_PER_PHASE 0
#endif
#if MK_PER_PHASE
#ifndef MK_LAST_PHASE
#define MK_LAST_PHASE N_PHASES
#endif
    for (int ph = 0; ph < MK_LAST_PHASE; ++ph) { a.ph_lo = ph; a.ph_hi = ph + 1; hipLaunchKernelGGL(mk_fwd, dim3(grid), dim3(NWAVES * 64), LDS_BYTES, stream, a); }
#ifdef PROBE_HASH
    a.ph_lo = 100; a.ph_hi = 101; hipLaunchKernelGGL(mk_fwd, dim3(grid), dim3(NWAVES * 64), LDS_BYTES, stream, a);
#endif
#else
    a.ph_lo = 0; a.ph_hi = N_PHASES; hipLaunchKernelGGL(mk_fwd, dim3(grid), dim3(NWAVES * 64), LDS_BYTES, stream, a);
#endif
}
```
